# Optimizing an MI355X kernel written in HIP

```python
import math
import jax, jax.numpy as jnp
from jax import lax
import numpy as np

D_MODEL = 1024
BATCH = 4
SEQ = 4096
DEPTH = 2

D_A = D_MODEL
CONV_A_WIDTH = 3
D_R = (D_MODEL * 5) // 4
N_RG_BLOCKS = 10
RG_BLOCK = D_R // N_RG_BLOCKS
CONV_R_WIDTH = 4
RG_C = 8.0
SPLITS = (D_A, 2 * D_A, 3 * D_A, 3 * D_A + D_R, 3 * D_A + 2 * D_R, 3 * D_A + 2 * D_R + D_MODEL)
D_IN = 3 * D_A + 2 * D_R + 2 * D_MODEL
N_EXPERTS = 16
N_GROUPS = 4
EXPERTS_PER_GROUP = N_EXPERTS // N_GROUPS
TOP_K = 2
D_FF_EXPERT = D_MODEL // 2
DN_ALPHA = (2.0 * DEPTH) ** 0.25
DN_BETA = (8.0 * DEPTH) ** -0.25
LN_EPS = 1e-5

kernel_name = 'hybrid_conv_rglru_grouped_moe_deepnorm'


def layer_norm(x, g, b):
    xf = x.astype(jnp.float32)
    mu = jnp.mean(xf, axis=-1, keepdims=True)
    var = jnp.mean(jnp.square(xf - mu), axis=-1, keepdims=True)
    return ((xf - mu) * lax.rsqrt(var + LN_EPS) * g.astype(jnp.float32) + b.astype(jnp.float32)).astype(x.dtype)


def causal_dwconv(u, w):
    k_width = w.shape[0]
    s = u.shape[1]
    up = jnp.pad(u, ((0, 0), (k_width - 1, 0), (0, 0)))
    y = up[:, 0:s] * w[0]
    for k in range(1, k_width):
        y = y + up[:, k:k + s] * w[k]
    return y


def linear_recurrence(a, b):
    def combine(left, right):
        a_l, b_l = left
        a_r, b_r = right
        return a_r * a_l, a_r * b_l + b_r
    _, h = lax.associative_scan(combine, (a, b), axis=1)
    return h


def block_diag(u, w, bias):
    bsz, s, _ = u.shape
    ub = u.reshape(bsz, s, N_RG_BLOCKS, RG_BLOCK)
    return (jnp.einsum('bshi,hij->bshj', ub, w) + bias).reshape(bsz, s, D_R)


def shared_group_router(xt, w_router, b_router):
    logits = xt.astype(jnp.float32) @ w_router.astype(jnp.float32) + b_router.astype(jnp.float32)
    probs = jax.nn.softmax(logits, axis=-1)
    probs_g = probs.reshape(-1, N_GROUPS, EXPERTS_PER_GROUP)
    group_score = jnp.sum(lax.top_k(probs_g, TOP_K)[0], axis=-1)
    g_sel = jnp.argmax(group_score, axis=-1)
    in_group = jnp.take_along_axis(probs_g, g_sel[:, None, None], axis=1)[:, 0]
    vals, local = lax.top_k(in_group, TOP_K)
    vals = vals / jnp.sum(vals, axis=-1, keepdims=True)
    idx = g_sel[:, None] * EXPERTS_PER_GROUP + local
    return jnp.sum(jax.nn.one_hot(idx, N_EXPERTS, dtype=jnp.float32) * vals[..., None], axis=1)


def grouped_moe(x, w_router, b_router, w_gate, w_up, w_down):
    bsz, s, d = x.shape
    xt = x.reshape(bsz * s, d)
    gates = shared_group_router(xt, w_router, b_router).astype(x.dtype)
    out = jnp.zeros_like(xt)
    for e in range(N_EXPERTS):
        h = jax.nn.silu(xt @ w_gate[e]) * (xt @ w_up[e])
        out = out + gates[:, e:e + 1] * (h @ w_down[e])
    return out.reshape(bsz, s, d)


def setup_inputs(seed: int = 0) -> dict:
    key = jax.random.key(seed)
    ks = jax.random.split(key, 24)

    def nrm(k, shape, scale):
        return jax.random.normal(k, shape, jnp.float32) * scale

    u = jax.random.uniform(ks[10], (DEPTH, D_R), jnp.float32, minval=0.9, maxval=0.999)
    p = u ** (1.0 / RG_C)
    rg_lambda = jnp.log(p) - jnp.log1p(-p)
    return {
        'x': nrm(ks[0], (BATCH, SEQ, D_MODEL), 1.0),
        'w_in': nrm(ks[1], (DEPTH, D_MODEL, D_IN), D_MODEL ** -0.5),
        'conv_a_w': nrm(ks[2], (DEPTH, CONV_A_WIDTH, D_A), CONV_A_WIDTH ** -0.5),
        'w_branch_a': nrm(ks[3], (DEPTH, D_A, D_MODEL), DN_BETA * D_A ** -0.5),
        'conv_r_w': nrm(ks[4], (DEPTH, CONV_R_WIDTH, D_R), CONV_R_WIDTH ** -0.5),
        'conv_r_b': nrm(ks[5], (DEPTH, D_R), 0.01),
        'w_rg_a': nrm(ks[6], (DEPTH, N_RG_BLOCKS, RG_BLOCK, RG_BLOCK), RG_BLOCK ** -0.5),
        'b_rg_a': nrm(ks[7], (DEPTH, N_RG_BLOCKS, RG_BLOCK), 0.01),
        'w_rg_x': nrm(ks[8], (DEPTH, N_RG_BLOCKS, RG_BLOCK, RG_BLOCK), RG_BLOCK ** -0.5),
        'b_rg_x': nrm(ks[9], (DEPTH, N_RG_BLOCKS, RG_BLOCK), 0.01),
        'rg_lambda': rg_lambda,
        'w_branch_r': nrm(ks[11], (DEPTH, D_R, D_MODEL), DN_BETA * D_R ** -0.5),
        'w_out': nrm(ks[12], (DEPTH, D_MODEL, D_MODEL), DN_BETA * D_MODEL ** -0.5),
        'ln1_g': 1.0 + nrm(ks[13], (DEPTH, D_MODEL), 0.02),
        'ln1_b': nrm(ks[14], (DEPTH, D_MODEL), 0.02),
        'w_router': nrm(ks[15], (D_MODEL, N_EXPERTS), D_MODEL ** -0.5),
        'b_router': nrm(ks[16], (N_EXPERTS,), 0.01),
        'w_exp_gate': nrm(ks[17], (DEPTH, N_EXPERTS, D_MODEL, D_FF_EXPERT), D_MODEL ** -0.5),
        'w_exp_up': nrm(ks[18], (DEPTH, N_EXPERTS, D_MODEL, D_FF_EXPERT), D_MODEL ** -0.5),
        'w_exp_down': nrm(ks[19], (DEPTH, N_EXPERTS, D_FF_EXPERT, D_MODEL), DN_BETA * D_FF_EXPERT ** -0.5),
        'ln2_g': 1.0 + nrm(ks[20], (DEPTH, D_MODEL), 0.02),
        'ln2_b': nrm(ks[21], (DEPTH, D_MODEL), 0.02),
    }


def reference(x, w_in, conv_a_w, w_branch_a, conv_r_w, conv_r_b, w_rg_a, b_rg_a, w_rg_x, b_rg_x,
              rg_lambda, w_branch_r, w_out, ln1_g, ln1_b, w_router, b_router,
              w_exp_gate, w_exp_up, w_exp_down, ln2_g, ln2_b):
    for l in range(DEPTH):
        z = x @ w_in[l]
        h_a, b_a, c_a, x_r, y_r, g_a, g_r = jnp.split(z, SPLITS, axis=-1)
        ya = (b_a * causal_dwconv(c_a * h_a, conv_a_w[l])) @ w_branch_a[l]
        xc = causal_dwconv(x_r, conv_r_w[l]) + conv_r_b[l]
        r_gate = jax.nn.sigmoid(block_diag(xc, w_rg_a[l], b_rg_a[l]))
        i_gate = jax.nn.sigmoid(block_diag(xc, w_rg_x[l], b_rg_x[l]))
        log_a = -RG_C * r_gate.astype(jnp.float32) * jax.nn.softplus(-rg_lambda[l].astype(jnp.float32))
        a_t = jnp.exp(log_a)
        b_t = jnp.sqrt(-jnp.expm1(2.0 * log_a)) * (i_gate * xc).astype(jnp.float32)
        h_r = linear_recurrence(a_t, b_t).astype(x.dtype)
        yr = (h_r * jax.nn.gelu(y_r)) @ w_branch_r[l]
        merged = jax.nn.sigmoid(g_a) * ya + jax.nn.sigmoid(g_r) * yr
        x = layer_norm(DN_ALPHA * x + merged @ w_out[l], ln1_g[l], ln1_b[l])
        moe = grouped_moe(x, w_router, b_router, w_exp_gate[l], w_exp_up[l], w_exp_down[l])
        x = layer_norm(DN_ALPHA * x + moe, ln2_g[l], ln2_b[l])
    return x
```

```cpp
#include <hip/hip_runtime.h>
#include <cstdio>
#include <cstdint>

#ifndef MK_PER_STEP_LAUNCH
#define MK_PER_STEP_LAUNCH 0
#endif

#define LAS __attribute__((address_space(3)))
typedef unsigned short bf16_t;
typedef short bf16x8 __attribute__((ext_vector_type(8)));
typedef float f32x4 __attribute__((ext_vector_type(4)));
typedef float f32x2 __attribute__((ext_vector_type(2)));
typedef unsigned u32x4 __attribute__((ext_vector_type(4)));
typedef unsigned u32x2 __attribute__((ext_vector_type(2)));

constexpr int D = 1024, T = 16384, SEQ = 4096, NBATCH = 4, DR = 1280, NHEAD = 10, DIN = 7680, NE = 16, FF = 512, DEPTH = 2;
constexpr int NCHUNK = 2, TH = T / NCHUNK;
constexpr int ZC = 5632;
constexpr int GGC = 2048;
constexpr int SCH = 64, NSCH = SEQ / SCH;
constexpr int MOE_ROWS = 36864, MOE_TILES = MOE_ROWS / 256;
constexpr float LN_EPS = 1e-5f;
constexpr float DN_ALPHA = 1.4142135623730951f;

constexpr size_t MiB = 1u << 20;
constexpr size_t WS_CTL = 0, CTL_ZERO_BYTES = 128 * 1024;
constexpr size_t WS_WIN = 1 * MiB;
constexpr size_t WS_WA = 16 * MiB;
constexpr size_t WS_WR = 18 * MiB;
constexpr size_t WS_WO = 21 * MiB;
constexpr size_t WS_WG = 23 * MiB;
constexpr size_t WS_XB = 24 * MiB;
constexpr size_t WS_UA = 56 * MiB;
constexpr size_t WS_UR = 88 * MiB;
constexpr size_t WS_GG = 128 * MiB;
constexpr size_t WS_Z = 192 * MiB;
constexpr size_t WS_XC = 280 * MiB;
constexpr size_t WS_GT = 300 * MiB;
constexpr size_t WS_SMALL = 340 * MiB;
constexpr size_t WS_STASH = 192 * MiB;
constexpr size_t WS_MERGED = 256 * MiB;
constexpr size_t WS_Y = 56 * MiB;
constexpr size_t WS_X1 = 128 * MiB;
constexpr size_t WS_WEX = 192 * MiB;
constexpr size_t WS_XG = 240 * MiB;
constexpr size_t WS_H = 56 * MiB;
constexpr size_t WS_O = 240 * MiB;
constexpr size_t WS_NEED = 344 * MiB + 512 * 1024;
constexpr size_t SM_AEND = 0;
constexpr size_t SM_HEND = SM_AEND + (size_t)NBATCH * NSCH * DR * 4;
constexpr size_t SM_TOKE = SM_HEND + (size_t)NBATCH * NSCH * DR * 4;
constexpr size_t SM_TOKP = SM_TOKE + (size_t)T * 4;
constexpr size_t SM_TOKW = SM_TOKP + (size_t)T * 8;
constexpr size_t SM_ROWINFO = SM_TOKW + (size_t)T * 8;
constexpr size_t SM_END = SM_ROWINFO + (size_t)MOE_ROWS * 4;
static_assert(WS_SMALL + SM_END <= WS_NEED, "small region");
constexpr int CW_BAR = 4096;
constexpr int CW_CNT = 8192;
constexpr int CW_NTILES = 8256;
constexpr int CW_TILEE = 8320;

constexpr int RING_BYTES = 131072;
constexpr int LDSCTL_OFF = RING_BYTES, MISC_OFF = LDSCTL_OFF + 320;
constexpr int LDS_BYTES = 147456;

__device__ __forceinline__ unsigned cvt_pk_bf16(float lo, float hi) { unsigned r; asm volatile("v_cvt_pk_bf16_f32 %0, %1, %2" : "=v"(r) : "v"(lo), "v"(hi)); return r; }
__device__ __forceinline__ float bflo(unsigned w) { return __uint_as_float(w << 16); }
__device__ __forceinline__ float bfhi(unsigned w) { return __uint_as_float(w & 0xffff0000u); }
__device__ __forceinline__ float bf1(bf16_t b) { return __uint_as_float((unsigned)b << 16); }
__device__ __forceinline__ float fsigmoid(float x) { return __fdividef(1.0f, 1.0f + __expf(-x)); }
__device__ __forceinline__ float gelu_tanh(float y) { const float u = 1.5957691216057308f * (y + 0.044715f * y * y * y); return y * fsigmoid(u); }
__device__ __forceinline__ float wave_sum(float v) {
#pragma unroll
    for (int o = 1; o < 64; o <<= 1) v += __shfl_xor(v, o);
    return v;
}
#define LDS_WAIT() asm volatile("s_waitcnt lgkmcnt(0)" ::: "memory")
#define VM_WAIT() asm volatile("s_waitcnt vmcnt(0)" ::: "memory")

namespace pg8 {
constexpr int BM = 256, BK = 64, HALF = 128, HTB = HALF * BK * 2, STAGE_BYTES = 8 * HTB, NXCD = 8, WGM = 8;
__host__ __device__ __forceinline__ int lds_byte(int r, int c) { const int st = (r >> 4) * 2 + (c >> 5), rr = r & 15, cc = c & 31, ob = rr * 64 + cc * 2; return st * 1024 + (ob ^ (((ob >> 9) & 1) << 5)); }
__host__ __device__ __forceinline__ void stage_rc(int b, int& R, int& C) { const int st = b / 1024, sb = b % 1024, swz = sb ^ (((sb >> 9) & 1) << 5); R = (st >> 1) * 16 + swz / 64; C = (st & 1) * 32 + (swz % 64) / 2; }
__host__ __device__ __forceinline__ int perm32(int rho) { const int n = rho >> 4, i = rho & 15; return 8 * (i >> 2) + 4 * n + (i & 3); }

struct Unit { const char* a; const char* b; int pm, pn; };

__device__ __forceinline__ bool static_order(int i, int G, int c, int nM, int nN, int& pm, int& pn) {
    const int nwg = nM * nN; const long L = (long)i * G + c; if (L >= nwg) return false;
    int wgid = (int)L; { const int q = nwg / NXCD, r = nwg % NXCD, xcd = wgid % NXCD, off = wgid / NXCD; wgid = (xcd < r ? xcd * (q + 1) : r * (q + 1) + (xcd - r) * q) + off; }
    const int nig = WGM * nN, gid = wgid / nig, fm = gid * WGM, gsz = (nM - fm) < WGM ? (nM - fm) : WGM;
    pm = fm + ((wgid % nig) % gsz); pn = (wgid % nig) / gsz; return true;
}
struct SchedPlain {
    int nM, nN, G, c; const char* A; const char* B; size_t a_tile, b_tile, a_pn;
    __device__ __forceinline__ bool next(int i, Unit& u) const {
        int pm, pn; if (!static_order(i, G, c, nM, nN, pm, pn)) return false;
        u.pm = pm; u.pn = pn; u.a = A + (size_t)pm * a_tile + (size_t)pn * a_pn; u.b = B + (size_t)pn * b_tile; return true;
    }
};
struct SchedMoe {
    int nM, nN, G, c; const char* A; const char* B; size_t a_tile, b_tile, b_exp; const unsigned* tile_e;
    __device__ __forceinline__ bool next(int i, Unit& u) const {
        int pm, pn; if (!static_order(i, G, c, nM, nN, pm, pn)) return false;
        const int e = __builtin_amdgcn_readfirstlane((int)__hip_atomic_load(tile_e + pm, __ATOMIC_RELAXED, __HIP_MEMORY_SCOPE_AGENT));
        u.pm = pm; u.pn = pn; u.a = A + (size_t)pm * a_tile; u.b = B + (size_t)e * b_exp + (size_t)pn * b_tile; return true;
    }
};

template <class Epi, class Sched, bool ALIGN_EPI>
__device__ __forceinline__ void gemm_phase(LAS unsigned char* lds, const int lda, const int ldb, const int K, const Sched& S, const Epi& E) {
    int tid = threadIdx.x; asm volatile("" : "+v"(tid));
    const int wid = __builtin_amdgcn_readfirstlane(tid >> 6), lane = tid & 63, wr = wid >> 2, wc = wid & 3, fr = lane & 15, fq = lane >> 4;
    int Kop = K; asm volatile("" : "+s"(Kop));
    const int nt = Kop / BK;
    unsigned voffA[2], voffB[2];
#pragma unroll
    for (int i = 0; i < 2; ++i) { int R, C; stage_rc(tid * 16 + i * 8192, R, C); const int Rb = Epi::PERM ? ((R & ~31) + perm32(R & 31)) : R;
        voffA[i] = (unsigned)(R * lda + C) * 2u; voffB[i] = (unsigned)(Rb * ldb + C) * 2u; }
    const size_t kstep = (size_t)(BK * 2);
    const size_t hstepA = (size_t)HALF * lda * 2, hstepB = (size_t)HALF * ldb * 2;
    const unsigned ldsw = (unsigned)wid * 1024u;
    const int aoff = lds_byte(wr * 64 + fr, fq * 8), boff = lds_byte(wc * 32 + fr, fq * 8);
#define PG8_SA(b, h) (((b) * 2 + (h)) * HTB)
#define PG8_SB(b, h) ((4 + (b) * 2 + (h)) * HTB)
#define PG8_STAGE(bufoff, gbase, voff) do { _Pragma("unroll") for (int _i = 0; _i < 2; ++_i) \
        __builtin_amdgcn_global_load_lds((const unsigned*)((const char*)(gbase) + (voff)[_i]), (LAS unsigned*)(lds + (bufoff) + ldsw + _i * 8192), 16, 0, 0); } while (0)
#define PG8_LDA(dst, b, h) do { _Pragma("unroll") for (int m = 0; m < 4; ++m) _Pragma("unroll") for (int k = 0; k < 2; ++k) dst[m][k] = *(const LAS bf16x8*)(lds + PG8_SA(b, h) + aoff + m * 2048 + k * 1024); } while (0)
#define PG8_LDB(dst, b, h) do { _Pragma("unroll") for (int n = 0; n < 2; ++n) _Pragma("unroll") for (int k = 0; k < 2; ++k) dst[n][k] = *(const LAS bf16x8*)(lds + PG8_SB(b, h) + boff + n * 2048 + k * 1024); } while (0)
#define PG8_MMA(ai, bj, At, Bt) do { __builtin_amdgcn_s_setprio(1); _Pragma("unroll") for (int m = 0; m < 4; ++m) _Pragma("unroll") for (int n = 0; n < 2; ++n) _Pragma("unroll") for (int k = 0; k < 2; ++k) \
        acc[ai][bj][m][n] = __builtin_amdgcn_mfma_f32_16x16x32_bf16(Bt[n][k], At[m][k], acc[ai][bj][m][n], 0, 0, 0); __builtin_amdgcn_s_setprio(0); } while (0)
#define PG8_WAIT_V(n) asm volatile("s_waitcnt vmcnt(" #n ")" ::: "memory")
#define PG8_WAIT_L(n) asm volatile("s_waitcnt lgkmcnt(" #n ")" ::: "memory")
#define PG8_BAR __builtin_amdgcn_s_barrier()
#define PG8_SCHED __builtin_amdgcn_sched_barrier(0)
    Unit cur, nxt; int ui = 0;
    if (!S.next(0, cur)) return;
    f32x4 acc[2][2][4][2];
#pragma unroll
    for (int a = 0; a < 2; ++a)
#pragma unroll
        for (int b = 0; b < 2; ++b)
#pragma unroll
            for (int m = 0; m < 4; ++m)
#pragma unroll
                for (int n = 0; n < 2; ++n) acc[a][b][m][n] = (f32x4){0.f, 0.f, 0.f, 0.f};
    bf16x8 At[4][2], B0[2][2], B1[2][2];
    const char* cA = cur.a; const char* cB = cur.b;
    PG8_STAGE(PG8_SB(0, 0), cB, voffB); PG8_STAGE(PG8_SB(0, 1), cB + hstepB, voffB); PG8_STAGE(PG8_SA(0, 0), cA, voffA); PG8_STAGE(PG8_SA(0, 1), cA + hstepA, voffA);
    if (wr == 1) PG8_BAR;
    PG8_WAIT_V(2); PG8_BAR;
    PG8_STAGE(PG8_SB(1, 0), cB + kstep, voffB); PG8_STAGE(PG8_SA(1, 0), cA + kstep, voffA); PG8_STAGE(PG8_SB(1, 1), cB + hstepB + kstep, voffB);
    PG8_WAIT_V(6); PG8_BAR;
    for (;;) {
        const bool has_next = S.next(ui + 1, nxt);
        const char* nA = has_next ? nxt.a : cA; const char* nB = has_next ? nxt.b : cB;
        for (int t = 0; t < nt; t += 2) {
            const bool last = (t == nt - 2);
            const char* a1 = cA + (size_t)(t + 1) * kstep;
            const char* a2 = last ? nA : cA + (size_t)(t + 2) * kstep; const char* b2 = last ? nB : cB + (size_t)(t + 2) * kstep;
            const char* a3 = a2 + kstep; const char* b3 = b2 + kstep;
            PG8_LDB(B0, 0, 0); PG8_LDB(B1, 0, 1); PG8_SCHED; PG8_LDA(At, 0, 0); PG8_STAGE(PG8_SA(1, 1), a1 + hstepA, voffA);
            PG8_WAIT_V(8); PG8_WAIT_L(0); PG8_BAR; PG8_MMA(0, 0, At, B0); PG8_MMA(0, 1, At, B1); PG8_BAR; PG8_SCHED;
            PG8_LDA(At, 0, 1); PG8_STAGE(PG8_SB(0, 0), b2, voffB); PG8_STAGE(PG8_SB(0, 1), b2 + hstepB, voffB); PG8_STAGE(PG8_SA(0, 0), a2, voffA);
            PG8_WAIT_V(8); PG8_WAIT_L(0); PG8_BAR; PG8_MMA(1, 0, At, B0); PG8_MMA(1, 1, At, B1); PG8_BAR; PG8_SCHED;
            PG8_LDB(B0, 1, 0); PG8_LDB(B1, 1, 1); PG8_SCHED; PG8_LDA(At, 1, 0); PG8_STAGE(PG8_SA(0, 1), a2 + hstepA, voffA);
            PG8_WAIT_V(8); PG8_WAIT_L(0); PG8_BAR; PG8_MMA(0, 0, At, B0); PG8_MMA(0, 1, At, B1); PG8_BAR; PG8_SCHED;
            PG8_LDA(At, 1, 1); PG8_STAGE(PG8_SB(1, 0), b3, voffB); PG8_STAGE(PG8_SB(1, 1), b3 + hstepB, voffB); PG8_STAGE(PG8_SA(1, 0), a3, voffA);
            PG8_WAIT_V(8); PG8_WAIT_L(0); PG8_BAR; PG8_MMA(1, 0, At, B0); PG8_MMA(1, 1, At, B1); PG8_BAR; PG8_SCHED;
        }
        if constexpr (ALIGN_EPI) { if (wr == 0) PG8_BAR; }
        E(acc, cur, wr, wc, fr, fq);
        if (!has_next) break;
#pragma unroll
        for (int a = 0; a < 2; ++a)
#pragma unroll
            for (int b = 0; b < 2; ++b)
#pragma unroll
                for (int m = 0; m < 4; ++m)
#pragma unroll
                    for (int n = 0; n < 2; ++n) acc[a][b][m][n] = (f32x4){0.f, 0.f, 0.f, 0.f};
        cur = nxt; cA = nA; cB = nB; ++ui;
        if constexpr (ALIGN_EPI) { if (wr == 1) PG8_BAR; }
    }
    PG8_WAIT_V(0);
    if constexpr (!ALIGN_EPI) { if (wr == 0) PG8_BAR; }
    PG8_BAR;
#undef PG8_SA
#undef PG8_SB
#undef PG8_STAGE
#undef PG8_LDA
#undef PG8_LDB
#undef PG8_MMA
#undef PG8_WAIT_V
#undef PG8_WAIT_L
#undef PG8_BAR
#undef PG8_SCHED
}

typedef const f32x4 (&AccRef)[2][2][4][2];
#define EPI_LOOP_ROWS for (int ai = 0; ai < 2; ++ai) _Pragma("unroll") for (int m = 0; m < 4; ++m)

struct EpiZ {
    static constexpr bool PERM = true;
    bf16_t* Z; bf16_t* GG; int row_base;
    __device__ __forceinline__ void operator()(AccRef acc, const Unit& u, int wr, int wc, int fr, int fq) const {
        const int row0 = u.pm * BM + wr * 64 + fr; const int colt = u.pn * BM + wc * 32 + 8 * fq;
        bf16_t* base; size_t ldc;
        if (u.pn < 22) { base = Z + colt; ldc = ZC; } else { base = GG + (size_t)row_base * GGC + (colt - ZC); ldc = GGC; }
#pragma unroll
        EPI_LOOP_ROWS { bf16_t* rowp = base + (size_t)(row0 + ai * HALF + m * 16) * ldc;
#pragma unroll
            for (int bj = 0; bj < 2; ++bj) { const f32x4 v0 = acc[ai][bj][m][0], v1 = acc[ai][bj][m][1];
                u32x4 w; w.x = cvt_pk_bf16(v0[0], v0[1]); w.y = cvt_pk_bf16(v0[2], v0[3]); w.z = cvt_pk_bf16(v1[0], v1[1]); w.w = cvt_pk_bf16(v1[2], v1[3]);
                *(u32x4*)(rowp + bj * HALF) = w; } }
    }
};
struct EpiBf16 {
    static constexpr bool PERM = true;
    bf16_t* O; int ldc;
    __device__ __forceinline__ void operator()(AccRef acc, const Unit& u, int wr, int wc, int fr, int fq) const {
        const int row0 = u.pm * BM + wr * 64 + fr; const int colt = u.pn * BM + wc * 32 + 8 * fq;
#pragma unroll
        EPI_LOOP_ROWS { bf16_t* rowp = O + (size_t)(row0 + ai * HALF + m * 16) * ldc + colt;
#pragma unroll
            for (int bj = 0; bj < 2; ++bj) { const f32x4 v0 = acc[ai][bj][m][0], v1 = acc[ai][bj][m][1];
                u32x4 w; w.x = cvt_pk_bf16(v0[0], v0[1]); w.y = cvt_pk_bf16(v0[2], v0[3]); w.z = cvt_pk_bf16(v1[0], v1[1]); w.w = cvt_pk_bf16(v1[2], v1[3]);
                *(u32x4*)(rowp + bj * HALF) = w; } }
    }
};
struct EpiYa {
    static constexpr bool PERM = false;
    float* ST; const bf16_t* GG;
    __device__ __forceinline__ void operator()(AccRef acc, const Unit& u, int wr, int wc, int fr, int fq) const {
        const int row0 = u.pm * BM + wr * 64 + fr, col0 = u.pn * BM + wc * 32 + 4 * fq;
#pragma unroll
        EPI_LOOP_ROWS { const size_t r = (size_t)(row0 + ai * HALF + m * 16);
#pragma unroll
            for (int bj = 0; bj < 2; ++bj)
#pragma unroll
                for (int n = 0; n < 2; ++n) { const int c = col0 + bj * HALF + n * 16; const u32x2 g = *(const u32x2*)(GG + r * GGC + c); const f32x4 a = acc[ai][bj][m][n];
                    f32x4 o; o[0] = fsigmoid(bflo(g.x)) * a[0]; o[1] = fsigmoid(bfhi(g.x)) * a[1]; o[2] = fsigmoid(bflo(g.y)) * a[2]; o[3] = fsigmoid(bfhi(g.y)) * a[3];
                    *(f32x4*)(ST + r * D + c) = o; }
            asm volatile("" ::: "memory"); }
    }
};
struct EpiMerged {
    static constexpr bool PERM = true;
    const float* ST; const bf16_t* GG; bf16_t* MG;
    __device__ __forceinline__ void operator()(AccRef acc, const Unit& u, int wr, int wc, int fr, int fq) const {
        const int row0 = u.pm * BM + wr * 64 + fr; const int colt = u.pn * BM + wc * 32 + 8 * fq;
#pragma unroll
        EPI_LOOP_ROWS { const size_t r = (size_t)(row0 + ai * HALF + m * 16);
#pragma unroll
            for (int bj = 0; bj < 2; ++bj) { const int c = colt + bj * HALF;
                const f32x4 s0 = *(const f32x4*)(ST + r * D + c), s1 = *(const f32x4*)(ST + r * D + c + 4); const u32x4 g = *(const u32x4*)(GG + r * GGC + D + c);
                const f32x4 v0 = acc[ai][bj][m][0], v1 = acc[ai][bj][m][1];
                u32x4 w; w.x = cvt_pk_bf16(s0[0] + fsigmoid(bflo(g.x)) * v0[0], s0[1] + fsigmoid(bfhi(g.x)) * v0[1]);
                w.y = cvt_pk_bf16(s0[2] + fsigmoid(bflo(g.y)) * v0[2], s0[3] + fsigmoid(bfhi(g.y)) * v0[3]);
                w.z = cvt_pk_bf16(s1[0] + fsigmoid(bflo(g.z)) * v1[0], s1[1] + fsigmoid(bfhi(g.z)) * v1[1]);
                w.w = cvt_pk_bf16(s1[2] + fsigmoid(bflo(g.w)) * v1[2], s1[3] + fsigmoid(bfhi(g.w)) * v1[3]);
                *(u32x4*)(MG + r * D + c) = w; }
            asm volatile("" ::: "memory"); }
    }
};
struct EpiY {
    static constexpr bool PERM = false;
    const float* X0; float* Y;
    __device__ __forceinline__ void operator()(AccRef acc, const Unit& u, int wr, int wc, int fr, int fq) const {
        const int row0 = u.pm * BM + wr * 64 + fr, col0 = u.pn * BM + wc * 32 + 4 * fq;
#pragma unroll
        EPI_LOOP_ROWS { const size_t r = (size_t)(row0 + ai * HALF + m * 16);
#pragma unroll
            for (int bj = 0; bj < 2; ++bj)
#pragma unroll
                for (int n = 0; n < 2; ++n) { const int c = col0 + bj * HALF + n * 16; const f32x4 x = *(const f32x4*)(X0 + r * D + c);
                    *(f32x4*)(Y + r * D + c) = x * DN_ALPHA + acc[ai][bj][m][n]; }
            asm volatile("" ::: "memory"); }
    }
};
struct EpiH {
    static constexpr bool PERM = true;
    bf16_t* H;
    __device__ __forceinline__ void operator()(AccRef acc, const Unit& u, int wr, int wc, int fr, int fq) const {
        const int row0 = u.pm * BM + wr * 64 + fr; const int col = u.pn * HALF + wc * 32 + 8 * fq;
#pragma unroll
        EPI_LOOP_ROWS { const size_t r = (size_t)(row0 + ai * HALF + m * 16);
            const f32x4 g0 = acc[ai][0][m][0], g1 = acc[ai][0][m][1], u0 = acc[ai][1][m][0], u1 = acc[ai][1][m][1];
            u32x4 w;
            w.x = cvt_pk_bf16(g0[0] * fsigmoid(g0[0]) * u0[0], g0[1] * fsigmoid(g0[1]) * u0[1]);
            w.y = cvt_pk_bf16(g0[2] * fsigmoid(g0[2]) * u0[2], g0[3] * fsigmoid(g0[3]) * u0[3]);
            w.z = cvt_pk_bf16(g1[0] * fsigmoid(g1[0]) * u1[0], g1[1] * fsigmoid(g1[1]) * u1[1]);
            w.w = cvt_pk_bf16(g1[2] * fsigmoid(g1[2]) * u1[2], g1[3] * fsigmoid(g1[3]) * u1[3]);
            *(u32x4*)(H + r * FF + col) = w; }
    }
};
struct EpiO {
    static constexpr bool PERM = true;
    bf16_t* O; const int* rowinfo;
    __device__ __forceinline__ void operator()(AccRef acc, const Unit& u, int wr, int wc, int fr, int fq) const {
        const int row0 = u.pm * BM + wr * 64 + fr; const int colt = u.pn * BM + wc * 32 + 8 * fq;
#pragma unroll
        EPI_LOOP_ROWS { const int dst = rowinfo[row0 + ai * HALF + m * 16];
            if (dst >= 0) { bf16_t* rowp = O + (size_t)dst * D + colt;
#pragma unroll
                for (int bj = 0; bj < 2; ++bj) { const f32x4 v0 = acc[ai][bj][m][0], v1 = acc[ai][bj][m][1];
                    u32x4 w; w.x = cvt_pk_bf16(v0[0], v0[1]); w.y = cvt_pk_bf16(v0[2], v0[3]); w.z = cvt_pk_bf16(v1[0], v1[1]); w.w = cvt_pk_bf16(v1[2], v1[3]);
                    *(u32x4*)(rowp + bj * HALF) = w; } } }
    }
};
}

#define XB_TMO      128
#define XB_XCNT(j)  (256  + 64 * (j))
#define XB_XSUB(j)  (1280 + 64 * (j))
#define XB_XGEN(j)  (2304 + 64 * (j))
#define XB_TOP      3328
#define XB_TOPGEN   3392
#define XCD_BAR_WORDS 3456
#define XB_SPIN_CAP (1u << 18)
__device__ __forceinline__ unsigned xb_ld(unsigned* p)              { return __hip_atomic_load(p, __ATOMIC_RELAXED, __HIP_MEMORY_SCOPE_AGENT); }
__device__ __forceinline__ unsigned xb_add(unsigned* p, unsigned v) { return __hip_atomic_fetch_add(p, v, __ATOMIC_RELAXED, __HIP_MEMORY_SCOPE_AGENT); }
__device__ __forceinline__ unsigned xb_xcc_id() { return (unsigned)__builtin_amdgcn_s_getreg((3 << 11) | 20) & 0xFu; }
#define XB_SPIN(cond, bar) do { unsigned _sp = 0; while (cond) { __builtin_amdgcn_s_sleep(1); \
    if ((++_sp & 255u) == 0u) { if (xb_ld(&(bar)[XB_TMO])) break; if (_sp > XB_SPIN_CAP) { atomicAdd(&(bar)[XB_TMO], 1u); break; } } } } while (0)
struct XcdBarrier { unsigned* bar; unsigned x; volatile LAS unsigned* st; };
__device__ __forceinline__ XcdBarrier xcd_barrier_post(unsigned* bar, volatile LAS unsigned* st) {
    XcdBarrier b; b.bar = bar; b.x = xb_xcc_id(); b.st = st;
    if (threadIdx.x == 0) (void)xb_add(&bar[XB_XCNT(b.x)], 1u);
    return b;
}
__device__ __forceinline__ void xcd_barrier_complete(unsigned* bar, unsigned x, unsigned& nloc, unsigned& nx) {
    const unsigned G = gridDim.x * gridDim.y * gridDim.z;
    unsigned sum, cnt, mine, sp = 0u;
    for (;;) {
        sum = 0u; cnt = 0u; mine = 0u;
#pragma unroll
        for (unsigned j = 0; j < 16; ++j) { const unsigned c = xb_ld(&bar[XB_XCNT(j)]); sum += c; cnt += (c > 0u) ? 1u : 0u; mine = (j == x) ? c : mine; }
        if (sum == G) break;
        __builtin_amdgcn_s_sleep(1);
        if ((++sp & 255u) == 0u) { if (xb_ld(&bar[XB_TMO])) break; if (sp > XB_SPIN_CAP) { atomicAdd(&bar[XB_TMO], 1u); break; } }
    }
    nloc = mine > 0u ? mine : 1u; nx = cnt > 0u ? cnt : 1u;
}
__device__ __forceinline__ void xcd_barrier(const XcdBarrier& b) {
    asm volatile("s_waitcnt vmcnt(0)" ::: "memory");
    __syncthreads();
    if (threadIdx.x == 0) {
        unsigned* bar = b.bar;
        __builtin_amdgcn_s_waitcnt(0);
        unsigned nloc = b.st[0], nx = b.st[1];
        if (nloc == 0u) { xcd_barrier_complete(bar, b.x, nloc, nx); b.st[0] = nloc; b.st[1] = nx; }
        const unsigned old = xb_add(&bar[XB_XSUB(b.x)], 1u);
        const unsigned gen = old / nloc;
        if (old + 1u == (gen + 1u) * nloc) {
            __builtin_amdgcn_fence(__ATOMIC_RELEASE, "agent");
            asm volatile("s_waitcnt vmcnt(0)" ::: "memory");
            const unsigned og = xb_add(&bar[XB_TOP], 1u);
            const unsigned tg = og / nx;
            if (og + 1u == (tg + 1u) * nx) xb_add(&bar[XB_TOPGEN], 1u);
            else XB_SPIN(xb_ld(&bar[XB_TOPGEN]) == tg, bar);
            __builtin_amdgcn_fence(__ATOMIC_ACQUIRE, "agent");
            xb_add(&bar[XB_XGEN(b.x)], 1u);
            asm volatile("s_waitcnt vmcnt(0)" ::: "memory");
        } else {
            XB_SPIN(xb_ld(&bar[XB_XGEN(b.x)]) == gen, bar);
            __builtin_amdgcn_fence(__ATOMIC_ACQUIRE, "agent");
            asm volatile("s_waitcnt vmcnt(0)" ::: "memory");
        }
    }
    __syncthreads();
}

struct Args {
    const float* x; const float* w_in; const float* conv_a_w; const float* w_branch_a; const float* conv_r_w; const float* conv_r_b;
    const float* w_rg_a; const float* b_rg_a; const float* w_rg_x; const float* b_rg_x; const float* rg_lambda; const float* w_branch_r; const float* w_out;
    const float* ln1_g; const float* ln1_b; const float* w_router; const float* b_router; const float* w_exp_gate; const float* w_exp_up; const float* w_exp_down;
    const float* ln2_g; const float* ln2_b;
    float* out; unsigned char* ws; int ph_lo, ph_hi;
};

typedef const Args __attribute__((address_space(4)))* ArgsP;

__device__ __forceinline__ void transpose_item(const float* W, int N, int k0, int n0, bf16_t* WT, int ldk, int drow0, LAS float* scr, int lane) {
#pragma unroll 8
    for (int i = 0; i < 32; ++i) { const int kk = 2 * i + (lane >> 5); scr[kk * 33 + (lane & 31)] = W[(size_t)(k0 + kk) * N + n0 + (lane & 31)]; }
    LDS_WAIT(); asm volatile("" ::: "memory");
    const int c = lane & 7;
#pragma unroll
    for (int j = 0; j < 4; ++j) { const int n = (lane >> 3) + 8 * j; const LAS float* s = scr + (8 * c) * 33 + n;
        u32x4 o; o.x = cvt_pk_bf16(s[0 * 33], s[1 * 33]); o.y = cvt_pk_bf16(s[2 * 33], s[3 * 33]); o.z = cvt_pk_bf16(s[4 * 33], s[5 * 33]); o.w = cvt_pk_bf16(s[6 * 33], s[7 * 33]);
        *(u32x4*)(WT + (size_t)(drow0 + n) * ldk + k0 + 8 * c) = o; }
    LDS_WAIT(); asm volatile("" ::: "memory");
}
__device__ __forceinline__ void transpose_plain(const float* W, int K, int N, bf16_t* WT, int item, LAS float* scr, int lane) {
    const int nblk = N / 32, kb = item / nblk, nb = item % nblk;
    transpose_item(W, N, 64 * kb, 32 * nb, WT, K, 32 * nb, scr, lane);
}

__device__ __forceinline__ void prep_tm_weights(ArgsP a, int l, unsigned char* ws, LAS float* scr, int gw, int NGW, int lane) {
    constexpr int I_IN = (D / 64) * (DIN / 32), I_A = (D / 64) * (D / 32), I_R = (DR / 64) * (D / 32), I_O = I_A, I_G = 2 * NHEAD * 2 * 4;
    constexpr int NITEMS = I_IN + I_A + I_R + I_O + I_G;
    for (int it = gw; it < NITEMS; it += NGW) {
        int r = it;
        if (r < I_IN) { transpose_plain(a->w_in + (size_t)l * D * DIN, D, DIN, (bf16_t*)(ws + WS_WIN), r, scr, lane); continue; } r -= I_IN;
        if (r < I_A) { transpose_plain(a->w_branch_a + (size_t)l * D * D, D, D, (bf16_t*)(ws + WS_WA), r, scr, lane); continue; } r -= I_A;
        if (r < I_R) { transpose_plain(a->w_branch_r + (size_t)l * DR * D, DR, D, (bf16_t*)(ws + WS_WR), r, scr, lane); continue; } r -= I_R;
        if (r < I_O) { transpose_plain(a->w_out + (size_t)l * D * D, D, D, (bf16_t*)(ws + WS_WO), r, scr, lane); continue; } r -= I_O;
        {
            const int nb = r & 3, kb = (r >> 2) & 1, hw = r >> 3, which = hw & 1, hh = hw >> 1;
            const float* W = (which ? a->w_rg_x : a->w_rg_a) + ((size_t)l * NHEAD + hh) * 128 * 128;
            transpose_item(W, 128, 64 * kb, 32 * nb, (bf16_t*)(ws + WS_WG), 128, hh * 256 + which * 128 + 32 * nb, scr, lane);
        }
    }
}
__device__ __forceinline__ void prep_expert_weights(ArgsP a, int l, unsigned char* ws, LAS float* scr, int gw, int NGW, int lane) {
    constexpr int I_G = (D / 64) * (FF / 32), I_D = (FF / 64) * (D / 32), PER_E = 2 * I_G + I_D;
    bf16_t* WGU = (bf16_t*)(ws + WS_WEX); bf16_t* WDN = WGU + (size_t)NE * 1024 * 1024;
    for (int it = gw; it < NE * PER_E; it += NGW) {
        const int e = it / PER_E; int r = it % PER_E;
        if (r < 2 * I_G) { const int which = r / I_G; r %= I_G; const int nblk = FF / 32, kb = r / nblk, nb = r % nblk, n0 = 32 * nb;
            const float* W = (which ? a->w_exp_up : a->w_exp_gate) + ((size_t)l * NE + e) * D * FF;
            const int drow0 = (n0 >> 7) * 256 + which * 128 + (n0 & 127);
            transpose_item(W, FF, 64 * kb, n0, WGU + (size_t)e * 1024 * 1024, D, drow0, scr, lane);
        } else { r -= 2 * I_G; const float* W = a->w_exp_down + ((size_t)l * NE + e) * FF * D;
            transpose_plain(W, FF, D, WDN + (size_t)e * 1024 * 512, r, scr, lane); }
    }
}
__device__ __forceinline__ void cvt_x(const float* x, bf16_t* xb, int gtid, int nthr) {
    for (size_t i = gtid; i < (size_t)T * D / 8; i += nthr) { const f32x4 a = *(const f32x4*)(x + i * 8), b = *(const f32x4*)(x + i * 8 + 4);
        u32x4 w; w.x = cvt_pk_bf16(a[0], a[1]); w.y = cvt_pk_bf16(a[2], a[3]); w.z = cvt_pk_bf16(b[0], b[1]); w.w = cvt_pk_bf16(b[2], b[3]); *(u32x4*)(xb + i * 8) = w; }
}
__device__ __forceinline__ void unpack8(const u32x4 w, float (&f)[8]) { f[0] = bflo(w.x); f[1] = bfhi(w.x); f[2] = bflo(w.y); f[3] = bfhi(w.y); f[4] = bflo(w.z); f[5] = bfhi(w.z); f[6] = bflo(w.w); f[7] = bfhi(w.w); }
__device__ __forceinline__ u32x4 pack8(const float (&f)[8]) { u32x4 w; w.x = cvt_pk_bf16(f[0], f[1]); w.y = cvt_pk_bf16(f[2], f[3]); w.z = cvt_pk_bf16(f[4], f[5]); w.w = cvt_pk_bf16(f[6], f[7]); return w; }

__device__ __forceinline__ void phase_e1(ArgsP a, int l, int half, unsigned char* ws, int gtid, int nthr) {
    const bf16_t* Z = (const bf16_t*)(ws + WS_Z); bf16_t* UA = (bf16_t*)(ws + WS_UA) + (size_t)half * TH * D; bf16_t* XC = (bf16_t*)(ws + WS_XC);
    constexpr int RUN = 8;
    constexpr int NA = (TH / RUN) * (D / 8), NR = (TH / RUN) * (DR / 8);
    for (int it = gtid; it < NA + NR; it += nthr) {
        if (it < NA) {
            const int cg = it % (D / 8), run = it / (D / 8), t0 = run * RUN, c0 = cg * 8;
            float w0[8], w1[8], w2[8];
            { const float* cw = a->conv_a_w + (size_t)l * 3 * D + c0;
#pragma unroll
              for (int j = 0; j < 8; ++j) { w0[j] = cw[j]; w1[j] = cw[D + j]; w2[j] = cw[2 * D + j]; } }
            float vm2[8], vm1[8];
            if ((t0 & (SEQ - 1)) == 0) {
#pragma unroll
                for (int j = 0; j < 8; ++j) { vm2[j] = 0.f; vm1[j] = 0.f; }
            } else {
                float h2[8], c2[8], h1[8], c1[8];
                unpack8(*(const u32x4*)(Z + (size_t)(t0 - 2) * ZC + c0), h2); unpack8(*(const u32x4*)(Z + (size_t)(t0 - 2) * ZC + 2 * D + c0), c2);
                unpack8(*(const u32x4*)(Z + (size_t)(t0 - 1) * ZC + c0), h1); unpack8(*(const u32x4*)(Z + (size_t)(t0 - 1) * ZC + 2 * D + c0), c1);
#pragma unroll
                for (int j = 0; j < 8; ++j) { vm2[j] = c2[j] * h2[j]; vm1[j] = c1[j] * h1[j]; }
            }
#pragma unroll
            for (int i = 0; i < RUN; ++i) { const size_t t = (size_t)(t0 + i);
                float hh[8], bb[8], cc[8], o[8];
                unpack8(*(const u32x4*)(Z + t * ZC + c0), hh); unpack8(*(const u32x4*)(Z + t * ZC + D + c0), bb); unpack8(*(const u32x4*)(Z + t * ZC + 2 * D + c0), cc);
#pragma unroll
                for (int j = 0; j < 8; ++j) { const float v = cc[j] * hh[j]; o[j] = bb[j] * (w0[j] * vm2[j] + w1[j] * vm1[j] + w2[j] * v); vm2[j] = vm1[j]; vm1[j] = v; }
                *(u32x4*)(UA + t * D + c0) = pack8(o); }
        } else {
            const int r = it - NA; const int cg = r % (DR / 8), run = r / (DR / 8), t0 = run * RUN, c0 = cg * 8;
            float w0[8], w1[8], w2[8], w3[8], bi[8];
            { const float* cw = a->conv_r_w + (size_t)l * 4 * DR + c0; const float* cb = a->conv_r_b + (size_t)l * DR + c0;
#pragma unroll
              for (int j = 0; j < 8; ++j) { w0[j] = cw[j]; w1[j] = cw[DR + j]; w2[j] = cw[2 * DR + j]; w3[j] = cw[3 * DR + j]; bi[j] = cb[j]; } }
            float x3[8], x2[8], x1[8];
            if ((t0 & (SEQ - 1)) == 0) {
#pragma unroll
                for (int j = 0; j < 8; ++j) { x3[j] = 0.f; x2[j] = 0.f; x1[j] = 0.f; }
            } else {
                unpack8(*(const u32x4*)(Z + (size_t)(t0 - 3) * ZC + 3 * D + c0), x3); unpack8(*(const u32x4*)(Z + (size_t)(t0 - 2) * ZC + 3 * D + c0), x2);
                unpack8(*(const u32x4*)(Z + (size_t)(t0 - 1) * ZC + 3 * D + c0), x1);
            }
#pragma unroll
            for (int i = 0; i < RUN; ++i) { const size_t t = (size_t)(t0 + i);
                float x0[8], o[8]; unpack8(*(const u32x4*)(Z + t * ZC + 3 * D + c0), x0);
#pragma unroll
                for (int j = 0; j < 8; ++j) { o[j] = w0[j] * x3[j] + w1[j] * x2[j] + w2[j] * x1[j] + w3[j] * x0[j] + bi[j]; x3[j] = x2[j]; x2[j] = x1[j]; x1[j] = x0[j]; }
                *(u32x4*)(XC + t * DR + c0) = pack8(o); }
        }
    }
}

__device__ __forceinline__ void rg_elem(float rp, float ip, float xc, float c8, float ba, float bx, float& av, float& bv) {
    const float la = -c8 * fsigmoid(rp + ba);
    av = __expf(la);
    const float x = 2.0f * la;
    float em = -x * (1.0f + x * (0.5f + x * (0.16666667f + x * (0.041666668f + x * (0.0083333338f + x * 0.0013888889f)))));
    if (x < -0.4f) em = 1.0f - __expf(x);
    bv = sqrtf(em) * fsigmoid(ip + bx) * xc;
}
template <bool FINAL>
__device__ __forceinline__ void phase_scan(ArgsP a, int l, int half, unsigned char* ws, int gtid, int nthr) {
    const bf16_t* GT = (const bf16_t*)(ws + WS_GT); const bf16_t* XC = (const bf16_t*)(ws + WS_XC); const bf16_t* Z = (const bf16_t*)(ws + WS_Z);
    float* AEND = (float*)(ws + WS_SMALL + SM_AEND); float* HEND = (float*)(ws + WS_SMALL + SM_HEND);
    bf16_t* UR = (bf16_t*)(ws + WS_UR) + (size_t)half * TH * DR;
    constexpr int NP = DR / 2, NITEMS = (TH / SEQ) * NSCH * NP;
    for (int it = gtid; it < NITEMS; it += nthr) {
        const int cp = it % NP, j = (it / NP) % NSCH, bl = it / (NP * NSCH), c = 2 * cp, hh = c >> 7, cc = c & 127, b = half * (TH / SEQ) + bl;
        const float lam0 = a->rg_lambda[(size_t)l * DR + c], lam1 = a->rg_lambda[(size_t)l * DR + c + 1];
        const float c80 = 8.0f * log1pf(__expf(-lam0)), c81 = 8.0f * log1pf(__expf(-lam1));
        const float ba0 = a->b_rg_a[(size_t)l * DR + c], ba1 = a->b_rg_a[(size_t)l * DR + c + 1], bx0 = a->b_rg_x[(size_t)l * DR + c], bx1 = a->b_rg_x[(size_t)l * DR + c + 1];
        float h0 = 0.f, h1 = 0.f, A0 = 1.f, A1 = 1.f;
        if (FINAL) {
            for (int jj = 0; jj < j; ++jj) { const size_t si = ((size_t)b * NSCH + jj) * DR + c; const f32x2 ae = *(const f32x2*)(AEND + si), he = *(const f32x2*)(HEND + si);
                h0 = ae.x * h0 + he.x; h1 = ae.y * h1 + he.y; }
        }
        const size_t row0 = (size_t)bl * SEQ + (size_t)j * SCH;
#pragma unroll 4
        for (int tt = 0; tt < SCH; ++tt) { const size_t row = row0 + tt;
            const unsigned rp = *(const unsigned*)(GT + row * 2560 + hh * 256 + cc), ip = *(const unsigned*)(GT + row * 2560 + hh * 256 + 128 + cc), xc = *(const unsigned*)(XC + row * DR + c);
            float a0, b0, a1, b1; rg_elem(bflo(rp), bflo(ip), bflo(xc), c80, ba0, bx0, a0, b0); rg_elem(bfhi(rp), bfhi(ip), bfhi(xc), c81, ba1, bx1, a1, b1);
            h0 = a0 * h0 + b0; h1 = a1 * h1 + b1;
            if (FINAL) { const unsigned yr = *(const unsigned*)(Z + row * ZC + 3 * D + DR + c);
                *(unsigned*)(UR + row * DR + c) = cvt_pk_bf16(h0 * gelu_tanh(bflo(yr)), h1 * gelu_tanh(bfhi(yr))); }
            else { A0 *= a0; A1 *= a1; }
        }
        if (!FINAL) { const size_t si = ((size_t)b * NSCH + j) * DR + c; *(f32x2*)(AEND + si) = (f32x2){A0, A1}; *(f32x2*)(HEND + si) = (f32x2){h0, h1}; }
    }
}

__device__ __forceinline__ void phase_ln1_router(ArgsP a, int l, unsigned char* ws, LAS unsigned char* lds, int tid, int lane, int gw, int NGW) {
    LAS f32x4* wl = (LAS f32x4*)lds;
    for (int idx = tid; idx < 4096; idx += 512) { const int ln = idx & 63, q = (idx >> 6) & 3, jk = idx >> 8, d = 4 * ln + 256 * (jk >> 2) + (jk & 3);
        wl[idx] = *(const f32x4*)(a->w_router + (size_t)d * NE + 4 * q); }
    __syncthreads();
    const float* Y = (const float*)(ws + WS_Y); float* X1 = (float*)(ws + WS_X1); bf16_t* XB = (bf16_t*)(ws + WS_XB);
    unsigned* ctl = (unsigned*)(ws + WS_CTL);
    unsigned* TOKE = (unsigned*)(ws + WS_SMALL + SM_TOKE); unsigned* TOKP = (unsigned*)(ws + WS_SMALL + SM_TOKP); float* TOKW = (float*)(ws + WS_SMALL + SM_TOKW);
    f32x4 gv[4], bv[4];
#pragma unroll
    for (int j = 0; j < 4; ++j) { gv[j] = *(const f32x4*)(a->ln1_g + (size_t)l * D + 4 * lane + 256 * j); bv[j] = *(const f32x4*)(a->ln1_b + (size_t)l * D + 4 * lane + 256 * j); }
    float br[16];
#pragma unroll
    for (int e = 0; e < 16; ++e) br[e] = a->b_router[e];
    for (int t = gw; t < T; t += NGW) {
        f32x4 v[4]; float s = 0.f;
#pragma unroll
        for (int j = 0; j < 4; ++j) { v[j] = *(const f32x4*)(Y + (size_t)t * D + 4 * lane + 256 * j); s += (v[j][0] + v[j][1]) + (v[j][2] + v[j][3]); }
        const float mean = wave_sum(s) * (1.f / D); float s2 = 0.f;
#pragma unroll
        for (int j = 0; j < 4; ++j) { v[j] = v[j] - mean; s2 += (v[j][0] * v[j][0] + v[j][1] * v[j][1]) + (v[j][2] * v[j][2] + v[j][3] * v[j][3]); }
        const float rstd = 1.f / sqrtf(wave_sum(s2) * (1.f / D) + LN_EPS);
        float acc[16];
#pragma unroll
        for (int e = 0; e < 16; ++e) acc[e] = 0.f;
#pragma unroll
        for (int j = 0; j < 4; ++j) { v[j] = v[j] * rstd * gv[j] + bv[j];
            *(f32x4*)(X1 + (size_t)t * D + 4 * lane + 256 * j) = v[j];
            u32x2 w; w.x = cvt_pk_bf16(v[j][0], v[j][1]); w.y = cvt_pk_bf16(v[j][2], v[j][3]); *(u32x2*)(XB + (size_t)t * D + 4 * lane + 256 * j) = w;
#pragma unroll
            for (int k = 0; k < 4; ++k) { const float xv = v[j][k];
#pragma unroll
                for (int q = 0; q < 4; ++q) { const f32x4 w4 = wl[((j * 4 + k) * 4 + q) * 64 + lane]; acc[4 * q] += xv * w4[0]; acc[4 * q + 1] += xv * w4[1]; acc[4 * q + 2] += xv * w4[2]; acc[4 * q + 3] += xv * w4[3]; } } }
        float r8[8], r4[4], r2[2], r1;
        { const bool hi = (lane & 32) != 0;
#pragma unroll
          for (int i = 0; i < 8; ++i) { const float keep = hi ? acc[i + 8] : acc[i], send = hi ? acc[i] : acc[i + 8]; r8[i] = keep + __shfl_xor(send, 32); } }
        { const bool hi = (lane & 16) != 0;
#pragma unroll
          for (int i = 0; i < 4; ++i) { const float keep = hi ? r8[i + 4] : r8[i], send = hi ? r8[i] : r8[i + 4]; r4[i] = keep + __shfl_xor(send, 16); } }
        { const bool hi = (lane & 8) != 0;
#pragma unroll
          for (int i = 0; i < 2; ++i) { const float keep = hi ? r4[i + 2] : r4[i], send = hi ? r4[i] : r4[i + 2]; r2[i] = keep + __shfl_xor(send, 8); } }
        { const bool hi = (lane & 4) != 0; const float keep = hi ? r2[1] : r2[0], send = hi ? r2[0] : r2[1]; r1 = keep + __shfl_xor(send, 4); }
        r1 += __shfl_xor(r1, 2); r1 += __shfl_xor(r1, 1);
        float lg[16]; float mx = -3.0e38f;
#pragma unroll
        for (int e = 0; e < 16; ++e) { lg[e] = __shfl(r1, 4 * e) + br[e]; mx = fmaxf(mx, lg[e]); }
        float p[16];
#pragma unroll
        for (int e = 0; e < 16; ++e) p[e] = __expf(lg[e] - mx);
        int gsel = 0; float gbest = -1.f;
#pragma unroll
        for (int g = 0; g < 4; ++g) { const float p0 = p[4 * g], p1 = p[4 * g + 1], p2 = p[4 * g + 2], p3 = p[4 * g + 3];
            const float sum = (p0 + p1) + (p2 + p3), mn1 = fminf(fminf(p0, p1), fminf(p2, p3));
            const float hi01 = fmaxf(p0, p1), lo01 = fminf(p0, p1), hi23 = fmaxf(p2, p3), lo23 = fminf(p2, p3);
            const float top1 = fmaxf(hi01, hi23), top2 = fmaxf(fminf(hi01, hi23), fmaxf(lo01, lo23));
            (void)sum; (void)mn1;
            const float sc = top1 + top2; if (sc > gbest) { gbest = sc; gsel = g; } }
        float q0, q1, q2, q3;
        q0 = gsel == 0 ? p[0] : gsel == 1 ? p[4] : gsel == 2 ? p[8] : p[12];
        q1 = gsel == 0 ? p[1] : gsel == 1 ? p[5] : gsel == 2 ? p[9] : p[13];
        q2 = gsel == 0 ? p[2] : gsel == 1 ? p[6] : gsel == 2 ? p[10] : p[14];
        q3 = gsel == 0 ? p[3] : gsel == 1 ? p[7] : gsel == 2 ? p[11] : p[15];
        int i1 = 0; float v1 = q0;
        if (q1 > v1) { v1 = q1; i1 = 1; } if (q2 > v1) { v1 = q2; i1 = 2; } if (q3 > v1) { v1 = q3; i1 = 3; }
        int i2 = -1; float v2 = -1.f;
        if (i1 != 0 && q0 > v2) { v2 = q0; i2 = 0; } if (i1 != 1 && q1 > v2) { v2 = q1; i2 = 1; } if (i1 != 2 && q2 > v2) { v2 = q2; i2 = 2; } if (i1 != 3 && q3 > v2) { v2 = q3; i2 = 3; }
        const float inv = 1.0f / (v1 + v2);
        if (lane == 0) { const int e1 = 4 * gsel + i1, e2 = 4 * gsel + i2;
            const unsigned pos1 = __hip_atomic_fetch_add(ctl + CW_CNT + e1, 1u, __ATOMIC_RELAXED, __HIP_MEMORY_SCOPE_AGENT);
            const unsigned pos2 = __hip_atomic_fetch_add(ctl + CW_CNT + e2, 1u, __ATOMIC_RELAXED, __HIP_MEMORY_SCOPE_AGENT);
            TOKE[t] = (unsigned)e1 | ((unsigned)e2 << 8); TOKP[2 * t] = pos1; TOKP[2 * t + 1] = pos2; TOKW[2 * t] = v1 * inv; TOKW[2 * t + 1] = v2 * inv; }
    }
}

__device__ __forceinline__ void phase_moe_lists(unsigned char* ws, LAS unsigned char* lds, int tid, int lane, int gw, int NGW) {
    unsigned* ctl = (unsigned*)(ws + WS_CTL);
    LAS unsigned* off = (LAS unsigned*)lds;
    if (tid == 0) { unsigned o = 0;
        for (int e = 0; e < NE; ++e) { const unsigned c = __hip_atomic_load(ctl + CW_CNT + e, __ATOMIC_RELAXED, __HIP_MEMORY_SCOPE_AGENT); off[e] = o; off[32 + e] = c; o += (c + 255u) & ~255u; }
        off[16] = o; }
    __syncthreads();
    int* ROWINFO = (int*)(ws + WS_SMALL + SM_ROWINFO);
    if (blockIdx.x == 0) {
        if (tid == 0) ctl[CW_NTILES] = off[16] >> 8;
        if (tid < NE) { const unsigned t0 = off[tid] >> 8, t1 = off[tid + 1] >> 8; for (unsigned tt = t0; tt < t1; ++tt) ctl[CW_TILEE + tt] = (unsigned)tid; }
        for (int e = 0; e < NE; ++e) { const unsigned p0 = off[e] + off[32 + e], p1 = off[e + 1]; for (unsigned r = p0 + tid; r < p1; r += 512) ROWINFO[r] = -1; }
    }
    const bf16_t* XB = (const bf16_t*)(ws + WS_XB); bf16_t* XG = (bf16_t*)(ws + WS_XG);
    const unsigned* TOKE = (const unsigned*)(ws + WS_SMALL + SM_TOKE); const unsigned* TOKP = (const unsigned*)(ws + WS_SMALL + SM_TOKP);
    for (int t = gw; t < T; t += NGW) {
        const unsigned ee = TOKE[t]; const unsigned r1 = off[ee & 255u] + TOKP[2 * t], r2 = off[(ee >> 8) & 255u] + TOKP[2 * t + 1];
        const u32x4 v0 = *(const u32x4*)(XB + (size_t)t * D + 8 * lane), v1 = *(const u32x4*)(XB + (size_t)t * D + 512 + 8 * lane);
        *(u32x4*)(XG + (size_t)r1 * D + 8 * lane) = v0; *(u32x4*)(XG + (size_t)r1 * D + 512 + 8 * lane) = v1;
        *(u32x4*)(XG + (size_t)r2 * D + 8 * lane) = v0; *(u32x4*)(XG + (size_t)r2 * D + 512 + 8 * lane) = v1;
        if (lane == 0) { ROWINFO[r1] = 2 * t; ROWINFO[r2] = 2 * t + 1; }
    }
}

__device__ __forceinline__ void phase_ln2(ArgsP a, int l, unsigned char* ws, float* out, int lane, int gw, int NGW) {
    const float* X1 = (const float*)(ws + WS_X1); const bf16_t* O = (const bf16_t*)(ws + WS_O); bf16_t* XB = (bf16_t*)(ws + WS_XB);
    const float* TOKW = (const float*)(ws + WS_SMALL + SM_TOKW);
    f32x4 gv[4], bv[4];
#pragma unroll
    for (int j = 0; j < 4; ++j) { gv[j] = *(const f32x4*)(a->ln2_g + (size_t)l * D + 4 * lane + 256 * j); bv[j] = *(const f32x4*)(a->ln2_b + (size_t)l * D + 4 * lane + 256 * j); }
    for (int t = gw; t < T; t += NGW) {
        const float w1 = TOKW[2 * t], w2 = TOKW[2 * t + 1];
        f32x4 v[4]; float s = 0.f;
#pragma unroll
        for (int j = 0; j < 4; ++j) { const f32x4 x = *(const f32x4*)(X1 + (size_t)t * D + 4 * lane + 256 * j);
            const u32x2 o1 = *(const u32x2*)(O + (size_t)(2 * t) * D + 4 * lane + 256 * j), o2 = *(const u32x2*)(O + (size_t)(2 * t + 1) * D + 4 * lane + 256 * j);
            f32x4 mo; mo[0] = w1 * bflo(o1.x) + w2 * bflo(o2.x); mo[1] = w1 * bfhi(o1.x) + w2 * bfhi(o2.x); mo[2] = w1 * bflo(o1.y) + w2 * bflo(o2.y); mo[3] = w1 * bfhi(o1.y) + w2 * bfhi(o2.y);
            v[j] = x * DN_ALPHA + mo; s += (v[j][0] + v[j][1]) + (v[j][2] + v[j][3]); }
        const float mean = wave_sum(s) * (1.f / D); float s2 = 0.f;
#pragma unroll
        for (int j = 0; j < 4; ++j) { v[j] = v[j] - mean; s2 += (v[j][0] * v[j][0] + v[j][1] * v[j][1]) + (v[j][2] * v[j][2] + v[j][3] * v[j][3]); }
        const float rstd = 1.f / sqrtf(wave_sum(s2) * (1.f / D) + LN_EPS);
#pragma unroll
        for (int j = 0; j < 4; ++j) { v[j] = v[j] * rstd * gv[j] + bv[j];
            *(f32x4*)(out + (size_t)t * D + 4 * lane + 256 * j) = v[j];
            u32x2 w; w.x = cvt_pk_bf16(v[j][0], v[j][1]); w.y = cvt_pk_bf16(v[j][2], v[j][3]); *(u32x2*)(XB + (size_t)t * D + 4 * lane + 256 * j) = w; }
    }
}

constexpr int STEPS_PER_LAYER = 5 * NCHUNK + 8;
constexpr int N_STEPS = 1 + DEPTH * STEPS_PER_LAYER;

__global__ void __launch_bounds__(512, 2) mk_fwd(Args args_by_value) {
    (void)args_by_value;
    extern __shared__ __attribute__((aligned(16))) unsigned char lds_raw[];
    LAS unsigned char* lds = (LAS unsigned char*)lds_raw;
    volatile LAS unsigned* MISC = (volatile LAS unsigned*)(lds + MISC_OFF);
    const int tid0 = threadIdx.x;
    const int G = gridDim.x; const int bx = blockIdx.x; const int vcu0 = (G % 8 == 0) ? (bx % 8) * (G / 8) + bx / 8 : bx;
    const int NGW = G * 8, nthr = G * 512;
    ArgsP ap0 = (ArgsP)__builtin_amdgcn_kernarg_segment_ptr();
    unsigned char* ws0 = ap0->ws;
    unsigned* ctl = (unsigned*)(ws0 + WS_CTL);
    for (int u = tid0; u < (LDS_BYTES - LDSCTL_OFF) / 4; u += 512) ((LAS unsigned*)(lds + LDSCTL_OFF))[u] = 0u;
    __syncthreads();
    XcdBarrier bar; bar.bar = ctl + CW_BAR; bar.x = 0; bar.st = nullptr;
    if (!MK_PER_STEP_LAUNCH) bar = xcd_barrier_post(ctl + CW_BAR, MISC + 8);
    const int lo = ap0->ph_lo, hi = ap0->ph_hi;
    int step = 0;
#ifndef MK_MASK
#define MK_MASK 0xFFFFFFFFu
#endif
#define STEP_BEGIN(id) if (((MK_MASK >> (id)) & 1u) && lo <= step && step < hi) { unsigned char* ws = ws0; asm volatile("" : "+s"(ws)); ArgsP args = ap0; asm volatile("" : "+s"(args)); int tid = tid0; asm volatile("" : "+v"(tid)); int vcu = vcu0; asm volatile("" : "+s"(vcu)); \
    const int lane = tid & 63, wave = __builtin_amdgcn_readfirstlane(tid >> 6), gw = vcu * 8 + wave, gtid = vcu * 512 + tid; LAS float* scr = (LAS float*)(lds + wave * 16384); (void)lane; (void)gw; (void)gtid; (void)scr;
#define STEP_END   if (step + 1 < hi) { if (MK_PER_STEP_LAUNCH) {} else xcd_barrier(bar); } } ++step;

    STEP_BEGIN(0)
        prep_tm_weights(args, 0, ws, scr, gw, NGW, lane);
        cvt_x(args->x, (bf16_t*)(ws + WS_XB), gtid, nthr);
    STEP_END

#pragma unroll 1
    for (int l = 0; l < DEPTH; ++l) {

#pragma unroll 1
        for (int half = 0; half < NCHUNK; ++half) {
            STEP_BEGIN(1)
                pg8::SchedPlain S{TH / 256, DIN / 256, G, bx, (const char*)(ws + WS_XB) + (size_t)half * TH * D * 2, (const char*)(ws + WS_WIN), (size_t)256 * D * 2, (size_t)256 * D * 2, 0};
                pg8::EpiZ E{(bf16_t*)(ws + WS_Z), (bf16_t*)(ws + WS_GG), half * TH};
                pg8::gemm_phase<pg8::EpiZ, pg8::SchedPlain, true>(lds, D, D, D, S, E);
            STEP_END
            STEP_BEGIN(2)
                phase_e1(args, l, half, ws, gtid, nthr);
            STEP_END
            STEP_BEGIN(3)
                pg8::SchedPlain S{TH / 256, NHEAD, G, bx, (const char*)(ws + WS_XC), (const char*)(ws + WS_WG), (size_t)256 * DR * 2, (size_t)256 * 128 * 2, (size_t)128 * 2};
                pg8::EpiBf16 E{(bf16_t*)(ws + WS_GT), 2560};
                pg8::gemm_phase<pg8::EpiBf16, pg8::SchedPlain, true>(lds, DR, 128, 128, S, E);
            STEP_END
            STEP_BEGIN(4)
                phase_scan<false>(args, l, half, ws, gtid, nthr);
            STEP_END
            STEP_BEGIN(5)
                phase_scan<true>(args, l, half, ws, gtid, nthr);
            STEP_END
        }
        STEP_BEGIN(6)
            pg8::SchedPlain S{T / 256, D / 256, G, bx, (const char*)(ws + WS_UA), (const char*)(ws + WS_WA), (size_t)256 * D * 2, (size_t)256 * D * 2, 0};
            pg8::EpiYa E{(float*)(ws + WS_STASH), (const bf16_t*)(ws + WS_GG)};
            pg8::gemm_phase<pg8::EpiYa, pg8::SchedPlain, true>(lds, D, D, D, S, E);
        STEP_END
        STEP_BEGIN(7)
            pg8::SchedPlain S{T / 256, D / 256, G, bx, (const char*)(ws + WS_UR), (const char*)(ws + WS_WR), (size_t)256 * DR * 2, (size_t)256 * DR * 2, 0};
            pg8::EpiMerged E{(const float*)(ws + WS_STASH), (const bf16_t*)(ws + WS_GG), (bf16_t*)(ws + WS_MERGED)};
            pg8::gemm_phase<pg8::EpiMerged, pg8::SchedPlain, true>(lds, DR, DR, DR, S, E);
        STEP_END
        STEP_BEGIN(8)
            pg8::SchedPlain S{T / 256, D / 256, G, bx, (const char*)(ws + WS_MERGED), (const char*)(ws + WS_WO), (size_t)256 * D * 2, (size_t)256 * D * 2, 0};
            pg8::EpiY E{(l == 0) ? args->x : (const float*)args->out, (float*)(ws + WS_Y)};
            pg8::gemm_phase<pg8::EpiY, pg8::SchedPlain, true>(lds, D, D, D, S, E);
        STEP_END
        STEP_BEGIN(9)
            prep_expert_weights(args, l, ws, scr, gw, NGW, lane);
            __syncthreads();
            phase_ln1_router(args, l, ws, lds, tid, lane, gw, NGW);
        STEP_END
        STEP_BEGIN(10)
            phase_moe_lists(ws, lds, tid, lane, gw, NGW);
            __syncthreads();
            if (l + 1 < DEPTH) prep_tm_weights(args, l + 1, ws, scr, gw, NGW, lane);
        STEP_END
        STEP_BEGIN(11)
            const int ntiles = (int)__hip_atomic_load(ctl + CW_NTILES, __ATOMIC_RELAXED, __HIP_MEMORY_SCOPE_AGENT);
            pg8::SchedMoe S{ntiles, 4, G, bx, (const char*)(ws + WS_XG), (const char*)(ws + WS_WEX), (size_t)256 * D * 2, (size_t)256 * D * 2, (size_t)1024 * 1024 * 2, ctl + CW_TILEE};
            pg8::EpiH E{(bf16_t*)(ws + WS_H)};
            pg8::gemm_phase<pg8::EpiH, pg8::SchedMoe, true>(lds, D, D, D, S, E);
        STEP_END
        STEP_BEGIN(12)
            const int ntiles = (int)__hip_atomic_load(ctl + CW_NTILES, __ATOMIC_RELAXED, __HIP_MEMORY_SCOPE_AGENT);
            pg8::SchedMoe S{ntiles, 4, G, bx, (const char*)(ws + WS_H), (const char*)(ws + WS_WEX) + (size_t)NE * 1024 * 1024 * 2, (size_t)256 * FF * 2, (size_t)256 * FF * 2, (size_t)1024 * 512 * 2, ctl + CW_TILEE};
            pg8::EpiO E{(bf16_t*)(ws + WS_O), (const int*)(ws + WS_SMALL + SM_ROWINFO)};
            pg8::gemm_phase<pg8::EpiO, pg8::SchedMoe, true>(lds, FF, FF, FF, S, E);
        STEP_END
        STEP_BEGIN(13)
            phase_ln2(args, l, ws, args->out, lane, gw, NGW);
            if (bx == 0 && tid < NE) __hip_atomic_store(ctl + CW_CNT + tid, 0u, __ATOMIC_RELAXED, __HIP_MEMORY_SCOPE_AGENT);
        STEP_END
    }
#undef STEP_BEGIN
#undef STEP_END
}

extern "C" void kernel_launch(void* const* d_in, const int* in_sizes, int n_in, void* d_out, int out_size, void* d_ws, size_t ws_size, hipStream_t stream) {
    static int grid = 0;
    if (grid == 0) {
        if (n_in != 22 || in_sizes[0] != T * D || out_size != T * D || ws_size < WS_NEED) {
            fprintf(stderr, "kernel_launch: unexpected shapes (n_in %d, in0 %d, out %d, ws %zu, need %zu); nothing launched\n", n_in, n_in > 0 ? in_sizes[0] : -1, out_size, ws_size, (size_t)WS_NEED); grid = -1; return; }
        int dev = 0, cus = 0, per_cu = 0;
        if (hipGetDevice(&dev) != hipSuccess || hipDeviceGetAttribute(&cus, hipDeviceAttributeMultiprocessorCount, dev) != hipSuccess) { grid = -1; return; }
        if (hipFuncSetAttribute((const void*)mk_fwd, hipFuncAttributeMaxDynamicSharedMemorySize, LDS_BYTES) != hipSuccess) { fprintf(stderr, "kernel_launch: hipFuncSetAttribute failed\n"); grid = -1; return; }
        if (hipOccupancyMaxActiveBlocksPerMultiprocessor(&per_cu, (const void*)mk_fwd, 512, LDS_BYTES) != hipSuccess || per_cu < 1) { fprintf(stderr, "kernel_launch: occupancy query says %d blocks per CU\n", per_cu); per_cu = 1; }
        (void)hipGetLastError();
        grid = cus;
    }
    if (grid < 0) return;
    (void)hipMemsetAsync((char*)d_ws + WS_CTL, 0, CTL_ZERO_BYTES, stream);
    Args a{};
    const float** p = (const float**)&a;
    for (int i = 0; i < 22; ++i) p[i] = (const float*)d_in[i];
    a.out = (float*)d_out; a.ws = (unsigned char*)d_ws;
#if MK_PER_STEP_LAUNCH
    for (int s = 0; s < N_STEPS; ++s) { a.ph_lo = s; a.ph_hi = s + 1; hipLaunchKernelGGL(mk_fwd, dim3(grid), dim3(512), LDS_BYTES, stream, a); }
#else
    a.ph_lo = 0; a.ph_hi = N_STEPS;
    hipLaunchKernelGGL(mk_fwd, dim3(grid), dim3(512), LDS_BYTES, stream, a);
#endif
}
```

```cpp
#include <hip/hip_runtime.h>
#include <cstdio>
#include <cstdint>

#ifndef MK_PER_STEP_LAUNCH
#define MK_PER_STEP_LAUNCH 0
#endif

#define LAS __attribute__((address_space(3)))
typedef unsigned short bf16_t;
typedef short bf16x8 __attribute__((ext_vector_type(8)));
typedef float f32x4 __attribute__((ext_vector_type(4)));
typedef float f32x2 __attribute__((ext_vector_type(2)));
typedef unsigned u32x4 __attribute__((ext_vector_type(4)));
typedef unsigned u32x2 __attribute__((ext_vector_type(2)));

constexpr int D = 1024, T = 16384, SEQ = 4096, NBATCH = 4, DR = 1280, NHEAD = 10, DIN = 7680, NE = 16, FF = 512, DEPTH = 2;
constexpr int NCHUNK = 2, TH = T / NCHUNK;
constexpr int ZC = 5632;
constexpr int GGC = 2048;
constexpr int SCH = 64, NSCH = SEQ / SCH;
constexpr int MOE_ROWS = 36864, MOE_TILES = MOE_ROWS / 256;
constexpr float LN_EPS = 1e-5f;
constexpr float DN_ALPHA = 1.4142135623730951f;

constexpr size_t MiB = 1u << 20;
constexpr size_t WS_CTL = 0, CTL_ZERO_BYTES = 128 * 1024;
constexpr size_t WS_WIN = 1 * MiB;
constexpr size_t WS_WA = 16 * MiB;
constexpr size_t WS_WR = 18 * MiB;
constexpr size_t WS_WO = 21 * MiB;
constexpr size_t WS_WG = 23 * MiB;
constexpr size_t WS_XB = 24 * MiB;
constexpr size_t WS_UA = 56 * MiB;
constexpr size_t WS_UR = 88 * MiB;
constexpr size_t WS_GG = 128 * MiB;
constexpr size_t WS_Z = 192 * MiB;
constexpr size_t WS_XC = 280 * MiB;
constexpr size_t WS_GT = 300 * MiB;
constexpr size_t WS_SMALL = 340 * MiB;
constexpr size_t WS_STASH = 192 * MiB;
constexpr size_t WS_MERGED = 256 * MiB;
constexpr size_t WS_Y = 56 * MiB;
constexpr size_t WS_X1 = 128 * MiB;
constexpr size_t WS_WEX = 192 * MiB;
constexpr size_t WS_XG = 240 * MiB;
constexpr size_t WS_H = 56 * MiB;
constexpr size_t WS_O = 240 * MiB;
constexpr size_t WS_NEED = 344 * MiB + 512 * 1024;
constexpr size_t SM_AEND = 0;
constexpr size_t SM_HEND = SM_AEND + (size_t)NBATCH * NSCH * DR * 4;
constexpr size_t SM_TOKE = SM_HEND + (size_t)NBATCH * NSCH * DR * 4;
constexpr size_t SM_TOKP = SM_TOKE + (size_t)T * 4;
constexpr size_t SM_TOKW = SM_TOKP + (size_t)T * 8;
constexpr size_t SM_ROWINFO = SM_TOKW + (size_t)T * 8;
constexpr size_t SM_WGCNT = SM_ROWINFO + (size_t)MOE_ROWS * 4;
constexpr size_t SM_END = SM_WGCNT + 256 * 16 * 4;
static_assert(WS_SMALL + SM_END <= WS_NEED, "small region");
constexpr int CW_BAR = 4096;
constexpr int CW_CNT = 8192;
constexpr int CW_NTILES = 8256;
constexpr int CW_TILEE = 8320;

constexpr int RING_BYTES = 131072;
constexpr int LDSCTL_OFF = RING_BYTES, MISC_OFF = LDSCTL_OFF + 320;
constexpr int LDS_BYTES = 147456;

__device__ __forceinline__ unsigned cvt_pk_bf16(float lo, float hi) { unsigned r; asm volatile("v_cvt_pk_bf16_f32 %0, %1, %2" : "=v"(r) : "v"(lo), "v"(hi)); return r; }
__device__ __forceinline__ float bflo(unsigned w) { return __uint_as_float(w << 16); }
__device__ __forceinline__ float bfhi(unsigned w) { return __uint_as_float(w & 0xffff0000u); }
__device__ __forceinline__ float bf1(bf16_t b) { return __uint_as_float((unsigned)b << 16); }
__device__ __forceinline__ float fsigmoid(float x) { return __fdividef(1.0f, 1.0f + __expf(-x)); }
__device__ __forceinline__ float gelu_tanh(float y) { const float u = 1.5957691216057308f * (y + 0.044715f * y * y * y); return y * fsigmoid(u); }
__device__ __forceinline__ float wave_sum(float v) {
#pragma unroll
    for (int o = 1; o < 64; o <<= 1) v += __shfl_xor(v, o);
    return v;
}
#define LDS_WAIT() asm volatile("s_waitcnt lgkmcnt(0)" ::: "memory")
#define VM_WAIT() asm volatile("s_waitcnt vmcnt(0)" ::: "memory")

namespace pg8 {
constexpr int BM = 256, BK = 64, HALF = 128, HTB = HALF * BK * 2, STAGE_BYTES = 8 * HTB, NXCD = 8, WGM = 8;
__host__ __device__ __forceinline__ int lds_byte(int r, int c) { const int st = (r >> 4) * 2 + (c >> 5), rr = r & 15, cc = c & 31, ob = rr * 64 + cc * 2; return st * 1024 + (ob ^ (((ob >> 9) & 1) << 5)); }
__host__ __device__ __forceinline__ void stage_rc(int b, int& R, int& C) { const int st = b / 1024, sb = b % 1024, swz = sb ^ (((sb >> 9) & 1) << 5); R = (st >> 1) * 16 + swz / 64; C = (st & 1) * 32 + (swz % 64) / 2; }
__host__ __device__ __forceinline__ int perm32(int rho) { const int n = rho >> 4, i = rho & 15; return 8 * (i >> 2) + 4 * n + (i & 3); }

struct Unit { const char* a; const char* b; int pm, pn; };

__device__ __forceinline__ bool static_order(int i, int G, int c, int nM, int nN, int& pm, int& pn) {
    const int nwg = nM * nN; const long L = (long)i * G + c; if (L >= nwg) return false;
    int wgid = (int)L; { const int q = nwg / NXCD, r = nwg % NXCD, xcd = wgid % NXCD, off = wgid / NXCD; wgid = (xcd < r ? xcd * (q + 1) : r * (q + 1) + (xcd - r) * q) + off; }
    const int nig = WGM * nN, gid = wgid / nig, fm = gid * WGM, gsz = (nM - fm) < WGM ? (nM - fm) : WGM;
    pm = fm + ((wgid % nig) % gsz); pn = (wgid % nig) / gsz; return true;
}
struct SchedPlain {
    int nM, nN, G, c; const char* A; const char* B; size_t a_tile, b_tile, a_pn;
    __device__ __forceinline__ bool next(int i, Unit& u) const {
        int pm, pn; if (!static_order(i, G, c, nM, nN, pm, pn)) return false;
        u.pm = pm; u.pn = pn; u.a = A + (size_t)pm * a_tile + (size_t)pn * a_pn; u.b = B + (size_t)pn * b_tile; return true;
    }
};
struct SchedMoe {
    int nM, nN, G, c; const char* A; const char* B; size_t a_tile, b_tile, b_exp; const unsigned* tile_e;
    __device__ __forceinline__ bool next(int i, Unit& u) const {
        int pm, pn; if (!static_order(i, G, c, nM, nN, pm, pn)) return false;
        const int e = __builtin_amdgcn_readfirstlane((int)__hip_atomic_load(tile_e + pm, __ATOMIC_RELAXED, __HIP_MEMORY_SCOPE_AGENT));
        u.pm = pm; u.pn = pn; u.a = A + (size_t)pm * a_tile; u.b = B + (size_t)e * b_exp + (size_t)pn * b_tile; return true;
    }
};

template <class Epi, class Sched, bool ALIGN_EPI>
__device__ __forceinline__ void gemm_phase(LAS unsigned char* lds, const int lda, const int ldb, const int K, const Sched& S, const Epi& E) {
    int tid = threadIdx.x; asm volatile("" : "+v"(tid));
    const int wid = __builtin_amdgcn_readfirstlane(tid >> 6), lane = tid & 63, wr = wid >> 2, wc = wid & 3, fr = lane & 15, fq = lane >> 4;
    int Kop = K; asm volatile("" : "+s"(Kop));
    const int nt = Kop / BK;
    unsigned voffA[2], voffB[2];
#pragma unroll
    for (int i = 0; i < 2; ++i) { int R, C; stage_rc(tid * 16 + i * 8192, R, C); const int Rb = Epi::PERM ? ((R & ~31) + perm32(R & 31)) : R;
        voffA[i] = (unsigned)(R * lda + C) * 2u; voffB[i] = (unsigned)(Rb * ldb + C) * 2u; }
    const size_t kstep = (size_t)(BK * 2);
    const size_t hstepA = (size_t)HALF * lda * 2, hstepB = (size_t)HALF * ldb * 2;
    const unsigned ldsw = (unsigned)wid * 1024u;
    const int aoff = lds_byte(wr * 64 + fr, fq * 8), boff = lds_byte(wc * 32 + fr, fq * 8);
#define PG8_SA(b, h) (((b) * 2 + (h)) * HTB)
#define PG8_SB(b, h) ((4 + (b) * 2 + (h)) * HTB)
#define PG8_STAGE(bufoff, gbase, voff) do { _Pragma("unroll") for (int _i = 0; _i < 2; ++_i) \
        __builtin_amdgcn_global_load_lds((const unsigned*)((const char*)(gbase) + (voff)[_i]), (LAS unsigned*)(lds + (bufoff) + ldsw + _i * 8192), 16, 0, 0); } while (0)
#define PG8_LDA(dst, b, h) do { _Pragma("unroll") for (int m = 0; m < 4; ++m) _Pragma("unroll") for (int k = 0; k < 2; ++k) dst[m][k] = *(const LAS bf16x8*)(lds + PG8_SA(b, h) + aoff + m * 2048 + k * 1024); } while (0)
#define PG8_LDB(dst, b, h) do { _Pragma("unroll") for (int n = 0; n < 2; ++n) _Pragma("unroll") for (int k = 0; k < 2; ++k) dst[n][k] = *(const LAS bf16x8*)(lds + PG8_SB(b, h) + boff + n * 2048 + k * 1024); } while (0)
#define PG8_MMA(ai, bj, At, Bt) do { __builtin_amdgcn_s_setprio(1); _Pragma("unroll") for (int m = 0; m < 4; ++m) _Pragma("unroll") for (int n = 0; n < 2; ++n) _Pragma("unroll") for (int k = 0; k < 2; ++k) \
        acc[ai][bj][m][n] = __builtin_amdgcn_mfma_f32_16x16x32_bf16(Bt[n][k], At[m][k], acc[ai][bj][m][n], 0, 0, 0); __builtin_amdgcn_s_setprio(0); } while (0)
#define PG8_WAIT_V(n) asm volatile("s_waitcnt vmcnt(" #n ")" ::: "memory")
#define PG8_WAIT_L(n) asm volatile("s_waitcnt lgkmcnt(" #n ")" ::: "memory")
#define PG8_BAR __builtin_amdgcn_s_barrier()
#define PG8_SCHED __builtin_amdgcn_sched_barrier(0)
    Unit cur, nxt; int ui = 0;
    if (!S.next(0, cur)) return;
    f32x4 acc[2][2][4][2];
#pragma unroll
    for (int a = 0; a < 2; ++a)
#pragma unroll
        for (int b = 0; b < 2; ++b)
#pragma unroll
            for (int m = 0; m < 4; ++m)
#pragma unroll
                for (int n = 0; n < 2; ++n) acc[a][b][m][n] = (f32x4){0.f, 0.f, 0.f, 0.f};
    bf16x8 At[4][2], B0[2][2], B1[2][2];
    const char* cA = cur.a; const char* cB = cur.b;
    PG8_STAGE(PG8_SB(0, 0), cB, voffB); PG8_STAGE(PG8_SB(0, 1), cB + hstepB, voffB); PG8_STAGE(PG8_SA(0, 0), cA, voffA); PG8_STAGE(PG8_SA(0, 1), cA + hstepA, voffA);
    if (wr == 1) PG8_BAR;
    PG8_WAIT_V(2); PG8_BAR;
    PG8_STAGE(PG8_SB(1, 0), cB + kstep, voffB); PG8_STAGE(PG8_SA(1, 0), cA + kstep, voffA); PG8_STAGE(PG8_SB(1, 1), cB + hstepB + kstep, voffB);
    PG8_WAIT_V(6); PG8_BAR;
    for (;;) {
        const bool has_next = S.next(ui + 1, nxt);
        const char* nA = has_next ? nxt.a : cA; const char* nB = has_next ? nxt.b : cB;
        for (int t = 0; t < nt; t += 2) {
            const bool last = (t == nt - 2);
            const char* a1 = cA + (size_t)(t + 1) * kstep;
            const char* a2 = last ? nA : cA + (size_t)(t + 2) * kstep; const char* b2 = last ? nB : cB + (size_t)(t + 2) * kstep;
            const char* a3 = a2 + kstep; const char* b3 = b2 + kstep;
            PG8_LDB(B0, 0, 0); PG8_LDB(B1, 0, 1); PG8_SCHED; PG8_LDA(At, 0, 0); PG8_STAGE(PG8_SA(1, 1), a1 + hstepA, voffA);
            PG8_WAIT_V(8); PG8_WAIT_L(0); PG8_BAR; PG8_MMA(0, 0, At, B0); PG8_MMA(0, 1, At, B1); PG8_BAR; PG8_SCHED;
            PG8_LDA(At, 0, 1); PG8_STAGE(PG8_SB(0, 0), b2, voffB); PG8_STAGE(PG8_SB(0, 1), b2 + hstepB, voffB); PG8_STAGE(PG8_SA(0, 0), a2, voffA);
            PG8_WAIT_V(8); PG8_WAIT_L(0); PG8_BAR; PG8_MMA(1, 0, At, B0); PG8_MMA(1, 1, At, B1); PG8_BAR; PG8_SCHED;
            PG8_LDB(B0, 1, 0); PG8_LDB(B1, 1, 1); PG8_SCHED; PG8_LDA(At, 1, 0); PG8_STAGE(PG8_SA(0, 1), a2 + hstepA, voffA);
            PG8_WAIT_V(8); PG8_WAIT_L(0); PG8_BAR; PG8_MMA(0, 0, At, B0); PG8_MMA(0, 1, At, B1); PG8_BAR; PG8_SCHED;
            PG8_LDA(At, 1, 1); PG8_STAGE(PG8_SB(1, 0), b3, voffB); PG8_STAGE(PG8_SB(1, 1), b3 + hstepB, voffB); PG8_STAGE(PG8_SA(1, 0), a3, voffA);
            PG8_WAIT_V(8); PG8_WAIT_L(0); PG8_BAR; PG8_MMA(1, 0, At, B0); PG8_MMA(1, 1, At, B1); PG8_BAR; PG8_SCHED;
        }
        if constexpr (ALIGN_EPI) { if (wr == 0) PG8_BAR; }
        E(acc, cur, wr, wc, fr, fq);
        if (!has_next) break;
#pragma unroll
        for (int a = 0; a < 2; ++a)
#pragma unroll
            for (int b = 0; b < 2; ++b)
#pragma unroll
                for (int m = 0; m < 4; ++m)
#pragma unroll
                    for (int n = 0; n < 2; ++n) acc[a][b][m][n] = (f32x4){0.f, 0.f, 0.f, 0.f};
        cur = nxt; cA = nA; cB = nB; ++ui;
        if constexpr (ALIGN_EPI) { if (wr == 1) PG8_BAR; }
    }
    PG8_WAIT_V(0);
    if constexpr (!ALIGN_EPI) { if (wr == 0) PG8_BAR; }
    PG8_BAR;
#undef PG8_SA
#undef PG8_SB
#undef PG8_STAGE
#undef PG8_LDA
#undef PG8_LDB
#undef PG8_MMA
#undef PG8_WAIT_V
#undef PG8_WAIT_L
#undef PG8_BAR
#undef PG8_SCHED
}

typedef const f32x4 (&AccRef)[2][2][4][2];
#define EPI_LOOP_ROWS for (int ai = 0; ai < 2; ++ai) _Pragma("unroll") for (int m = 0; m < 4; ++m)

struct EpiZ {
    static constexpr bool PERM = true;
    bf16_t* Z; bf16_t* GG; int row_base;
    __device__ __forceinline__ void operator()(AccRef acc, const Unit& u, int wr, int wc, int fr, int fq) const {
        const int row0 = u.pm * BM + wr * 64 + fr; const int colt = u.pn * BM + wc * 32 + 8 * fq;
        bf16_t* base; size_t ldc;
        if (u.pn < 22) { base = Z + colt; ldc = ZC; } else { base = GG + (size_t)row_base * GGC + (colt - ZC); ldc = GGC; }
#pragma unroll
        EPI_LOOP_ROWS { bf16_t* rowp = base + (size_t)(row0 + ai * HALF + m * 16) * ldc;
#pragma unroll
            for (int bj = 0; bj < 2; ++bj) { const f32x4 v0 = acc[ai][bj][m][0], v1 = acc[ai][bj][m][1];
                u32x4 w; w.x = cvt_pk_bf16(v0[0], v0[1]); w.y = cvt_pk_bf16(v0[2], v0[3]); w.z = cvt_pk_bf16(v1[0], v1[1]); w.w = cvt_pk_bf16(v1[2], v1[3]);
                *(u32x4*)(rowp + bj * HALF) = w; } }
    }
};
struct EpiBf16 {
    static constexpr bool PERM = true;
    bf16_t* O; int ldc;
    __device__ __forceinline__ void operator()(AccRef acc, const Unit& u, int wr, int wc, int fr, int fq) const {
        const int row0 = u.pm * BM + wr * 64 + fr; const int colt = u.pn * BM + wc * 32 + 8 * fq;
#pragma unroll
        EPI_LOOP_ROWS { bf16_t* rowp = O + (size_t)(row0 + ai * HALF + m * 16) * ldc + colt;
#pragma unroll
            for (int bj = 0; bj < 2; ++bj) { const f32x4 v0 = acc[ai][bj][m][0], v1 = acc[ai][bj][m][1];
                u32x4 w; w.x = cvt_pk_bf16(v0[0], v0[1]); w.y = cvt_pk_bf16(v0[2], v0[3]); w.z = cvt_pk_bf16(v1[0], v1[1]); w.w = cvt_pk_bf16(v1[2], v1[3]);
                *(u32x4*)(rowp + bj * HALF) = w; } }
    }
};
struct EpiYa {
    static constexpr bool PERM = false;
    float* ST; const bf16_t* GG;
    __device__ __forceinline__ void operator()(AccRef acc, const Unit& u, int wr, int wc, int fr, int fq) const {
        const int row0 = u.pm * BM + wr * 64 + fr, col0 = u.pn * BM + wc * 32 + 4 * fq;
#pragma unroll
        EPI_LOOP_ROWS { const size_t r = (size_t)(row0 + ai * HALF + m * 16);
#pragma unroll
            for (int bj = 0; bj < 2; ++bj)
#pragma unroll
                for (int n = 0; n < 2; ++n) { const int c = col0 + bj * HALF + n * 16; const u32x2 g = *(const u32x2*)(GG + r * GGC + c); const f32x4 a = acc[ai][bj][m][n];
                    f32x4 o; o[0] = fsigmoid(bflo(g.x)) * a[0]; o[1] = fsigmoid(bfhi(g.x)) * a[1]; o[2] = fsigmoid(bflo(g.y)) * a[2]; o[3] = fsigmoid(bfhi(g.y)) * a[3];
                    *(f32x4*)(ST + r * D + c) = o; }
            asm volatile("" ::: "memory"); }
    }
};
struct EpiMerged {
    static constexpr bool PERM = true;
    const float* ST; const bf16_t* GG; bf16_t* MG;
    __device__ __forceinline__ void operator()(AccRef acc, const Unit& u, int wr, int wc, int fr, int fq) const {
        const int row0 = u.pm * BM + wr * 64 + fr; const int colt = u.pn * BM + wc * 32 + 8 * fq;
#pragma unroll
        EPI_LOOP_ROWS { const size_t r = (size_t)(row0 + ai * HALF + m * 16);
#pragma unroll
            for (int bj = 0; bj < 2; ++bj) { const int c = colt + bj * HALF;
                const f32x4 s0 = *(const f32x4*)(ST + r * D + c), s1 = *(const f32x4*)(ST + r * D + c + 4); const u32x4 g = *(const u32x4*)(GG + r * GGC + D + c);
                const f32x4 v0 = acc[ai][bj][m][0], v1 = acc[ai][bj][m][1];
                u32x4 w; w.x = cvt_pk_bf16(s0[0] + fsigmoid(bflo(g.x)) * v0[0], s0[1] + fsigmoid(bfhi(g.x)) * v0[1]);
                w.y = cvt_pk_bf16(s0[2] + fsigmoid(bflo(g.y)) * v0[2], s0[3] + fsigmoid(bfhi(g.y)) * v0[3]);
                w.z = cvt_pk_bf16(s1[0] + fsigmoid(bflo(g.z)) * v1[0], s1[1] + fsigmoid(bfhi(g.z)) * v1[1]);
                w.w = cvt_pk_bf16(s1[2] + fsigmoid(bflo(g.w)) * v1[2], s1[3] + fsigmoid(bfhi(g.w)) * v1[3]);
                *(u32x4*)(MG + r * D + c) = w; }
            asm volatile("" ::: "memory"); }
    }
};
struct EpiY {
    static constexpr bool PERM = false;
    const float* X0; float* Y;
    __device__ __forceinline__ void operator()(AccRef acc, const Unit& u, int wr, int wc, int fr, int fq) const {
        const int row0 = u.pm * BM + wr * 64 + fr, col0 = u.pn * BM + wc * 32 + 4 * fq;
#pragma unroll
        EPI_LOOP_ROWS { const size_t r = (size_t)(row0 + ai * HALF + m * 16);
#pragma unroll
            for (int bj = 0; bj < 2; ++bj)
#pragma unroll
                for (int n = 0; n < 2; ++n) { const int c = col0 + bj * HALF + n * 16; const f32x4 x = *(const f32x4*)(X0 + r * D + c);
                    *(f32x4*)(Y + r * D + c) = x * DN_ALPHA + acc[ai][bj][m][n]; }
            asm volatile("" ::: "memory"); }
    }
};
struct EpiH {
    static constexpr bool PERM = true;
    bf16_t* H;
    __device__ __forceinline__ void operator()(AccRef acc, const Unit& u, int wr, int wc, int fr, int fq) const {
        const int row0 = u.pm * BM + wr * 64 + fr; const int col = u.pn * HALF + wc * 32 + 8 * fq;
#pragma unroll
        EPI_LOOP_ROWS { const size_t r = (size_t)(row0 + ai * HALF + m * 16);
            const f32x4 g0 = acc[ai][0][m][0], g1 = acc[ai][0][m][1], u0 = acc[ai][1][m][0], u1 = acc[ai][1][m][1];
            u32x4 w;
            w.x = cvt_pk_bf16(g0[0] * fsigmoid(g0[0]) * u0[0], g0[1] * fsigmoid(g0[1]) * u0[1]);
            w.y = cvt_pk_bf16(g0[2] * fsigmoid(g0[2]) * u0[2], g0[3] * fsigmoid(g0[3]) * u0[3]);
            w.z = cvt_pk_bf16(g1[0] * fsigmoid(g1[0]) * u1[0], g1[1] * fsigmoid(g1[1]) * u1[1]);
            w.w = cvt_pk_bf16(g1[2] * fsigmoid(g1[2]) * u1[2], g1[3] * fsigmoid(g1[3]) * u1[3]);
            *(u32x4*)(H + r * FF + col) = w; }
    }
};
struct EpiO {
    static constexpr bool PERM = true;
    bf16_t* O; const int* rowinfo;
    __device__ __forceinline__ void operator()(AccRef acc, const Unit& u, int wr, int wc, int fr, int fq) const {
        const int row0 = u.pm * BM + wr * 64 + fr; const int colt = u.pn * BM + wc * 32 + 8 * fq;
#pragma unroll
        EPI_LOOP_ROWS { const int dst = rowinfo[row0 + ai * HALF + m * 16];
            if (dst >= 0) { bf16_t* rowp = O + (size_t)dst * D + colt;
#pragma unroll
                for (int bj = 0; bj < 2; ++bj) { const f32x4 v0 = acc[ai][bj][m][0], v1 = acc[ai][bj][m][1];
                    u32x4 w; w.x = cvt_pk_bf16(v0[0], v0[1]); w.y = cvt_pk_bf16(v0[2], v0[3]); w.z = cvt_pk_bf16(v1[0], v1[1]); w.w = cvt_pk_bf16(v1[2], v1[3]);
                    *(u32x4*)(rowp + bj * HALF) = w; } } }
    }
};
}

#define XB_TMO      128
#define XB_XCNT(j)  (256  + 64 * (j))
#define XB_XSUB(j)  (1280 + 64 * (j))
#define XB_XGEN(j)  (2304 + 64 * (j))
#define XB_TOP      3328
#define XB_TOPGEN   3392
#define XCD_BAR_WORDS 3456
#define XB_SPIN_CAP (1u << 18)
__device__ __forceinline__ unsigned xb_ld(unsigned* p)              { return __hip_atomic_load(p, __ATOMIC_RELAXED, __HIP_MEMORY_SCOPE_AGENT); }
__device__ __forceinline__ unsigned xb_add(unsigned* p, unsigned v) { return __hip_atomic_fetch_add(p, v, __ATOMIC_RELAXED, __HIP_MEMORY_SCOPE_AGENT); }
__device__ __forceinline__ unsigned xb_xcc_id() { return (unsigned)__builtin_amdgcn_s_getreg((3 << 11) | 20) & 0xFu; }
#define XB_SPIN(cond, bar) do { unsigned _sp = 0; while (cond) { __builtin_amdgcn_s_sleep(1); \
    if ((++_sp & 255u) == 0u) { if (xb_ld(&(bar)[XB_TMO])) break; if (_sp > XB_SPIN_CAP) { atomicAdd(&(bar)[XB_TMO], 1u); break; } } } } while (0)
struct XcdBarrier { unsigned* bar; unsigned x; volatile LAS unsigned* st; };
__device__ __forceinline__ XcdBarrier xcd_barrier_post(unsigned* bar, volatile LAS unsigned* st) {
    XcdBarrier b; b.bar = bar; b.x = xb_xcc_id(); b.st = st;
    if (threadIdx.x == 0) (void)xb_add(&bar[XB_XCNT(b.x)], 1u);
    return b;
}
__device__ __forceinline__ void xcd_barrier_complete(unsigned* bar, unsigned x, unsigned& nloc, unsigned& nx) {
    const unsigned G = gridDim.x * gridDim.y * gridDim.z;
    unsigned sum, cnt, mine, sp = 0u;
    for (;;) {
        sum = 0u; cnt = 0u; mine = 0u;
#pragma unroll
        for (unsigned j = 0; j < 16; ++j) { const unsigned c = xb_ld(&bar[XB_XCNT(j)]); sum += c; cnt += (c > 0u) ? 1u : 0u; mine = (j == x) ? c : mine; }
        if (sum == G) break;
        __builtin_amdgcn_s_sleep(1);
        if ((++sp & 255u) == 0u) { if (xb_ld(&bar[XB_TMO])) break; if (sp > XB_SPIN_CAP) { atomicAdd(&bar[XB_TMO], 1u); break; } }
    }
    nloc = mine > 0u ? mine : 1u; nx = cnt > 0u ? cnt : 1u;
}
__device__ __forceinline__ void xcd_barrier(const XcdBarrier& b) {
    asm volatile("s_waitcnt vmcnt(0)" ::: "memory");
    __syncthreads();
    if (threadIdx.x == 0) {
        unsigned* bar = b.bar;
        __builtin_amdgcn_s_waitcnt(0);
        unsigned nloc = b.st[0], nx = b.st[1];
        if (nloc == 0u) { xcd_barrier_complete(bar, b.x, nloc, nx); b.st[0] = nloc; b.st[1] = nx; }
        const unsigned old = xb_add(&bar[XB_XSUB(b.x)], 1u);
        const unsigned gen = old / nloc;
        if (old + 1u == (gen + 1u) * nloc) {
            __builtin_amdgcn_fence(__ATOMIC_RELEASE, "agent");
            asm volatile("s_waitcnt vmcnt(0)" ::: "memory");
            const unsigned og = xb_add(&bar[XB_TOP], 1u);
            const unsigned tg = og / nx;
            if (og + 1u == (tg + 1u) * nx) xb_add(&bar[XB_TOPGEN], 1u);
            else XB_SPIN(xb_ld(&bar[XB_TOPGEN]) == tg, bar);
            __builtin_amdgcn_fence(__ATOMIC_ACQUIRE, "agent");
            xb_add(&bar[XB_XGEN(b.x)], 1u);
            asm volatile("s_waitcnt vmcnt(0)" ::: "memory");
        } else {
            XB_SPIN(xb_ld(&bar[XB_XGEN(b.x)]) == gen, bar);
            __builtin_amdgcn_fence(__ATOMIC_ACQUIRE, "agent");
            asm volatile("s_waitcnt vmcnt(0)" ::: "memory");
        }
    }
    __syncthreads();
}

struct Args {
    const float* x; const float* w_in; const float* conv_a_w; const float* w_branch_a; const float* conv_r_w; const float* conv_r_b;
    const float* w_rg_a; const float* b_rg_a; const float* w_rg_x; const float* b_rg_x; const float* rg_lambda; const float* w_branch_r; const float* w_out;
    const float* ln1_g; const float* ln1_b; const float* w_router; const float* b_router; const float* w_exp_gate; const float* w_exp_up; const float* w_exp_down;
    const float* ln2_g; const float* ln2_b;
    float* out; unsigned char* ws; int ph_lo, ph_hi;
};

typedef const Args __attribute__((address_space(4)))* ArgsP;

__device__ __forceinline__ void transpose_item(const float* W, int N, int k0, int n0, bf16_t* WT, int ldk, int drow0, LAS float* scr, int lane) {
#pragma unroll 8
    for (int i = 0; i < 32; ++i) { const int kk = 2 * i + (lane >> 5); scr[kk * 33 + (lane & 31)] = W[(size_t)(k0 + kk) * N + n0 + (lane & 31)]; }
    LDS_WAIT(); asm volatile("" ::: "memory");
    const int c = lane & 7;
#pragma unroll
    for (int j = 0; j < 4; ++j) { const int n = (lane >> 3) + 8 * j; const LAS float* s = scr + (8 * c) * 33 + n;
        u32x4 o; o.x = cvt_pk_bf16(s[0 * 33], s[1 * 33]); o.y = cvt_pk_bf16(s[2 * 33], s[3 * 33]); o.z = cvt_pk_bf16(s[4 * 33], s[5 * 33]); o.w = cvt_pk_bf16(s[6 * 33], s[7 * 33]);
        *(u32x4*)(WT + (size_t)(drow0 + n) * ldk + k0 + 8 * c) = o; }
    LDS_WAIT(); asm volatile("" ::: "memory");
}
__device__ __forceinline__ void transpose_plain(const float* W, int K, int N, bf16_t* WT, int item, LAS float* scr, int lane) {
    const int nblk = N / 32, kb = item / nblk, nb = item % nblk;
    transpose_item(W, N, 64 * kb, 32 * nb, WT, K, 32 * nb, scr, lane);
}

__device__ __forceinline__ void prep_tm_weights(ArgsP a, int l, unsigned char* ws, LAS float* scr, int gw, int NGW, int lane) {
    constexpr int I_IN = (D / 64) * (DIN / 32), I_A = (D / 64) * (D / 32), I_R = (DR / 64) * (D / 32), I_O = I_A, I_G = 2 * NHEAD * 2 * 4;
    constexpr int NITEMS = I_IN + I_A + I_R + I_O + I_G;
    for (int it = gw; it < NITEMS; it += NGW) {
        int r = it;
        if (r < I_IN) { transpose_plain(a->w_in + (size_t)l * D * DIN, D, DIN, (bf16_t*)(ws + WS_WIN), r, scr, lane); continue; } r -= I_IN;
        if (r < I_A) { transpose_plain(a->w_branch_a + (size_t)l * D * D, D, D, (bf16_t*)(ws + WS_WA), r, scr, lane); continue; } r -= I_A;
        if (r < I_R) { transpose_plain(a->w_branch_r + (size_t)l * DR * D, DR, D, (bf16_t*)(ws + WS_WR), r, scr, lane); continue; } r -= I_R;
        if (r < I_O) { transpose_plain(a->w_out + (size_t)l * D * D, D, D, (bf16_t*)(ws + WS_WO), r, scr, lane); continue; } r -= I_O;
        {
            const int nb = r & 3, kb = (r >> 2) & 1, hw = r >> 3, which = hw & 1, hh = hw >> 1;
            const float* W = (which ? a->w_rg_x : a->w_rg_a) + ((size_t)l * NHEAD + hh) * 128 * 128;
            transpose_item(W, 128, 64 * kb, 32 * nb, (bf16_t*)(ws + WS_WG), 128, hh * 256 + which * 128 + 32 * nb, scr, lane);
        }
    }
}
__device__ __forceinline__ void prep_expert_weights(ArgsP a, int l, unsigned char* ws, LAS float* scr, int gw, int NGW, int lane) {
    constexpr int I_G = (D / 64) * (FF / 32), I_D = (FF / 64) * (D / 32), PER_E = 2 * I_G + I_D;
    bf16_t* WGU = (bf16_t*)(ws + WS_WEX); bf16_t* WDN = WGU + (size_t)NE * 1024 * 1024;
    for (int it = gw; it < NE * PER_E; it += NGW) {
        const int e = it / PER_E; int r = it % PER_E;
        if (r < 2 * I_G) { const int which = r / I_G; r %= I_G; const int nblk = FF / 32, kb = r / nblk, nb = r % nblk, n0 = 32 * nb;
            const float* W = (which ? a->w_exp_up : a->w_exp_gate) + ((size_t)l * NE + e) * D * FF;
            const int drow0 = (n0 >> 7) * 256 + which * 128 + (n0 & 127);
            transpose_item(W, FF, 64 * kb, n0, WGU + (size_t)e * 1024 * 1024, D, drow0, scr, lane);
        } else { r -= 2 * I_G; const float* W = a->w_exp_down + ((size_t)l * NE + e) * FF * D;
            transpose_plain(W, FF, D, WDN + (size_t)e * 1024 * 512, r, scr, lane); }
    }
}
__device__ __forceinline__ void cvt_x(const float* x, bf16_t* xb, int gtid, int nthr) {
    for (size_t i = gtid; i < (size_t)T * D / 8; i += nthr) { const f32x4 a = *(const f32x4*)(x + i * 8), b = *(const f32x4*)(x + i * 8 + 4);
        u32x4 w; w.x = cvt_pk_bf16(a[0], a[1]); w.y = cvt_pk_bf16(a[2], a[3]); w.z = cvt_pk_bf16(b[0], b[1]); w.w = cvt_pk_bf16(b[2], b[3]); *(u32x4*)(xb + i * 8) = w; }
}
__device__ __forceinline__ void unpack8(const u32x4 w, float (&f)[8]) { f[0] = bflo(w.x); f[1] = bfhi(w.x); f[2] = bflo(w.y); f[3] = bfhi(w.y); f[4] = bflo(w.z); f[5] = bfhi(w.z); f[6] = bflo(w.w); f[7] = bfhi(w.w); }
__device__ __forceinline__ u32x4 pack8(const float (&f)[8]) { u32x4 w; w.x = cvt_pk_bf16(f[0], f[1]); w.y = cvt_pk_bf16(f[2], f[3]); w.z = cvt_pk_bf16(f[4], f[5]); w.w = cvt_pk_bf16(f[6], f[7]); return w; }

__device__ __forceinline__ void phase_e1(ArgsP a, int l, int half, unsigned char* ws, int gtid, int nthr) {
    const bf16_t* Z = (const bf16_t*)(ws + WS_Z); bf16_t* UA = (bf16_t*)(ws + WS_UA) + (size_t)half * TH * D; bf16_t* XC = (bf16_t*)(ws + WS_XC);
    constexpr int RUN = 8;
    constexpr int NA = (TH / RUN) * (D / 8), NR = (TH / RUN) * (DR / 8);
    for (int it = gtid; it < NA + NR; it += nthr) {
        if (it < NA) {
            const int cg = it % (D / 8), run = it / (D / 8), t0 = run * RUN, c0 = cg * 8;
            float w0[8], w1[8], w2[8];
            { const float* cw = a->conv_a_w + (size_t)l * 3 * D + c0;
#pragma unroll
              for (int j = 0; j < 8; ++j) { w0[j] = cw[j]; w1[j] = cw[D + j]; w2[j] = cw[2 * D + j]; } }
            float vm2[8], vm1[8];
            if ((t0 & (SEQ - 1)) == 0) {
#pragma unroll
                for (int j = 0; j < 8; ++j) { vm2[j] = 0.f; vm1[j] = 0.f; }
            } else {
                float h2[8], c2[8], h1[8], c1[8];
                unpack8(*(const u32x4*)(Z + (size_t)(t0 - 2) * ZC + c0), h2); unpack8(*(const u32x4*)(Z + (size_t)(t0 - 2) * ZC + 2 * D + c0), c2);
                unpack8(*(const u32x4*)(Z + (size_t)(t0 - 1) * ZC + c0), h1); unpack8(*(const u32x4*)(Z + (size_t)(t0 - 1) * ZC + 2 * D + c0), c1);
#pragma unroll
                for (int j = 0; j < 8; ++j) { vm2[j] = c2[j] * h2[j]; vm1[j] = c1[j] * h1[j]; }
            }
#pragma unroll
            for (int i = 0; i < RUN; ++i) { const size_t t = (size_t)(t0 + i);
                float hh[8], bb[8], cc[8], o[8];
                unpack8(*(const u32x4*)(Z + t * ZC + c0), hh); unpack8(*(const u32x4*)(Z + t * ZC + D + c0), bb); unpack8(*(const u32x4*)(Z + t * ZC + 2 * D + c0), cc);
#pragma unroll
                for (int j = 0; j < 8; ++j) { const float v = cc[j] * hh[j]; o[j] = bb[j] * (w0[j] * vm2[j] + w1[j] * vm1[j] + w2[j] * v); vm2[j] = vm1[j]; vm1[j] = v; }
                *(u32x4*)(UA + t * D + c0) = pack8(o); }
        } else {
            const int r = it - NA; const int cg = r % (DR / 8), run = r / (DR / 8), t0 = run * RUN, c0 = cg * 8;
            float w0[8], w1[8], w2[8], w3[8], bi[8];
            { const float* cw = a->conv_r_w + (size_t)l * 4 * DR + c0; const float* cb = a->conv_r_b + (size_t)l * DR + c0;
#pragma unroll
              for (int j = 0; j < 8; ++j) { w0[j] = cw[j]; w1[j] = cw[DR + j]; w2[j] = cw[2 * DR + j]; w3[j] = cw[3 * DR + j]; bi[j] = cb[j]; } }
            float x3[8], x2[8], x1[8];
            if ((t0 & (SEQ - 1)) == 0) {
#pragma unroll
                for (int j = 0; j < 8; ++j) { x3[j] = 0.f; x2[j] = 0.f; x1[j] = 0.f; }
            } else {
                unpack8(*(const u32x4*)(Z + (size_t)(t0 - 3) * ZC + 3 * D + c0), x3); unpack8(*(const u32x4*)(Z + (size_t)(t0 - 2) * ZC + 3 * D + c0), x2);
                unpack8(*(const u32x4*)(Z + (size_t)(t0 - 1) * ZC + 3 * D + c0), x1);
            }
#pragma unroll
            for (int i = 0; i < RUN; ++i) { const size_t t = (size_t)(t0 + i);
                float x0[8], o[8]; unpack8(*(const u32x4*)(Z + t * ZC + 3 * D + c0), x0);
#pragma unroll
                for (int j = 0; j < 8; ++j) { o[j] = w0[j] * x3[j] + w1[j] * x2[j] + w2[j] * x1[j] + w3[j] * x0[j] + bi[j]; x3[j] = x2[j]; x2[j] = x1[j]; x1[j] = x0[j]; }
                *(u32x4*)(XC + t * DR + c0) = pack8(o); }
        }
    }
}

__device__ __forceinline__ void rg_elem(float rp, float ip, float xc, float c8, float ba, float bx, float& av, float& bv) {
    const float la = -c8 * fsigmoid(rp + ba);
    av = __expf(la);
    const float x = 2.0f * la;
    float em = -x * (1.0f + x * (0.5f + x * (0.16666667f + x * (0.041666668f + x * (0.0083333338f + x * 0.0013888889f)))));
    if (x < -0.4f) em = 1.0f - __expf(x);
    bv = sqrtf(em) * fsigmoid(ip + bx) * xc;
}
template <bool FINAL>
__device__ __forceinline__ void phase_scan(ArgsP a, int l, int half, unsigned char* ws, int gtid, int nthr) {
    const bf16_t* GT = (const bf16_t*)(ws + WS_GT); const bf16_t* XC = (const bf16_t*)(ws + WS_XC); const bf16_t* Z = (const bf16_t*)(ws + WS_Z);
    float* AEND = (float*)(ws + WS_SMALL + SM_AEND); float* HEND = (float*)(ws + WS_SMALL + SM_HEND);
    bf16_t* UR = (bf16_t*)(ws + WS_UR) + (size_t)half * TH * DR;
    constexpr int NP = DR / 2, NITEMS = (TH / SEQ) * NSCH * NP;
    for (int it = gtid; it < NITEMS; it += nthr) {
        const int cp = it % NP, j = (it / NP) % NSCH, bl = it / (NP * NSCH), c = 2 * cp, hh = c >> 7, cc = c & 127, b = half * (TH / SEQ) + bl;
        const float lam0 = a->rg_lambda[(size_t)l * DR + c], lam1 = a->rg_lambda[(size_t)l * DR + c + 1];
        const float c80 = 8.0f * log1pf(__expf(-lam0)), c81 = 8.0f * log1pf(__expf(-lam1));
        const float ba0 = a->b_rg_a[(size_t)l * DR + c], ba1 = a->b_rg_a[(size_t)l * DR + c + 1], bx0 = a->b_rg_x[(size_t)l * DR + c], bx1 = a->b_rg_x[(size_t)l * DR + c + 1];
        float h0 = 0.f, h1 = 0.f, A0 = 1.f, A1 = 1.f;
        if (FINAL) {
            for (int jj = 0; jj < j; ++jj) { const size_t si = ((size_t)b * NSCH + jj) * DR + c; const f32x2 ae = *(const f32x2*)(AEND + si), he = *(const f32x2*)(HEND + si);
                h0 = ae.x * h0 + he.x; h1 = ae.y * h1 + he.y; }
        }
        const size_t row0 = (size_t)bl * SEQ + (size_t)j * SCH;
#pragma unroll 4
        for (int tt = 0; tt < SCH; ++tt) { const size_t row = row0 + tt;
            const unsigned rp = *(const unsigned*)(GT + row * 2560 + hh * 256 + cc), ip = *(const unsigned*)(GT + row * 2560 + hh * 256 + 128 + cc), xc = *(const unsigned*)(XC + row * DR + c);
            float a0, b0, a1, b1; rg_elem(bflo(rp), bflo(ip), bflo(xc), c80, ba0, bx0, a0, b0); rg_elem(bfhi(rp), bfhi(ip), bfhi(xc), c81, ba1, bx1, a1, b1);
            h0 = a0 * h0 + b0; h1 = a1 * h1 + b1;
            if (FINAL) { const unsigned yr = *(const unsigned*)(Z + row * ZC + 3 * D + DR + c);
                *(unsigned*)(UR + row * DR + c) = cvt_pk_bf16(h0 * gelu_tanh(bflo(yr)), h1 * gelu_tanh(bfhi(yr))); }
            else { A0 *= a0; A1 *= a1; }
        }
        if (!FINAL) { const size_t si = ((size_t)b * NSCH + j) * DR + c; *(f32x2*)(AEND + si) = (f32x2){A0, A1}; *(f32x2*)(HEND + si) = (f32x2){h0, h1}; }
    }
}

__device__ __forceinline__ void phase_ln1_router(ArgsP a, int l, unsigned char* ws, LAS unsigned char* lds, int tid, int lane, int gw, int NGW, int vcu) {
    LAS f32x4* wl = (LAS f32x4*)lds;
    for (int idx = tid; idx < 4096; idx += 512) { const int ln = idx & 63, q = (idx >> 6) & 3, jk = idx >> 8, d = 4 * ln + 256 * (jk >> 2) + (jk & 3);
        wl[idx] = *(const f32x4*)(a->w_router + (size_t)d * NE + 4 * q); }
    LAS unsigned* lcnt = (LAS unsigned*)(lds + 65536);
    if (tid < NE) lcnt[tid] = 0u;
    __syncthreads();
    const float* Y = (const float*)(ws + WS_Y); float* X1 = (float*)(ws + WS_X1); bf16_t* XB = (bf16_t*)(ws + WS_XB);
    unsigned* TOKE = (unsigned*)(ws + WS_SMALL + SM_TOKE); unsigned* TOKP = (unsigned*)(ws + WS_SMALL + SM_TOKP); float* TOKW = (float*)(ws + WS_SMALL + SM_TOKW);
    f32x4 gv[4], bv[4];
#pragma unroll
    for (int j = 0; j < 4; ++j) { gv[j] = *(const f32x4*)(a->ln1_g + (size_t)l * D + 4 * lane + 256 * j); bv[j] = *(const f32x4*)(a->ln1_b + (size_t)l * D + 4 * lane + 256 * j); }
    float br[16];
#pragma unroll
    for (int e = 0; e < 16; ++e) br[e] = a->b_router[e];
    for (int t = gw; t < T; t += NGW) {
        f32x4 v[4]; float s = 0.f;
#pragma unroll
        for (int j = 0; j < 4; ++j) { v[j] = *(const f32x4*)(Y + (size_t)t * D + 4 * lane + 256 * j); s += (v[j][0] + v[j][1]) + (v[j][2] + v[j][3]); }
        const float mean = wave_sum(s) * (1.f / D); float s2 = 0.f;
#pragma unroll
        for (int j = 0; j < 4; ++j) { v[j] = v[j] - mean; s2 += (v[j][0] * v[j][0] + v[j][1] * v[j][1]) + (v[j][2] * v[j][2] + v[j][3] * v[j][3]); }
        const float rstd = 1.f / sqrtf(wave_sum(s2) * (1.f / D) + LN_EPS);
        float acc[16];
#pragma unroll
        for (int e = 0; e < 16; ++e) acc[e] = 0.f;
#pragma unroll
        for (int j = 0; j < 4; ++j) { v[j] = v[j] * rstd * gv[j] + bv[j];
            *(f32x4*)(X1 + (size_t)t * D + 4 * lane + 256 * j) = v[j];
            u32x2 w; w.x = cvt_pk_bf16(v[j][0], v[j][1]); w.y = cvt_pk_bf16(v[j][2], v[j][3]); *(u32x2*)(XB + (size_t)t * D + 4 * lane + 256 * j) = w;
#pragma unroll
            for (int k = 0; k < 4; ++k) { const float xv = v[j][k];
#pragma unroll
                for (int q = 0; q < 4; ++q) { const f32x4 w4 = wl[((j * 4 + k) * 4 + q) * 64 + lane]; acc[4 * q] += xv * w4[0]; acc[4 * q + 1] += xv * w4[1]; acc[4 * q + 2] += xv * w4[2]; acc[4 * q + 3] += xv * w4[3]; } } }
        float r8[8], r4[4], r2[2], r1;
        { const bool hi = (lane & 32) != 0;
#pragma unroll
          for (int i = 0; i < 8; ++i) { const float keep = hi ? acc[i + 8] : acc[i], send = hi ? acc[i] : acc[i + 8]; r8[i] = keep + __shfl_xor(send, 32); } }
        { const bool hi = (lane & 16) != 0;
#pragma unroll
          for (int i = 0; i < 4; ++i) { const float keep = hi ? r8[i + 4] : r8[i], send = hi ? r8[i] : r8[i + 4]; r4[i] = keep + __shfl_xor(send, 16); } }
        { const bool hi = (lane & 8) != 0;
#pragma unroll
          for (int i = 0; i < 2; ++i) { const float keep = hi ? r4[i + 2] : r4[i], send = hi ? r4[i] : r4[i + 2]; r2[i] = keep + __shfl_xor(send, 8); } }
        { const bool hi = (lane & 4) != 0; const float keep = hi ? r2[1] : r2[0], send = hi ? r2[0] : r2[1]; r1 = keep + __shfl_xor(send, 4); }
        r1 += __shfl_xor(r1, 2); r1 += __shfl_xor(r1, 1);
        float lg[16]; float mx = -3.0e38f;
#pragma unroll
        for (int e = 0; e < 16; ++e) { lg[e] = __shfl(r1, 4 * e) + br[e]; mx = fmaxf(mx, lg[e]); }
        float p[16];
#pragma unroll
        for (int e = 0; e < 16; ++e) p[e] = __expf(lg[e] - mx);
        int gsel = 0; float gbest = -1.f;
#pragma unroll
        for (int g = 0; g < 4; ++g) { const float p0 = p[4 * g], p1 = p[4 * g + 1], p2 = p[4 * g + 2], p3 = p[4 * g + 3];
            const float sum = (p0 + p1) + (p2 + p3), mn1 = fminf(fminf(p0, p1), fminf(p2, p3));
            const float hi01 = fmaxf(p0, p1), lo01 = fminf(p0, p1), hi23 = fmaxf(p2, p3), lo23 = fminf(p2, p3);
            const float top1 = fmaxf(hi01, hi23), top2 = fmaxf(fminf(hi01, hi23), fmaxf(lo01, lo23));
            (void)sum; (void)mn1;
            const float sc = top1 + top2; if (sc > gbest) { gbest = sc; gsel = g; } }
        float q0, q1, q2, q3;
        q0 = gsel == 0 ? p[0] : gsel == 1 ? p[4] : gsel == 2 ? p[8] : p[12];
        q1 = gsel == 0 ? p[1] : gsel == 1 ? p[5] : gsel == 2 ? p[9] : p[13];
        q2 = gsel == 0 ? p[2] : gsel == 1 ? p[6] : gsel == 2 ? p[10] : p[14];
        q3 = gsel == 0 ? p[3] : gsel == 1 ? p[7] : gsel == 2 ? p[11] : p[15];
        int i1 = 0; float v1 = q0;
        if (q1 > v1) { v1 = q1; i1 = 1; } if (q2 > v1) { v1 = q2; i1 = 2; } if (q3 > v1) { v1 = q3; i1 = 3; }
        int i2 = -1; float v2 = -1.f;
        if (i1 != 0 && q0 > v2) { v2 = q0; i2 = 0; } if (i1 != 1 && q1 > v2) { v2 = q1; i2 = 1; } if (i1 != 2 && q2 > v2) { v2 = q2; i2 = 2; } if (i1 != 3 && q3 > v2) { v2 = q3; i2 = 3; }
        const float inv = 1.0f / (v1 + v2);
        if (lane == 0) { const int e1 = 4 * gsel + i1, e2 = 4 * gsel + i2;
            const unsigned pos1 = __hip_atomic_fetch_add(lcnt + e1, 1u, __ATOMIC_RELAXED, __HIP_MEMORY_SCOPE_WORKGROUP);
            const unsigned pos2 = __hip_atomic_fetch_add(lcnt + e2, 1u, __ATOMIC_RELAXED, __HIP_MEMORY_SCOPE_WORKGROUP);
            TOKE[t] = (unsigned)e1 | ((unsigned)e2 << 8); TOKP[2 * t] = pos1; TOKP[2 * t + 1] = pos2; TOKW[2 * t] = v1 * inv; TOKW[2 * t + 1] = v2 * inv; }
    }
    __syncthreads();
    if (tid < NE) ((unsigned*)(ws + WS_SMALL + SM_WGCNT))[vcu * NE + tid] = lcnt[tid];
}

__device__ __forceinline__ void phase_moe_lists(unsigned char* ws, LAS unsigned char* lds, int tid, int lane, int gw, int NGW, int vcu, int G) {
    unsigned* ctl = (unsigned*)(ws + WS_CTL);
    LAS unsigned* off = (LAS unsigned*)lds;
    { const unsigned* WGCNT = (const unsigned*)(ws + WS_SMALL + SM_WGCNT);
      const int e = tid & 15, p = tid >> 4; unsigned tot = 0, pre = 0;
      for (int v = p; v < G; v += 32) { const unsigned c = WGCNT[v * NE + e]; tot += c; pre += (v < vcu) ? c : 0u; }
      off[128 + p * 16 + e] = tot; off[128 + 512 + p * 16 + e] = pre; }
    __syncthreads();
    if (tid < NE) { unsigned tot = 0, pre = 0; for (int p = 0; p < 32; ++p) { tot += off[128 + p * 16 + tid]; pre += off[128 + 512 + p * 16 + tid]; } off[32 + tid] = tot; off[48 + tid] = pre; }
    __syncthreads();
    if (tid == 0) { unsigned o = 0;
        for (int e = 0; e < NE; ++e) { const unsigned c = off[32 + e]; off[e] = o; off[64 + e] = o + off[48 + e]; o += (c + 255u) & ~255u; }
        off[16] = o; }
    __syncthreads();
    int* ROWINFO = (int*)(ws + WS_SMALL + SM_ROWINFO);
    if (blockIdx.x == 0) {
        if (tid == 0) ctl[CW_NTILES] = off[16] >> 8;
        if (tid < NE) { const unsigned t0 = off[tid] >> 8, t1 = off[tid + 1] >> 8; for (unsigned tt = t0; tt < t1; ++tt) ctl[CW_TILEE + tt] = (unsigned)tid; }
        for (int e = 0; e < NE; ++e) { const unsigned p0 = off[e] + off[32 + e], p1 = off[e + 1]; for (unsigned r = p0 + tid; r < p1; r += 512) ROWINFO[r] = -1; }
    }
    const bf16_t* XB = (const bf16_t*)(ws + WS_XB); bf16_t* XG = (bf16_t*)(ws + WS_XG);
    const unsigned* TOKE = (const unsigned*)(ws + WS_SMALL + SM_TOKE); const unsigned* TOKP = (const unsigned*)(ws + WS_SMALL + SM_TOKP);
    for (int t = gw; t < T; t += NGW) {
        const unsigned ee = TOKE[t]; const unsigned r1 = off[64 + (ee & 255u)] + TOKP[2 * t], r2 = off[64 + ((ee >> 8) & 255u)] + TOKP[2 * t + 1];
        const u32x4 v0 = *(const u32x4*)(XB + (size_t)t * D + 8 * lane), v1 = *(const u32x4*)(XB + (size_t)t * D + 512 + 8 * lane);
        *(u32x4*)(XG + (size_t)r1 * D + 8 * lane) = v0; *(u32x4*)(XG + (size_t)r1 * D + 512 + 8 * lane) = v1;
        *(u32x4*)(XG + (size_t)r2 * D + 8 * lane) = v0; *(u32x4*)(XG + (size_t)r2 * D + 512 + 8 * lane) = v1;
        if (lane == 0) { ROWINFO[r1] = 2 * t; ROWINFO[r2] = 2 * t + 1; }
    }
}

__device__ __forceinline__ void phase_ln2(ArgsP a, int l, unsigned char* ws, float* out, int lane, int gw, int NGW) {
    const float* X1 = (const float*)(ws + WS_X1); const bf16_t* O = (const bf16_t*)(ws + WS_O); bf16_t* XB = (bf16_t*)(ws + WS_XB);
    const float* TOKW = (const float*)(ws + WS_SMALL + SM_TOKW);
    f32x4 gv[4], bv[4];
#pragma unroll
    for (int j = 0; j < 4; ++j) { gv[j] = *(const f32x4*)(a->ln2_g + (size_t)l * D + 4 * lane + 256 * j); bv[j] = *(const f32x4*)(a->ln2_b + (size_t)l * D + 4 * lane + 256 * j); }
    for (int t = gw; t < T; t += NGW) {
        const float w1 = TOKW[2 * t], w2 = TOKW[2 * t + 1];
        f32x4 v[4]; float s = 0.f;
#pragma unroll
        for (int j = 0; j < 4; ++j) { const f32x4 x = *(const f32x4*)(X1 + (size_t)t * D + 4 * lane + 256 * j);
            const u32x2 o1 = *(const u32x2*)(O + (size_t)(2 * t) * D + 4 * lane + 256 * j), o2 = *(const u32x2*)(O + (size_t)(2 * t + 1) * D + 4 * lane + 256 * j);
            f32x4 mo; mo[0] = w1 * bflo(o1.x) + w2 * bflo(o2.x); mo[1] = w1 * bfhi(o1.x) + w2 * bfhi(o2.x); mo[2] = w1 * bflo(o1.y) + w2 * bflo(o2.y); mo[3] = w1 * bfhi(o1.y) + w2 * bfhi(o2.y);
            v[j] = x * DN_ALPHA + mo; s += (v[j][0] + v[j][1]) + (v[j][2] + v[j][3]); }
        const float mean = wave_sum(s) * (1.f / D); float s2 = 0.f;
#pragma unroll
        for (int j = 0; j < 4; ++j) { v[j] = v[j] - mean; s2 += (v[j][0] * v[j][0] + v[j][1] * v[j][1]) + (v[j][2] * v[j][2] + v[j][3] * v[j][3]); }
        const float rstd = 1.f / sqrtf(wave_sum(s2) * (1.f / D) + LN_EPS);
#pragma unroll
        for (int j = 0; j < 4; ++j) { v[j] = v[j] * rstd * gv[j] + bv[j];
            *(f32x4*)(out + (size_t)t * D + 4 * lane + 256 * j) = v[j];
            u32x2 w; w.x = cvt_pk_bf16(v[j][0], v[j][1]); w.y = cvt_pk_bf16(v[j][2], v[j][3]); *(u32x2*)(XB + (size_t)t * D + 4 * lane + 256 * j) = w; }
    }
}

constexpr int STEPS_PER_LAYER = 5 * NCHUNK + 8;
constexpr int N_STEPS = 1 + DEPTH * STEPS_PER_LAYER;

__global__ void __launch_bounds__(512, 2) mk_fwd(Args args_by_value) {
    (void)args_by_value;
    extern __shared__ __attribute__((aligned(16))) unsigned char lds_raw[];
    LAS unsigned char* lds = (LAS unsigned char*)lds_raw;
    volatile LAS unsigned* MISC = (volatile LAS unsigned*)(lds + MISC_OFF);
    const int tid0 = threadIdx.x;
    const int G = gridDim.x; const int bx = blockIdx.x; const int vcu0 = (G % 8 == 0) ? (bx % 8) * (G / 8) + bx / 8 : bx;
    const int NGW = G * 8, nthr = G * 512;
    ArgsP ap0 = (ArgsP)__builtin_amdgcn_kernarg_segment_ptr();
    unsigned char* ws0 = ap0->ws;
    unsigned* ctl = (unsigned*)(ws0 + WS_CTL);
    for (int u = tid0; u < (LDS_BYTES - LDSCTL_OFF) / 4; u += 512) ((LAS unsigned*)(lds + LDSCTL_OFF))[u] = 0u;
    __syncthreads();
    XcdBarrier bar; bar.bar = ctl + CW_BAR; bar.x = 0; bar.st = nullptr;
    if (!MK_PER_STEP_LAUNCH) bar = xcd_barrier_post(ctl + CW_BAR, MISC + 8);
    const int lo = ap0->ph_lo, hi = ap0->ph_hi;
    int step = 0;
#ifndef MK_MASK
#define MK_MASK 0xFFFFFFFFu
#endif
#ifndef MK_REPEAT
#define MK_REPEAT 0u
#endif
#ifndef MK_BAR2
#define MK_BAR2 0
#endif
#define STEP_BEGIN(id) if (((MK_MASK >> (id)) & 1u) && lo <= step && step < hi) { for (int rep = 0; rep < 1 + (int)((MK_REPEAT >> (id)) & 1u); ++rep) { if (rep) __syncthreads(); unsigned char* ws = ws0; asm volatile("" : "+s"(ws)); ArgsP args = ap0; asm volatile("" : "+s"(args)); int tid = tid0; asm volatile("" : "+v"(tid)); int vcu = vcu0; asm volatile("" : "+s"(vcu)); \
    const int lane = tid & 63, wave = __builtin_amdgcn_readfirstlane(tid >> 6), gw = vcu * 8 + wave, gtid = vcu * 512 + tid; LAS float* scr = (LAS float*)(lds + wave * 16384); (void)lane; (void)gw; (void)gtid; (void)scr;
#define STEP_END   } if (step + 1 < hi) { if (MK_PER_STEP_LAUNCH) {} else { xcd_barrier(bar); if (MK_BAR2) xcd_barrier(bar); } } } ++step;

    STEP_BEGIN(0)
        prep_tm_weights(args, 0, ws, scr, gw, NGW, lane);
        cvt_x(args->x, (bf16_t*)(ws + WS_XB), gtid, nthr);
    STEP_END

#pragma unroll 1
    for (int l = 0; l < DEPTH; ++l) {

#pragma unroll 1
        for (int half = 0; half < NCHUNK; ++half) {
            STEP_BEGIN(1)
                pg8::SchedPlain S{TH / 256, DIN / 256, G, bx, (const char*)(ws + WS_XB) + (size_t)half * TH * D * 2, (const char*)(ws + WS_WIN), (size_t)256 * D * 2, (size_t)256 * D * 2, 0};
                pg8::EpiZ E{(bf16_t*)(ws + WS_Z), (bf16_t*)(ws + WS_GG), half * TH};
                pg8::gemm_phase<pg8::EpiZ, pg8::SchedPlain, true>(lds, D, D, D, S, E);
            STEP_END
            STEP_BEGIN(2)
                phase_e1(args, l, half, ws, gtid, nthr);
            STEP_END
            STEP_BEGIN(3)
                pg8::SchedPlain S{TH / 256, NHEAD, G, bx, (const char*)(ws + WS_XC), (const char*)(ws + WS_WG), (size_t)256 * DR * 2, (size_t)256 * 128 * 2, (size_t)128 * 2};
                pg8::EpiBf16 E{(bf16_t*)(ws + WS_GT), 2560};
                pg8::gemm_phase<pg8::EpiBf16, pg8::SchedPlain, true>(lds, DR, 128, 128, S, E);
            STEP_END
            STEP_BEGIN(4)
                phase_scan<false>(args, l, half, ws, gtid, nthr);
            STEP_END
            STEP_BEGIN(5)
                phase_scan<true>(args, l, half, ws, gtid, nthr);
            STEP_END
        }
        STEP_BEGIN(6)
            pg8::SchedPlain S{T / 256, D / 256, G, bx, (const char*)(ws + WS_UA), (const char*)(ws + WS_WA), (size_t)256 * D * 2, (size_t)256 * D * 2, 0};
            pg8::EpiYa E{(float*)(ws + WS_STASH), (const bf16_t*)(ws + WS_GG)};
            pg8::gemm_phase<pg8::EpiYa, pg8::SchedPlain, true>(lds, D, D, D, S, E);
        STEP_END
        STEP_BEGIN(7)
            pg8::SchedPlain S{T / 256, D / 256, G, bx, (const char*)(ws + WS_UR), (const char*)(ws + WS_WR), (size_t)256 * DR * 2, (size_t)256 * DR * 2, 0};
            pg8::EpiMerged E{(const float*)(ws + WS_STASH), (const bf16_t*)(ws + WS_GG), (bf16_t*)(ws + WS_MERGED)};
            pg8::gemm_phase<pg8::EpiMerged, pg8::SchedPlain, true>(lds, DR, DR, DR, S, E);
        STEP_END
        STEP_BEGIN(8)
            pg8::SchedPlain S{T / 256, D / 256, G, bx, (const char*)(ws + WS_MERGED), (const char*)(ws + WS_WO), (size_t)256 * D * 2, (size_t)256 * D * 2, 0};
            pg8::EpiY E{(l == 0) ? args->x : (const float*)args->out, (float*)(ws + WS_Y)};
            pg8::gemm_phase<pg8::EpiY, pg8::SchedPlain, true>(lds, D, D, D, S, E);
        STEP_END
        STEP_BEGIN(9)
            prep_expert_weights(args, l, ws, scr, gw, NGW, lane);
            __syncthreads();
            if (rep == 0) phase_ln1_router(args, l, ws, lds, tid, lane, gw, NGW, vcu);
        STEP_END
        STEP_BEGIN(10)
            phase_moe_lists(ws, lds, tid, lane, gw, NGW, vcu, G);
            __syncthreads();
            if (l + 1 < DEPTH) prep_tm_weights(args, l + 1, ws, scr, gw, NGW, lane);
        STEP_END
        STEP_BEGIN(11)
            const int ntiles = (int)__hip_atomic_load(ctl + CW_NTILES, __ATOMIC_RELAXED, __HIP_MEMORY_SCOPE_AGENT);
            pg8::SchedMoe S{ntiles, 4, G, bx, (const char*)(ws + WS_XG), (const char*)(ws + WS_WEX), (size_t)256 * D * 2, (size_t)256 * D * 2, (size_t)1024 * 1024 * 2, ctl + CW_TILEE};
            pg8::EpiH E{(bf16_t*)(ws + WS_H)};
            pg8::gemm_phase<pg8::EpiH, pg8::SchedMoe, true>(lds, D, D, D, S, E);
        STEP_END
        STEP_BEGIN(12)
            const int ntiles = (int)__hip_atomic_load(ctl + CW_NTILES, __ATOMIC_RELAXED, __HIP_MEMORY_SCOPE_AGENT);
            pg8::SchedMoe S{ntiles, 4, G, bx, (const char*)(ws + WS_H), (const char*)(ws + WS_WEX) + (size_t)NE * 1024 * 1024 * 2, (size_t)256 * FF * 2, (size_t)256 * FF * 2, (size_t)1024 * 512 * 2, ctl + CW_TILEE};
            pg8::EpiO E{(bf16_t*)(ws + WS_O), (const int*)(ws + WS_SMALL + SM_ROWINFO)};
            pg8::gemm_phase<pg8::EpiO, pg8::SchedMoe, true>(lds, FF, FF, FF, S, E);
        STEP_END
        STEP_BEGIN(13)
            phase_ln2(args, l, ws, args->out, lane, gw, NGW);
        STEP_END
    }
#undef STEP_BEGIN
#undef STEP_END
}

extern "C" void kernel_launch(void* const* d_in, const int* in_sizes, int n_in, void* d_out, int out_size, void* d_ws, size_t ws_size, hipStream_t stream) {
    static int grid = 0;
    if (grid == 0) {
        if (n_in != 22 || in_sizes[0] != T * D || out_size != T * D || ws_size < WS_NEED) {
            fprintf(stderr, "kernel_launch: unexpected shapes (n_in %d, in0 %d, out %d, ws %zu, need %zu); nothing launched\n", n_in, n_in > 0 ? in_sizes[0] : -1, out_size, ws_size, (size_t)WS_NEED); grid = -1; return; }
        int dev = 0, cus = 0, per_cu = 0;
        if (hipGetDevice(&dev) != hipSuccess || hipDeviceGetAttribute(&cus, hipDeviceAttributeMultiprocessorCount, dev) != hipSuccess) { grid = -1; return; }
        if (hipFuncSetAttribute((const void*)mk_fwd, hipFuncAttributeMaxDynamicSharedMemorySize, LDS_BYTES) != hipSuccess) { fprintf(stderr, "kernel_launch: hipFuncSetAttribute failed\n"); grid = -1; return; }
        if (hipOccupancyMaxActiveBlocksPerMultiprocessor(&per_cu, (const void*)mk_fwd, 512, LDS_BYTES) != hipSuccess || per_cu < 1) { fprintf(stderr, "kernel_launch: occupancy query says %d blocks per CU\n", per_cu); per_cu = 1; }
        (void)hipGetLastError();
        grid = cus;
    }
    if (grid < 0) return;
    (void)hipMemsetAsync((char*)d_ws + WS_CTL, 0, CTL_ZERO_BYTES, stream);
    Args a{};
    const float** p = (const float**)&a;
    for (int i = 0; i < 22; ++i) p[i] = (const float*)d_in[i];
    a.out = (float*)d_out; a.ws = (unsigned char*)d_ws;
#if MK_PER_STEP_LAUNCH
    for (int s = 0; s < N_STEPS; ++s) { a.ph_lo = s; a.ph_hi = s + 1; hipLaunchKernelGGL(mk_fwd, dim3(grid), dim3(512), LDS_BYTES, stream, a); }
#else
    a.ph_lo = 0; a.ph_hi = N_STEPS;
    hipLaunchKernelGGL(mk_fwd, dim3(grid), dim3(512), LDS_BYTES, stream, a);
#endif
}
```

```cpp
#include <hip/hip_runtime.h>
#include <cstdio>
#include <cstdint>

#ifndef MK_PER_STEP_LAUNCH
#define MK_PER_STEP_LAUNCH 0
#endif

#define LAS __attribute__((address_space(3)))
typedef unsigned short bf16_t;
typedef short bf16x8 __attribute__((ext_vector_type(8)));
typedef float f32x4 __attribute__((ext_vector_type(4)));
typedef float f32x2 __attribute__((ext_vector_type(2)));
typedef unsigned u32x4 __attribute__((ext_vector_type(4)));
typedef unsigned u32x2 __attribute__((ext_vector_type(2)));

constexpr int D = 1024, T = 16384, SEQ = 4096, NBATCH = 4, DR = 1280, NHEAD = 10, DIN = 7680, NE = 16, FF = 512, DEPTH = 2;
constexpr int NCHUNK = 2, TH = T / NCHUNK;
constexpr int ZC = 4608;
constexpr int GGC = 2048;
constexpr int SCH = 64, NSCH = SEQ / SCH;
constexpr int MOE_ROWS = 36864, MOE_TILES = MOE_ROWS / 256;
constexpr float LN_EPS = 1e-5f;
constexpr float DN_ALPHA = 1.4142135623730951f;

constexpr size_t MiB = 1u << 20;
constexpr size_t WS_CTL = 0, CTL_ZERO_BYTES = 128 * 1024;
constexpr size_t WS_WIN = 1 * MiB;
constexpr size_t WS_WA = 16 * MiB;
constexpr size_t WS_WR = 18 * MiB;
constexpr size_t WS_WO = 21 * MiB;
constexpr size_t WS_WG = 23 * MiB;
constexpr size_t WS_XB = 24 * MiB;
constexpr size_t WS_UA = 56 * MiB;
constexpr size_t WS_UR = 88 * MiB;
constexpr size_t WS_GG = 128 * MiB;
constexpr size_t WS_Z = 192 * MiB;
constexpr size_t WS_XC = 280 * MiB;
constexpr size_t WS_GT = 300 * MiB;
constexpr size_t WS_SMALL = 340 * MiB;
constexpr size_t WS_STASH = 192 * MiB;
constexpr size_t WS_MERGED = 256 * MiB;
constexpr size_t WS_Y = 56 * MiB;
constexpr size_t WS_X1 = 128 * MiB;
constexpr size_t WS_WEX = 192 * MiB;
constexpr size_t WS_XG = 240 * MiB;
constexpr size_t WS_H = 56 * MiB;
constexpr size_t WS_O = 240 * MiB;
constexpr size_t WS_NEED = 344 * MiB + 512 * 1024;
constexpr size_t SM_AEND = 0;
constexpr size_t SM_HEND = SM_AEND + (size_t)NBATCH * NSCH * DR * 4;
constexpr size_t SM_TOKE = SM_HEND + (size_t)NBATCH * NSCH * DR * 4;
constexpr size_t SM_TOKP = SM_TOKE + (size_t)T * 4;
constexpr size_t SM_TOKW = SM_TOKP + (size_t)T * 8;
constexpr size_t SM_ROWINFO = SM_TOKW + (size_t)T * 8;
constexpr size_t SM_WGCNT = SM_ROWINFO + (size_t)MOE_ROWS * 4;
constexpr size_t SM_PCONST = SM_WGCNT + 256 * 16 * 4;
constexpr size_t SM_END = SM_PCONST + 3 * 1280 * 4;
static_assert(WS_SMALL + SM_END <= WS_NEED, "small region");
constexpr int CW_BAR = 4096;
constexpr int CW_CNT = 8192;
constexpr int CW_NTILES = 8256;
constexpr int CW_TILEE = 8320;

constexpr int RING_BYTES = 131072;
constexpr int LDSCTL_OFF = RING_BYTES, MISC_OFF = LDSCTL_OFF + 320;
constexpr int LDS_BYTES = 147456;

__device__ __forceinline__ unsigned cvt_pk_bf16(float lo, float hi) { unsigned r; asm volatile("v_cvt_pk_bf16_f32 %0, %1, %2" : "=v"(r) : "v"(lo), "v"(hi)); return r; }
__device__ __forceinline__ float bflo(unsigned w) { return __uint_as_float(w << 16); }
__device__ __forceinline__ float bfhi(unsigned w) { return __uint_as_float(w & 0xffff0000u); }
__device__ __forceinline__ float bf1(bf16_t b) { return __uint_as_float((unsigned)b << 16); }
__device__ __forceinline__ float fsigmoid(float x) { return __fdividef(1.0f, 1.0f + __expf(-x)); }
__device__ __forceinline__ float gelu_tanh(float y) { const float u = 1.5957691216057308f * (y + 0.044715f * y * y * y); return y * fsigmoid(u); }
__device__ __forceinline__ float wave_sum(float v) {
#pragma unroll
    for (int o = 1; o < 64; o <<= 1) v += __shfl_xor(v, o);
    return v;
}
#define LDS_WAIT() asm volatile("s_waitcnt lgkmcnt(0)" ::: "memory")
#define VM_WAIT() asm volatile("s_waitcnt vmcnt(0)" ::: "memory")

namespace pg8 {
constexpr int BM = 256, BK = 64, HALF = 128, HTB = HALF * BK * 2, STAGE_BYTES = 8 * HTB, NXCD = 8, WGM = 8;
__host__ __device__ __forceinline__ int lds_byte(int r, int c) { const int st = (r >> 4) * 2 + (c >> 5), rr = r & 15, cc = c & 31, ob = rr * 64 + cc * 2; return st * 1024 + (ob ^ (((ob >> 9) & 1) << 5)); }
__host__ __device__ __forceinline__ void stage_rc(int b, int& R, int& C) { const int st = b / 1024, sb = b % 1024, swz = sb ^ (((sb >> 9) & 1) << 5); R = (st >> 1) * 16 + swz / 64; C = (st & 1) * 32 + (swz % 64) / 2; }
__host__ __device__ __forceinline__ int perm32(int rho) { const int n = rho >> 4, i = rho & 15; return 8 * (i >> 2) + 4 * n + (i & 3); }

struct Unit { const char* a; const char* b; int pm, pn; };

__device__ __forceinline__ bool static_order(int i, int G, int c, int nM, int nN, int& pm, int& pn) {
    const int nwg = nM * nN; const long L = (long)i * G + c; if (L >= nwg) return false;
    int wgid = (int)L; { const int q = nwg / NXCD, r = nwg % NXCD, xcd = wgid % NXCD, off = wgid / NXCD; wgid = (xcd < r ? xcd * (q + 1) : r * (q + 1) + (xcd - r) * q) + off; }
    const int nig = WGM * nN, gid = wgid / nig, fm = gid * WGM, gsz = (nM - fm) < WGM ? (nM - fm) : WGM;
    pm = fm + ((wgid % nig) % gsz); pn = (wgid % nig) / gsz; return true;
}
struct SchedPlain {
    int nM, nN, G, c; const char* A; const char* B; size_t a_tile, b_tile, a_pn;
    __device__ __forceinline__ bool next(int i, Unit& u) const {
        int pm, pn; if (!static_order(i, G, c, nM, nN, pm, pn)) return false;
        u.pm = pm; u.pn = pn; u.a = A + (size_t)pm * a_tile + (size_t)pn * a_pn; u.b = B + (size_t)pn * b_tile; return true;
    }
};
struct SchedMoe {
    int nM, nN, G, c; const char* A; const char* B; size_t a_tile, b_tile, b_exp; const unsigned* tile_e;
    __device__ __forceinline__ bool next(int i, Unit& u) const {
        int pm, pn; if (!static_order(i, G, c, nM, nN, pm, pn)) return false;
        const int e = __builtin_amdgcn_readfirstlane((int)__hip_atomic_load(tile_e + pm, __ATOMIC_RELAXED, __HIP_MEMORY_SCOPE_AGENT));
        u.pm = pm; u.pn = pn; u.a = A + (size_t)pm * a_tile; u.b = B + (size_t)e * b_exp + (size_t)pn * b_tile; return true;
    }
};

template <class Epi, class Sched, bool ALIGN_EPI>
__device__ __forceinline__ void gemm_phase(LAS unsigned char* lds, const int lda, const int ldb, const int K, const Sched& S, const Epi& E) {
    int tid = threadIdx.x; asm volatile("" : "+v"(tid));
    const int wid = __builtin_amdgcn_readfirstlane(tid >> 6), lane = tid & 63, wr = wid >> 2, wc = wid & 3, fr = lane & 15, fq = lane >> 4;
    int Kop = K; asm volatile("" : "+s"(Kop));
    const int nt = Kop / BK;
    unsigned voffA[2], voffB[2];
#pragma unroll
    for (int i = 0; i < 2; ++i) { int R, C; stage_rc(tid * 16 + i * 8192, R, C); const int Rb = Epi::PERM ? ((R & ~31) + perm32(R & 31)) : R;
        voffA[i] = (unsigned)(R * lda + C) * 2u; voffB[i] = (unsigned)(Rb * ldb + C) * 2u; }
    const size_t kstep = (size_t)(BK * 2);
    const size_t hstepA = (size_t)HALF * lda * 2, hstepB = (size_t)HALF * ldb * 2;
    const unsigned ldsw = (unsigned)wid * 1024u;
    const int aoff = lds_byte(wr * 64 + fr, fq * 8), boff = lds_byte(wc * 32 + fr, fq * 8);
#define PG8_SA(b, h) (((b) * 2 + (h)) * HTB)
#define PG8_SB(b, h) ((4 + (b) * 2 + (h)) * HTB)
#define PG8_STAGE(bufoff, gbase, voff) do { _Pragma("unroll") for (int _i = 0; _i < 2; ++_i) \
        __builtin_amdgcn_global_load_lds((const unsigned*)((const char*)(gbase) + (voff)[_i]), (LAS unsigned*)(lds + (bufoff) + ldsw + _i * 8192), 16, 0, 0); } while (0)
#define PG8_LDA(dst, b, h) do { _Pragma("unroll") for (int m = 0; m < 4; ++m) _Pragma("unroll") for (int k = 0; k < 2; ++k) dst[m][k] = *(const LAS bf16x8*)(lds + PG8_SA(b, h) + aoff + m * 2048 + k * 1024); } while (0)
#define PG8_LDB(dst, b, h) do { _Pragma("unroll") for (int n = 0; n < 2; ++n) _Pragma("unroll") for (int k = 0; k < 2; ++k) dst[n][k] = *(const LAS bf16x8*)(lds + PG8_SB(b, h) + boff + n * 2048 + k * 1024); } while (0)
#define PG8_MMA(ai, bj, At, Bt) do { __builtin_amdgcn_s_setprio(1); _Pragma("unroll") for (int m = 0; m < 4; ++m) _Pragma("unroll") for (int n = 0; n < 2; ++n) _Pragma("unroll") for (int k = 0; k < 2; ++k) \
        acc[ai][bj][m][n] = __builtin_amdgcn_mfma_f32_16x16x32_bf16(Bt[n][k], At[m][k], acc[ai][bj][m][n], 0, 0, 0); __builtin_amdgcn_s_setprio(0); } while (0)
#define PG8_WAIT_V(n) asm volatile("s_waitcnt vmcnt(" #n ")" ::: "memory")
#define PG8_WAIT_L(n) asm volatile("s_waitcnt lgkmcnt(" #n ")" ::: "memory")
#define PG8_BAR __builtin_amdgcn_s_barrier()
#define PG8_SCHED __builtin_amdgcn_sched_barrier(0)
    Unit cur, nxt; int ui = 0;
    if (!S.next(0, cur)) return;
    f32x4 acc[2][2][4][2];
#pragma unroll
    for (int a = 0; a < 2; ++a)
#pragma unroll
        for (int b = 0; b < 2; ++b)
#pragma unroll
            for (int m = 0; m < 4; ++m)
#pragma unroll
                for (int n = 0; n < 2; ++n) acc[a][b][m][n] = (f32x4){0.f, 0.f, 0.f, 0.f};
    bf16x8 At[4][2], B0[2][2], B1[2][2];
    const char* cA = cur.a; const char* cB = cur.b;
    PG8_STAGE(PG8_SB(0, 0), cB, voffB); PG8_STAGE(PG8_SB(0, 1), cB + hstepB, voffB); PG8_STAGE(PG8_SA(0, 0), cA, voffA); PG8_STAGE(PG8_SA(0, 1), cA + hstepA, voffA);
    if (wr == 1) PG8_BAR;
    PG8_WAIT_V(2); PG8_BAR;
    PG8_STAGE(PG8_SB(1, 0), cB + kstep, voffB); PG8_STAGE(PG8_SA(1, 0), cA + kstep, voffA); PG8_STAGE(PG8_SB(1, 1), cB + hstepB + kstep, voffB);
    PG8_WAIT_V(6); PG8_BAR;
    for (;;) {
        const bool has_next = S.next(ui + 1, nxt);
        const char* nA = has_next ? nxt.a : cA; const char* nB = has_next ? nxt.b : cB;
        for (int t = 0; t < nt; t += 2) {
            const bool last = (t == nt - 2);
            const char* a1 = cA + (size_t)(t + 1) * kstep;
            const char* a2 = last ? nA : cA + (size_t)(t + 2) * kstep; const char* b2 = last ? nB : cB + (size_t)(t + 2) * kstep;
            const char* a3 = a2 + kstep; const char* b3 = b2 + kstep;
            PG8_LDB(B0, 0, 0); PG8_LDB(B1, 0, 1); PG8_SCHED; PG8_LDA(At, 0, 0); PG8_STAGE(PG8_SA(1, 1), a1 + hstepA, voffA);
            PG8_WAIT_V(8); PG8_WAIT_L(0); PG8_BAR; PG8_MMA(0, 0, At, B0); PG8_MMA(0, 1, At, B1); PG8_BAR; PG8_SCHED;
            PG8_LDA(At, 0, 1); PG8_STAGE(PG8_SB(0, 0), b2, voffB); PG8_STAGE(PG8_SB(0, 1), b2 + hstepB, voffB); PG8_STAGE(PG8_SA(0, 0), a2, voffA);
            PG8_WAIT_V(8); PG8_WAIT_L(0); PG8_BAR; PG8_MMA(1, 0, At, B0); PG8_MMA(1, 1, At, B1); PG8_BAR; PG8_SCHED;
            PG8_LDB(B0, 1, 0); PG8_LDB(B1, 1, 1); PG8_SCHED; PG8_LDA(At, 1, 0); PG8_STAGE(PG8_SA(0, 1), a2 + hstepA, voffA);
            PG8_WAIT_V(8); PG8_WAIT_L(0); PG8_BAR; PG8_MMA(0, 0, At, B0); PG8_MMA(0, 1, At, B1); PG8_BAR; PG8_SCHED;
            PG8_LDA(At, 1, 1); PG8_STAGE(PG8_SB(1, 0), b3, voffB); PG8_STAGE(PG8_SB(1, 1), b3 + hstepB, voffB); PG8_STAGE(PG8_SA(1, 0), a3, voffA);
            PG8_WAIT_V(8); PG8_WAIT_L(0); PG8_BAR; PG8_MMA(1, 0, At, B0); PG8_MMA(1, 1, At, B1); PG8_BAR; PG8_SCHED;
        }
        if constexpr (ALIGN_EPI) { if (wr == 0) PG8_BAR; }
        E(acc, cur, wr, wc, fr, fq);
        if (!has_next) break;
#pragma unroll
        for (int a = 0; a < 2; ++a)
#pragma unroll
            for (int b = 0; b < 2; ++b)
#pragma unroll
                for (int m = 0; m < 4; ++m)
#pragma unroll
                    for (int n = 0; n < 2; ++n) acc[a][b][m][n] = (f32x4){0.f, 0.f, 0.f, 0.f};
        cur = nxt; cA = nA; cB = nB; ++ui;
        if constexpr (ALIGN_EPI) { if (wr == 1) PG8_BAR; }
    }
    PG8_WAIT_V(0);
    if constexpr (!ALIGN_EPI) { if (wr == 0) PG8_BAR; }
    PG8_BAR;
#undef PG8_SA
#undef PG8_SB
#undef PG8_STAGE
#undef PG8_LDA
#undef PG8_LDB
#undef PG8_MMA
#undef PG8_WAIT_V
#undef PG8_WAIT_L
#undef PG8_BAR
#undef PG8_SCHED
}

typedef const f32x4 (&AccRef)[2][2][4][2];
#define EPI_LOOP_ROWS for (int ai = 0; ai < 2; ++ai) _Pragma("unroll") for (int m = 0; m < 4; ++m)

struct EpiZ {
    static constexpr bool PERM = true;
    bf16_t* Z; bf16_t* GG; int row_base;
    __device__ __forceinline__ void operator()(AccRef acc, const Unit& u, int wr, int wc, int fr, int fq) const {
        const int row0 = u.pm * BM + wr * 64 + fr;
        if (u.pn < 8) {
            bf16_t* base = Z + u.pn * HALF + wc * 32 + 8 * fq;
#pragma unroll
            EPI_LOOP_ROWS { const f32x4 h0 = acc[ai][0][m][0], h1 = acc[ai][0][m][1], c0 = acc[ai][1][m][0], c1 = acc[ai][1][m][1];
                u32x4 w; w.x = cvt_pk_bf16(h0[0] * c0[0], h0[1] * c0[1]); w.y = cvt_pk_bf16(h0[2] * c0[2], h0[3] * c0[3]); w.z = cvt_pk_bf16(h1[0] * c1[0], h1[1] * c1[1]); w.w = cvt_pk_bf16(h1[2] * c1[2], h1[3] * c1[3]);
                *(u32x4*)(base + (size_t)(row0 + ai * HALF + m * 16) * ZC) = w; }
        } else {
            const int colt = u.pn * BM + wc * 32 + 8 * fq; const int act = u.pn < 17 ? 0 : (u.pn < 22 ? 1 : 2);
            bf16_t* base; size_t ldc;
            if (u.pn < 22) { base = Z + (colt - 1024); ldc = ZC; } else { base = GG + (size_t)row_base * GGC + (colt - 5632); ldc = GGC; }
#pragma unroll
            EPI_LOOP_ROWS { bf16_t* rowp = base + (size_t)(row0 + ai * HALF + m * 16) * ldc;
#pragma unroll
                for (int bj = 0; bj < 2; ++bj) { f32x4 v0 = acc[ai][bj][m][0], v1 = acc[ai][bj][m][1];
                    if (act == 1) {
#pragma unroll
                        for (int j = 0; j < 4; ++j) { v0[j] = gelu_tanh(v0[j]); v1[j] = gelu_tanh(v1[j]); } }
                    else if (act == 2) {
#pragma unroll
                        for (int j = 0; j < 4; ++j) { v0[j] = fsigmoid(v0[j]); v1[j] = fsigmoid(v1[j]); } }
                    u32x4 w; w.x = cvt_pk_bf16(v0[0], v0[1]); w.y = cvt_pk_bf16(v0[2], v0[3]); w.z = cvt_pk_bf16(v1[0], v1[1]); w.w = cvt_pk_bf16(v1[2], v1[3]);
                    *(u32x4*)(rowp + bj * HALF) = w; } }
        }
    }
};
struct EpiBf16 {
    static constexpr bool PERM = true;
    bf16_t* O; int ldc;
    __device__ __forceinline__ void operator()(AccRef acc, const Unit& u, int wr, int wc, int fr, int fq) const {
        const int row0 = u.pm * BM + wr * 64 + fr; const int colt = u.pn * BM + wc * 32 + 8 * fq;
#pragma unroll
        EPI_LOOP_ROWS { bf16_t* rowp = O + (size_t)(row0 + ai * HALF + m * 16) * ldc + colt;
#pragma unroll
            for (int bj = 0; bj < 2; ++bj) { const f32x4 v0 = acc[ai][bj][m][0], v1 = acc[ai][bj][m][1];
                u32x4 w; w.x = cvt_pk_bf16(v0[0], v0[1]); w.y = cvt_pk_bf16(v0[2], v0[3]); w.z = cvt_pk_bf16(v1[0], v1[1]); w.w = cvt_pk_bf16(v1[2], v1[3]);
                *(u32x4*)(rowp + bj * HALF) = w; } }
    }
};
struct EpiRG {
    static constexpr bool PERM = true;
    bf16_t* GT; const bf16_t* XC; const float* PC;
    __device__ __forceinline__ void operator()(AccRef acc, const Unit& u, int wr, int wc, int fr, int fq) const {
        const int row0 = u.pm * BM + wr * 64 + fr; const int cc = wc * 32 + 8 * fq, ch = u.pn * HALF + cc;
        float c8[8], ba[8], bx[8];
        { const f32x4 a0 = *(const f32x4*)(PC + ch), a1 = *(const f32x4*)(PC + ch + 4), b0 = *(const f32x4*)(PC + DR + ch), b1 = *(const f32x4*)(PC + DR + ch + 4), x0 = *(const f32x4*)(PC + 2 * DR + ch), x1 = *(const f32x4*)(PC + 2 * DR + ch + 4);
#pragma unroll
          for (int j = 0; j < 4; ++j) { c8[j] = a0[j]; c8[4 + j] = a1[j]; ba[j] = b0[j]; ba[4 + j] = b1[j]; bx[j] = x0[j]; bx[4 + j] = x1[j]; } }
#pragma unroll
        EPI_LOOP_ROWS { const size_t r = (size_t)(row0 + ai * HALF + m * 16);
            const u32x4 xw = *(const u32x4*)(XC + r * DR + ch);
            float xc[8]; xc[0] = bflo(xw.x); xc[1] = bfhi(xw.x); xc[2] = bflo(xw.y); xc[3] = bfhi(xw.y); xc[4] = bflo(xw.z); xc[5] = bfhi(xw.z); xc[6] = bflo(xw.w); xc[7] = bfhi(xw.w);
            float la[8], bb[8];
#pragma unroll
            for (int n = 0; n < 2; ++n)
#pragma unroll
                for (int j = 0; j < 4; ++j) { const int k = 4 * n + j; const float rp = acc[ai][0][m][n][j], ip = acc[ai][1][m][n][j];
                    const float l = -c8[k] * fsigmoid(rp + ba[k]); const float x = 2.0f * l;
                    float em = -x * (1.0f + x * (0.5f + x * (0.16666667f + x * (0.041666668f + x * (0.0083333338f + x * 0.0013888889f)))));
                    if (x < -0.4f) em = 1.0f - __expf(x);
                    la[k] = l; bb[k] = sqrtf(em) * fsigmoid(ip + bx[k]) * xc[k]; }
            u32x4 w0, w1; w0.x = cvt_pk_bf16(la[0], la[1]); w0.y = cvt_pk_bf16(la[2], la[3]); w0.z = cvt_pk_bf16(la[4], la[5]); w0.w = cvt_pk_bf16(la[6], la[7]);
            w1.x = cvt_pk_bf16(bb[0], bb[1]); w1.y = cvt_pk_bf16(bb[2], bb[3]); w1.z = cvt_pk_bf16(bb[4], bb[5]); w1.w = cvt_pk_bf16(bb[6], bb[7]);
            *(u32x4*)(GT + r * 2560 + u.pn * BM + cc) = w0; *(u32x4*)(GT + r * 2560 + u.pn * BM + HALF + cc) = w1;
            if (m & 1) asm volatile("" ::: "memory"); }
    }
};
struct EpiYa {
    static constexpr bool PERM = false;
    float* ST; const bf16_t* GG;
    __device__ __forceinline__ void operator()(AccRef acc, const Unit& u, int wr, int wc, int fr, int fq) const {
        const int row0 = u.pm * BM + wr * 64 + fr, col0 = u.pn * BM + wc * 32 + 4 * fq;
#pragma unroll
        EPI_LOOP_ROWS { const size_t r = (size_t)(row0 + ai * HALF + m * 16);
#pragma unroll
            for (int bj = 0; bj < 2; ++bj)
#pragma unroll
                for (int n = 0; n < 2; ++n) { const int c = col0 + bj * HALF + n * 16; const u32x2 g = *(const u32x2*)(GG + r * GGC + c); const f32x4 a = acc[ai][bj][m][n];
                    f32x4 o; o[0] = bflo(g.x) * a[0]; o[1] = bfhi(g.x) * a[1]; o[2] = bflo(g.y) * a[2]; o[3] = bfhi(g.y) * a[3];
                    *(f32x4*)(ST + r * D + c) = o; }
            asm volatile("" ::: "memory"); }
    }
};
struct EpiMerged {
    static constexpr bool PERM = true;
    const float* ST; const bf16_t* GG; bf16_t* MG;
    __device__ __forceinline__ void operator()(AccRef acc, const Unit& u, int wr, int wc, int fr, int fq) const {
        const int row0 = u.pm * BM + wr * 64 + fr; const int colt = u.pn * BM + wc * 32 + 8 * fq;
#pragma unroll
        EPI_LOOP_ROWS { const size_t r = (size_t)(row0 + ai * HALF + m * 16);
#pragma unroll
            for (int bj = 0; bj < 2; ++bj) { const int c = colt + bj * HALF;
                const f32x4 s0 = *(const f32x4*)(ST + r * D + c), s1 = *(const f32x4*)(ST + r * D + c + 4); const u32x4 g = *(const u32x4*)(GG + r * GGC + D + c);
                const f32x4 v0 = acc[ai][bj][m][0], v1 = acc[ai][bj][m][1];
                u32x4 w; w.x = cvt_pk_bf16(s0[0] + bflo(g.x) * v0[0], s0[1] + bfhi(g.x) * v0[1]);
                w.y = cvt_pk_bf16(s0[2] + bflo(g.y) * v0[2], s0[3] + bfhi(g.y) * v0[3]);
                w.z = cvt_pk_bf16(s1[0] + bflo(g.z) * v1[0], s1[1] + bfhi(g.z) * v1[1]);
                w.w = cvt_pk_bf16(s1[2] + bflo(g.w) * v1[2], s1[3] + bfhi(g.w) * v1[3]);
                *(u32x4*)(MG + r * D + c) = w; }
            asm volatile("" ::: "memory"); }
    }
};
struct EpiY {
    static constexpr bool PERM = false;
    const float* X0; float* Y;
    __device__ __forceinline__ void operator()(AccRef acc, const Unit& u, int wr, int wc, int fr, int fq) const {
        const int row0 = u.pm * BM + wr * 64 + fr, col0 = u.pn * BM + wc * 32 + 4 * fq;
#pragma unroll
        EPI_LOOP_ROWS { const size_t r = (size_t)(row0 + ai * HALF + m * 16);
#pragma unroll
            for (int bj = 0; bj < 2; ++bj)
#pragma unroll
                for (int n = 0; n < 2; ++n) { const int c = col0 + bj * HALF + n * 16; const f32x4 x = *(const f32x4*)(X0 + r * D + c);
                    *(f32x4*)(Y + r * D + c) = x * DN_ALPHA + acc[ai][bj][m][n]; }
            asm volatile("" ::: "memory"); }
    }
};
struct EpiH {
    static constexpr bool PERM = true;
    bf16_t* H;
    __device__ __forceinline__ void operator()(AccRef acc, const Unit& u, int wr, int wc, int fr, int fq) const {
        const int row0 = u.pm * BM + wr * 64 + fr; const int col = u.pn * HALF + wc * 32 + 8 * fq;
#pragma unroll
        EPI_LOOP_ROWS { const size_t r = (size_t)(row0 + ai * HALF + m * 16);
            const f32x4 g0 = acc[ai][0][m][0], g1 = acc[ai][0][m][1], u0 = acc[ai][1][m][0], u1 = acc[ai][1][m][1];
            u32x4 w;
            w.x = cvt_pk_bf16(g0[0] * fsigmoid(g0[0]) * u0[0], g0[1] * fsigmoid(g0[1]) * u0[1]);
            w.y = cvt_pk_bf16(g0[2] * fsigmoid(g0[2]) * u0[2], g0[3] * fsigmoid(g0[3]) * u0[3]);
            w.z = cvt_pk_bf16(g1[0] * fsigmoid(g1[0]) * u1[0], g1[1] * fsigmoid(g1[1]) * u1[1]);
            w.w = cvt_pk_bf16(g1[2] * fsigmoid(g1[2]) * u1[2], g1[3] * fsigmoid(g1[3]) * u1[3]);
            *(u32x4*)(H + r * FF + col) = w; }
    }
};
struct EpiO {
    static constexpr bool PERM = true;
    bf16_t* O; const int* rowinfo;
    __device__ __forceinline__ void operator()(AccRef acc, const Unit& u, int wr, int wc, int fr, int fq) const {
        const int row0 = u.pm * BM + wr * 64 + fr; const int colt = u.pn * BM + wc * 32 + 8 * fq;
#pragma unroll
        EPI_LOOP_ROWS { const int dst = rowinfo[row0 + ai * HALF + m * 16];
            if (dst >= 0) { bf16_t* rowp = O + (size_t)dst * D + colt;
#pragma unroll
                for (int bj = 0; bj < 2; ++bj) { const f32x4 v0 = acc[ai][bj][m][0], v1 = acc[ai][bj][m][1];
                    u32x4 w; w.x = cvt_pk_bf16(v0[0], v0[1]); w.y = cvt_pk_bf16(v0[2], v0[3]); w.z = cvt_pk_bf16(v1[0], v1[1]); w.w = cvt_pk_bf16(v1[2], v1[3]);
                    *(u32x4*)(rowp + bj * HALF) = w; } } }
    }
};
}

#define XB_TMO      128
#define XB_XCNT(j)  (256  + 64 * (j))
#define XB_XSUB(j)  (1280 + 64 * (j))
#define XB_XGEN(j)  (2304 + 64 * (j))
#define XB_TOP      3328
#define XB_TOPGEN   3392
#define XCD_BAR_WORDS 3456
#define XB_SPIN_CAP (1u << 18)
__device__ __forceinline__ unsigned xb_ld(unsigned* p)              { return __hip_atomic_load(p, __ATOMIC_RELAXED, __HIP_MEMORY_SCOPE_AGENT); }
__device__ __forceinline__ unsigned xb_add(unsigned* p, unsigned v) { return __hip_atomic_fetch_add(p, v, __ATOMIC_RELAXED, __HIP_MEMORY_SCOPE_AGENT); }
__device__ __forceinline__ unsigned xb_xcc_id() { return (unsigned)__builtin_amdgcn_s_getreg((3 << 11) | 20) & 0xFu; }
#define XB_SPIN(cond, bar) do { unsigned _sp = 0; while (cond) { __builtin_amdgcn_s_sleep(1); \
    if ((++_sp & 255u) == 0u) { if (xb_ld(&(bar)[XB_TMO])) break; if (_sp > XB_SPIN_CAP) { atomicAdd(&(bar)[XB_TMO], 1u); break; } } } } while (0)
struct XcdBarrier { unsigned* bar; unsigned x; volatile LAS unsigned* st; };
__device__ __forceinline__ XcdBarrier xcd_barrier_post(unsigned* bar, volatile LAS unsigned* st) {
    XcdBarrier b; b.bar = bar; b.x = xb_xcc_id(); b.st = st;
    if (threadIdx.x == 0) (void)xb_add(&bar[XB_XCNT(b.x)], 1u);
    return b;
}
__device__ __forceinline__ void xcd_barrier_complete(unsigned* bar, unsigned x, unsigned& nloc, unsigned& nx) {
    const unsigned G = gridDim.x * gridDim.y * gridDim.z;
    unsigned sum, cnt, mine, sp = 0u;
    for (;;) {
        sum = 0u; cnt = 0u; mine = 0u;
#pragma unroll
        for (unsigned j = 0; j < 16; ++j) { const unsigned c = xb_ld(&bar[XB_XCNT(j)]); sum += c; cnt += (c > 0u) ? 1u : 0u; mine = (j == x) ? c : mine; }
        if (sum == G) break;
        __builtin_amdgcn_s_sleep(1);
        if ((++sp & 255u) == 0u) { if (xb_ld(&bar[XB_TMO])) break; if (sp > XB_SPIN_CAP) { atomicAdd(&bar[XB_TMO], 1u); break; } }
    }
    nloc = mine > 0u ? mine : 1u; nx = cnt > 0u ? cnt : 1u;
}
__device__ __forceinline__ void xcd_barrier(const XcdBarrier& b) {
    asm volatile("s_waitcnt vmcnt(0)" ::: "memory");
    __syncthreads();
    if (threadIdx.x == 0) {
        unsigned* bar = b.bar;
        __builtin_amdgcn_s_waitcnt(0);
        unsigned nloc = b.st[0], nx = b.st[1];
        if (nloc == 0u) { xcd_barrier_complete(bar, b.x, nloc, nx); b.st[0] = nloc; b.st[1] = nx; }
        const unsigned old = xb_add(&bar[XB_XSUB(b.x)], 1u);
        const unsigned gen = old / nloc;
        if (old + 1u == (gen + 1u) * nloc) {
            __builtin_amdgcn_fence(__ATOMIC_RELEASE, "agent");
            asm volatile("s_waitcnt vmcnt(0)" ::: "memory");
            const unsigned og = xb_add(&bar[XB_TOP], 1u);
            const unsigned tg = og / nx;
            if (og + 1u == (tg + 1u) * nx) xb_add(&bar[XB_TOPGEN], 1u);
            else XB_SPIN(xb_ld(&bar[XB_TOPGEN]) == tg, bar);
            __builtin_amdgcn_fence(__ATOMIC_ACQUIRE, "agent");
            xb_add(&bar[XB_XGEN(b.x)], 1u);
            asm volatile("s_waitcnt vmcnt(0)" ::: "memory");
        } else {
            XB_SPIN(xb_ld(&bar[XB_XGEN(b.x)]) == gen, bar);
            __builtin_amdgcn_fence(__ATOMIC_ACQUIRE, "agent");
            asm volatile("s_waitcnt vmcnt(0)" ::: "memory");
        }
    }
    __syncthreads();
}

struct Args {
    const float* x; const float* w_in; const float* conv_a_w; const float* w_branch_a; const float* conv_r_w; const float* conv_r_b;
    const float* w_rg_a; const float* b_rg_a; const float* w_rg_x; const float* b_rg_x; const float* rg_lambda; const float* w_branch_r; const float* w_out;
    const float* ln1_g; const float* ln1_b; const float* w_router; const float* b_router; const float* w_exp_gate; const float* w_exp_up; const float* w_exp_down;
    const float* ln2_g; const float* ln2_b;
    float* out; unsigned char* ws; int ph_lo, ph_hi;
};

typedef const Args __attribute__((address_space(4)))* ArgsP;

__device__ __forceinline__ void transpose_item(const float* W, int N, int k0, int n0, bf16_t* WT, int ldk, int drow0, LAS float* scr, int lane) {
    float tv[32];
    { const float* wp = W + (size_t)(k0 + (lane >> 5)) * N + n0 + (lane & 31);
#pragma unroll
      for (int i = 0; i < 32; ++i) tv[i] = wp[(size_t)(2 * i) * N]; }
#pragma unroll
    for (int i = 0; i < 32; ++i) scr[(2 * i + (lane >> 5)) * 33 + (lane & 31)] = tv[i];
    LDS_WAIT(); asm volatile("" ::: "memory");
    const int c = lane & 7;
#pragma unroll
    for (int j = 0; j < 4; ++j) { const int n = (lane >> 3) + 8 * j; const LAS float* s = scr + (8 * c) * 33 + n;
        u32x4 o; o.x = cvt_pk_bf16(s[0 * 33], s[1 * 33]); o.y = cvt_pk_bf16(s[2 * 33], s[3 * 33]); o.z = cvt_pk_bf16(s[4 * 33], s[5 * 33]); o.w = cvt_pk_bf16(s[6 * 33], s[7 * 33]);
        *(u32x4*)(WT + (size_t)(drow0 + n) * ldk + k0 + 8 * c) = o; }
    LDS_WAIT(); asm volatile("" ::: "memory");
}
__device__ __forceinline__ void transpose_plain(const float* W, int K, int N, bf16_t* WT, int item, LAS float* scr, int lane) {
    const int nblk = N / 32, kb = item / nblk, nb = item % nblk;
    transpose_item(W, N, 64 * kb, 32 * nb, WT, K, 32 * nb, scr, lane);
}

__device__ __forceinline__ void prep_tm_weights(ArgsP a, int l, unsigned char* ws, LAS float* scr, int gw, int NGW, int lane) {
    constexpr int I_IN = (D / 64) * (DIN / 32), I_A = (D / 64) * (D / 32), I_R = (DR / 64) * (D / 32), I_O = I_A, I_G = 2 * NHEAD * 2 * 4;
    constexpr int NITEMS = I_IN + I_A + I_R + I_O + I_G;
    if (gw < 20) { const int c = gw * 64 + lane; float* PC = (float*)(ws + WS_SMALL + SM_PCONST);
        PC[c] = 8.0f * log1pf(__expf(-a->rg_lambda[(size_t)l * DR + c])); PC[DR + c] = a->b_rg_a[(size_t)l * DR + c]; PC[2 * DR + c] = a->b_rg_x[(size_t)l * DR + c]; }
    for (int it = gw; it < NITEMS; it += NGW) {
        int r = it;
        if (r < I_IN) { const int nblk = DIN / 32, kb = r / nblk, n0 = 32 * (r % nblk);
            const int drow0 = n0 < 1024 ? (n0 >> 7) * 256 + (n0 & 127) : (n0 < 2048 ? n0 + 1024 : (n0 < 3072 ? ((n0 - 2048) >> 7) * 256 + 128 + (n0 & 127) : n0));
            transpose_item(a->w_in + (size_t)l * D * DIN, DIN, 64 * kb, n0, (bf16_t*)(ws + WS_WIN), D, drow0, scr, lane); continue; } r -= I_IN;
        if (r < I_A) { transpose_plain(a->w_branch_a + (size_t)l * D * D, D, D, (bf16_t*)(ws + WS_WA), r, scr, lane); continue; } r -= I_A;
        if (r < I_R) { transpose_plain(a->w_branch_r + (size_t)l * DR * D, DR, D, (bf16_t*)(ws + WS_WR), r, scr, lane); continue; } r -= I_R;
        if (r < I_O) { transpose_plain(a->w_out + (size_t)l * D * D, D, D, (bf16_t*)(ws + WS_WO), r, scr, lane); continue; } r -= I_O;
        {
            const int nb = r & 3, kb = (r >> 2) & 1, hw = r >> 3, which = hw & 1, hh = hw >> 1;
            const float* W = (which ? a->w_rg_x : a->w_rg_a) + ((size_t)l * NHEAD + hh) * 128 * 128;
            transpose_item(W, 128, 64 * kb, 32 * nb, (bf16_t*)(ws + WS_WG), 128, hh * 256 + which * 128 + 32 * nb, scr, lane);
        }
    }
}
__device__ __forceinline__ void prep_expert_weights(ArgsP a, int l, unsigned char* ws, LAS float* scr, int gw, int NGW, int lane) {
    constexpr int I_G = (D / 64) * (FF / 32), I_D = (FF / 64) * (D / 32), PER_E = 2 * I_G + I_D;
    bf16_t* WGU = (bf16_t*)(ws + WS_WEX); bf16_t* WDN = WGU + (size_t)NE * 1024 * 1024;
    for (int it = gw; it < NE * PER_E; it += NGW) {
        const int e = it / PER_E; int r = it % PER_E;
        if (r < 2 * I_G) { const int which = r / I_G; r %= I_G; const int nblk = FF / 32, kb = r / nblk, nb = r % nblk, n0 = 32 * nb;
            const float* W = (which ? a->w_exp_up : a->w_exp_gate) + ((size_t)l * NE + e) * D * FF;
            const int drow0 = (n0 >> 7) * 256 + which * 128 + (n0 & 127);
            transpose_item(W, FF, 64 * kb, n0, WGU + (size_t)e * 1024 * 1024, D, drow0, scr, lane);
        } else { r -= 2 * I_G; const float* W = a->w_exp_down + ((size_t)l * NE + e) * FF * D;
            transpose_plain(W, FF, D, WDN + (size_t)e * 1024 * 512, r, scr, lane); }
    }
}
__device__ __forceinline__ void cvt_x(const float* x, bf16_t* xb, int gtid, int nthr) {
    for (size_t i = gtid; i < (size_t)T * D / 8; i += (size_t)4 * nthr) {
        f32x4 a[4], b[4];
#pragma unroll
        for (int k = 0; k < 4; ++k) { a[k] = *(const f32x4*)(x + (i + (size_t)k * nthr) * 8); b[k] = *(const f32x4*)(x + (i + (size_t)k * nthr) * 8 + 4); }
#pragma unroll
        for (int k = 0; k < 4; ++k) { u32x4 w; w.x = cvt_pk_bf16(a[k][0], a[k][1]); w.y = cvt_pk_bf16(a[k][2], a[k][3]); w.z = cvt_pk_bf16(b[k][0], b[k][1]); w.w = cvt_pk_bf16(b[k][2], b[k][3]); *(u32x4*)(xb + (i + (size_t)k * nthr) * 8) = w; } }
}
__device__ __forceinline__ void unpack8(const u32x4 w, float (&f)[8]) { f[0] = bflo(w.x); f[1] = bfhi(w.x); f[2] = bflo(w.y); f[3] = bfhi(w.y); f[4] = bflo(w.z); f[5] = bfhi(w.z); f[6] = bflo(w.w); f[7] = bfhi(w.w); }
__device__ __forceinline__ u32x4 pack8(const float (&f)[8]) { u32x4 w; w.x = cvt_pk_bf16(f[0], f[1]); w.y = cvt_pk_bf16(f[2], f[3]); w.z = cvt_pk_bf16(f[4], f[5]); w.w = cvt_pk_bf16(f[6], f[7]); return w; }

__device__ __forceinline__ void phase_e1(ArgsP a, int l, int half, unsigned char* ws, int gtid, int nthr) {
    const bf16_t* Z = (const bf16_t*)(ws + WS_Z); bf16_t* UA = (bf16_t*)(ws + WS_UA) + (size_t)half * TH * D; bf16_t* XC = (bf16_t*)(ws + WS_XC);
    constexpr int RUN = 8;
    constexpr int NA = (TH / RUN) * (D / 8), NR = (TH / RUN) * (DR / 8);
    for (int it = gtid; it < NA + NR; it += nthr) {
        if (it < NA) {
            const int cg = it % (D / 8), run = it / (D / 8), t0 = run * RUN, c0 = cg * 8;
            const bool first = (t0 & (SEQ - 1)) == 0;
            u32x4 vv[RUN + 2], bw[RUN];
            vv[0] = first ? (u32x4){0u, 0u, 0u, 0u} : *(const u32x4*)(Z + (size_t)(t0 - 2) * ZC + c0);
            vv[1] = first ? (u32x4){0u, 0u, 0u, 0u} : *(const u32x4*)(Z + (size_t)(t0 - 1) * ZC + c0);
#pragma unroll
            for (int i = 0; i < RUN; ++i) { vv[i + 2] = *(const u32x4*)(Z + (size_t)(t0 + i) * ZC + c0); bw[i] = *(const u32x4*)(Z + (size_t)(t0 + i) * ZC + D + c0); }
            float w0[8], w1[8], w2[8];
            { const float* cw = a->conv_a_w + (size_t)l * 3 * D + c0;
#pragma unroll
              for (int j = 0; j < 8; ++j) { w0[j] = cw[j]; w1[j] = cw[D + j]; w2[j] = cw[2 * D + j]; } }
            float vm2[8], vm1[8]; unpack8(vv[0], vm2); unpack8(vv[1], vm1);
#pragma unroll
            for (int i = 0; i < RUN; ++i) { float v[8], bb[8], o[8]; unpack8(vv[i + 2], v); unpack8(bw[i], bb);
#pragma unroll
                for (int j = 0; j < 8; ++j) { o[j] = bb[j] * (w0[j] * vm2[j] + w1[j] * vm1[j] + w2[j] * v[j]); vm2[j] = vm1[j]; vm1[j] = v[j]; }
                *(u32x4*)(UA + (size_t)(t0 + i) * D + c0) = pack8(o); }
        } else {
            const int r = it - NA; const int cg = r % (DR / 8), run = r / (DR / 8), t0 = run * RUN, c0 = cg * 8;
            const bool first = (t0 & (SEQ - 1)) == 0;
            u32x4 xv[RUN + 3];
#pragma unroll
            for (int i = 0; i < 3; ++i) xv[i] = first ? (u32x4){0u, 0u, 0u, 0u} : *(const u32x4*)(Z + (size_t)(t0 - 3 + i) * ZC + 2 * D + c0);
#pragma unroll
            for (int i = 0; i < RUN; ++i) xv[i + 3] = *(const u32x4*)(Z + (size_t)(t0 + i) * ZC + 2 * D + c0);
            float w0[8], w1[8], w2[8], w3[8], bi[8];
            { const float* cw = a->conv_r_w + (size_t)l * 4 * DR + c0; const float* cb = a->conv_r_b + (size_t)l * DR + c0;
#pragma unroll
              for (int j = 0; j < 8; ++j) { w0[j] = cw[j]; w1[j] = cw[DR + j]; w2[j] = cw[2 * DR + j]; w3[j] = cw[3 * DR + j]; bi[j] = cb[j]; } }
            float x3[8], x2[8], x1[8]; unpack8(xv[0], x3); unpack8(xv[1], x2); unpack8(xv[2], x1);
#pragma unroll
            for (int i = 0; i < RUN; ++i) { float x0[8], o[8]; unpack8(xv[i + 3], x0);
#pragma unroll
                for (int j = 0; j < 8; ++j) { o[j] = w0[j] * x3[j] + w1[j] * x2[j] + w2[j] * x1[j] + w3[j] * x0[j] + bi[j]; x3[j] = x2[j]; x2[j] = x1[j]; x1[j] = x0[j]; }
                *(u32x4*)(XC + (size_t)(t0 + i) * DR + c0) = pack8(o); }
        }
    }
}

template <bool FINAL>
__device__ __forceinline__ void phase_scan(int half, unsigned char* ws, int gtid, int nthr) {
    const bf16_t* GT = (const bf16_t*)(ws + WS_GT); const bf16_t* Z = (const bf16_t*)(ws + WS_Z);
    float* AEND = (float*)(ws + WS_SMALL + SM_AEND); float* HEND = (float*)(ws + WS_SMALL + SM_HEND);
    bf16_t* UR = (bf16_t*)(ws + WS_UR) + (size_t)half * TH * DR;
    constexpr int NP = DR / 2, NITEMS = (TH / SEQ) * NSCH * NP, BT = 16;
    for (int it = gtid; it < NITEMS; it += nthr) {
        const int cp = it % NP, j = (it / NP) % NSCH, bl = it / (NP * NSCH), c = 2 * cp, hh = c >> 7, cc = c & 127, b = half * (TH / SEQ) + bl;
        float h0 = 0.f, h1 = 0.f, L0 = 0.f, L1 = 0.f;
        if (FINAL) {
            const size_t sb = (size_t)b * NSCH * DR + c; int jj = 0;
            for (; jj + 8 <= j; jj += 8) { f32x2 ae[8], he[8];
#pragma unroll
                for (int k = 0; k < 8; ++k) { ae[k] = *(const f32x2*)(AEND + sb + (size_t)(jj + k) * DR); he[k] = *(const f32x2*)(HEND + sb + (size_t)(jj + k) * DR); }
#pragma unroll
                for (int k = 0; k < 8; ++k) { h0 = ae[k].x * h0 + he[k].x; h1 = ae[k].y * h1 + he[k].y; } }
            for (; jj < j; ++jj) { const f32x2 ae = *(const f32x2*)(AEND + sb + (size_t)jj * DR), he = *(const f32x2*)(HEND + sb + (size_t)jj * DR); h0 = ae.x * h0 + he.x; h1 = ae.y * h1 + he.y; }
        }
        const size_t row0 = (size_t)bl * SEQ + (size_t)j * SCH;
        const bf16_t* gl = GT + row0 * 2560 + hh * 256 + cc; const bf16_t* zy = Z + row0 * ZC + 2 * D + DR + c; bf16_t* ur = UR + row0 * DR + c;
#pragma unroll 1
        for (int t0 = 0; t0 < SCH; t0 += BT) {
            unsigned lw[BT], bw[BT], yw[BT];
#pragma unroll
            for (int k = 0; k < BT; ++k) { lw[k] = *(const unsigned*)(gl + (size_t)(t0 + k) * 2560); bw[k] = *(const unsigned*)(gl + (size_t)(t0 + k) * 2560 + 128);
                if (FINAL) yw[k] = *(const unsigned*)(zy + (size_t)(t0 + k) * ZC); }
#pragma unroll
            for (int k = 0; k < BT; ++k) { const float l0 = bflo(lw[k]), l1 = bfhi(lw[k]);
                h0 = __expf(l0) * h0 + bflo(bw[k]); h1 = __expf(l1) * h1 + bfhi(bw[k]);
                if (FINAL) *(unsigned*)(ur + (size_t)(t0 + k) * DR) = cvt_pk_bf16(h0 * bflo(yw[k]), h1 * bfhi(yw[k]));
                else { L0 += l0; L1 += l1; } }
        }
        if (!FINAL) { const size_t si = ((size_t)b * NSCH + j) * DR + c; *(f32x2*)(AEND + si) = (f32x2){__expf(L0), __expf(L1)}; *(f32x2*)(HEND + si) = (f32x2){h0, h1}; }
    }
}

__device__ __forceinline__ void phase_ln1_router(ArgsP a, int l, unsigned char* ws, LAS unsigned char* lds, int tid, int lane, int gw, int NGW, int vcu) {
    LAS f32x4* wl = (LAS f32x4*)lds;
    for (int idx = tid; idx < 4096; idx += 512) { const int ln = idx & 63, q = (idx >> 6) & 3, jk = idx >> 8, d = 4 * ln + 256 * (jk >> 2) + (jk & 3);
        wl[idx] = *(const f32x4*)(a->w_router + (size_t)d * NE + 4 * q); }
    LAS unsigned* lcnt = (LAS unsigned*)(lds + 65536);
    if (tid < NE) lcnt[tid] = 0u;
    __syncthreads();
    const float* Y = (const float*)(ws + WS_Y); float* X1 = (float*)(ws + WS_X1); bf16_t* XB = (bf16_t*)(ws + WS_XB);
    unsigned* TOKE = (unsigned*)(ws + WS_SMALL + SM_TOKE); unsigned* TOKP = (unsigned*)(ws + WS_SMALL + SM_TOKP); float* TOKW = (float*)(ws + WS_SMALL + SM_TOKW);
    f32x4 gv[4], bv[4];
#pragma unroll
    for (int j = 0; j < 4; ++j) { gv[j] = *(const f32x4*)(a->ln1_g + (size_t)l * D + 4 * lane + 256 * j); bv[j] = *(const f32x4*)(a->ln1_b + (size_t)l * D + 4 * lane + 256 * j); }
    float br[16];
#pragma unroll
    for (int e = 0; e < 16; ++e) br[e] = a->b_router[e];
    for (int t = gw; t < T; t += NGW) {
        f32x4 v[4]; float s = 0.f;
#pragma unroll
        for (int j = 0; j < 4; ++j) { v[j] = *(const f32x4*)(Y + (size_t)t * D + 4 * lane + 256 * j); s += (v[j][0] + v[j][1]) + (v[j][2] + v[j][3]); }
        const float mean = wave_sum(s) * (1.f / D); float s2 = 0.f;
#pragma unroll
        for (int j = 0; j < 4; ++j) { v[j] = v[j] - mean; s2 += (v[j][0] * v[j][0] + v[j][1] * v[j][1]) + (v[j][2] * v[j][2] + v[j][3] * v[j][3]); }
        const float rstd = 1.f / sqrtf(wave_sum(s2) * (1.f / D) + LN_EPS);
        float acc[16];
#pragma unroll
        for (int e = 0; e < 16; ++e) acc[e] = 0.f;
#pragma unroll
        for (int j = 0; j < 4; ++j) { v[j] = v[j] * rstd * gv[j] + bv[j];
            *(f32x4*)(X1 + (size_t)t * D + 4 * lane + 256 * j) = v[j];
            u32x2 w; w.x = cvt_pk_bf16(v[j][0], v[j][1]); w.y = cvt_pk_bf16(v[j][2], v[j][3]); *(u32x2*)(XB + (size_t)t * D + 4 * lane + 256 * j) = w;
#pragma unroll
            for (int k = 0; k < 4; ++k) { const float xv = v[j][k];
#pragma unroll
                for (int q = 0; q < 4; ++q) { const f32x4 w4 = wl[((j * 4 + k) * 4 + q) * 64 + lane]; acc[4 * q] += xv * w4[0]; acc[4 * q + 1] += xv * w4[1]; acc[4 * q + 2] += xv * w4[2]; acc[4 * q + 3] += xv * w4[3]; } } }
        float r8[8], r4[4], r2[2], r1;
        { const bool hi = (lane & 32) != 0;
#pragma unroll
          for (int i = 0; i < 8; ++i) { const float keep = hi ? acc[i + 8] : acc[i], send = hi ? acc[i] : acc[i + 8]; r8[i] = keep + __shfl_xor(send, 32); } }
        { const bool hi = (lane & 16) != 0;
#pragma unroll
          for (int i = 0; i < 4; ++i) { const float keep = hi ? r8[i + 4] : r8[i], send = hi ? r8[i] : r8[i + 4]; r4[i] = keep + __shfl_xor(send, 16); } }
        { const bool hi = (lane & 8) != 0;
#pragma unroll
          for (int i = 0; i < 2; ++i) { const float keep = hi ? r4[i + 2] : r4[i], send = hi ? r4[i] : r4[i + 2]; r2[i] = keep + __shfl_xor(send, 8); } }
        { const bool hi = (lane & 4) != 0; const float keep = hi ? r2[1] : r2[0], send = hi ? r2[0] : r2[1]; r1 = keep + __shfl_xor(send, 4); }
        r1 += __shfl_xor(r1, 2); r1 += __shfl_xor(r1, 1);
        float lg[16]; float mx = -3.0e38f;
#pragma unroll
        for (int e = 0; e < 16; ++e) { lg[e] = __shfl(r1, 4 * e) + br[e]; mx = fmaxf(mx, lg[e]); }
        float p[16];
#pragma unroll
        for (int e = 0; e < 16; ++e) p[e] = __expf(lg[e] - mx);
        int gsel = 0; float gbest = -1.f;
#pragma unroll
        for (int g = 0; g < 4; ++g) { const float p0 = p[4 * g], p1 = p[4 * g + 1], p2 = p[4 * g + 2], p3 = p[4 * g + 3];
            const float sum = (p0 + p1) + (p2 + p3), mn1 = fminf(fminf(p0, p1), fminf(p2, p3));
            const float hi01 = fmaxf(p0, p1), lo01 = fminf(p0, p1), hi23 = fmaxf(p2, p3), lo23 = fminf(p2, p3);
            const float top1 = fmaxf(hi01, hi23), top2 = fmaxf(fminf(hi01, hi23), fmaxf(lo01, lo23));
            (void)sum; (void)mn1;
            const float sc = top1 + top2; if (sc > gbest) { gbest = sc; gsel = g; } }
        float q0, q1, q2, q3;
        q0 = gsel == 0 ? p[0] : gsel == 1 ? p[4] : gsel == 2 ? p[8] : p[12];
        q1 = gsel == 0 ? p[1] : gsel == 1 ? p[5] : gsel == 2 ? p[9] : p[13];
        q2 = gsel == 0 ? p[2] : gsel == 1 ? p[6] : gsel == 2 ? p[10] : p[14];
        q3 = gsel == 0 ? p[3] : gsel == 1 ? p[7] : gsel == 2 ? p[11] : p[15];
        int i1 = 0; float v1 = q0;
        if (q1 > v1) { v1 = q1; i1 = 1; } if (q2 > v1) { v1 = q2; i1 = 2; } if (q3 > v1) { v1 = q3; i1 = 3; }
        int i2 = -1; float v2 = -1.f;
        if (i1 != 0 && q0 > v2) { v2 = q0; i2 = 0; } if (i1 != 1 && q1 > v2) { v2 = q1; i2 = 1; } if (i1 != 2 && q2 > v2) { v2 = q2; i2 = 2; } if (i1 != 3 && q3 > v2) { v2 = q3; i2 = 3; }
        const float inv = 1.0f / (v1 + v2);
        if (lane == 0) { const int e1 = 4 * gsel + i1, e2 = 4 * gsel + i2;
            const unsigned pos1 = __hip_atomic_fetch_add(lcnt + e1, 1u, __ATOMIC_RELAXED, __HIP_MEMORY_SCOPE_WORKGROUP);
            const unsigned pos2 = __hip_atomic_fetch_add(lcnt + e2, 1u, __ATOMIC_RELAXED, __HIP_MEMORY_SCOPE_WORKGROUP);
            TOKE[t] = (unsigned)e1 | ((unsigned)e2 << 8); TOKP[2 * t] = pos1; TOKP[2 * t + 1] = pos2; TOKW[2 * t] = v1 * inv; TOKW[2 * t + 1] = v2 * inv; }
    }
    __syncthreads();
    if (tid < NE) ((unsigned*)(ws + WS_SMALL + SM_WGCNT))[vcu * NE + tid] = lcnt[tid];
}

__device__ __forceinline__ void phase_moe_lists(unsigned char* ws, LAS unsigned char* lds, int tid, int lane, int gw, int NGW, int vcu, int G) {
    unsigned* ctl = (unsigned*)(ws + WS_CTL);
    LAS unsigned* off = (LAS unsigned*)lds;
    { const unsigned* WGCNT = (const unsigned*)(ws + WS_SMALL + SM_WGCNT);
      const int e = tid & 15, p = tid >> 4; unsigned tot = 0, pre = 0;
      for (int v = p; v < G; v += 32) { const unsigned c = WGCNT[v * NE + e]; tot += c; pre += (v < vcu) ? c : 0u; }
      off[128 + p * 16 + e] = tot; off[128 + 512 + p * 16 + e] = pre; }
    __syncthreads();
    if (tid < NE) { unsigned tot = 0, pre = 0; for (int p = 0; p < 32; ++p) { tot += off[128 + p * 16 + tid]; pre += off[128 + 512 + p * 16 + tid]; } off[32 + tid] = tot; off[48 + tid] = pre; }
    __syncthreads();
    if (tid == 0) { unsigned o = 0;
        for (int e = 0; e < NE; ++e) { const unsigned c = off[32 + e]; off[e] = o; off[64 + e] = o + off[48 + e]; o += (c + 255u) & ~255u; }
        off[16] = o; }
    __syncthreads();
    int* ROWINFO = (int*)(ws + WS_SMALL + SM_ROWINFO);
    if (blockIdx.x == 0) {
        if (tid == 0) ctl[CW_NTILES] = off[16] >> 8;
        if (tid < NE) { const unsigned t0 = off[tid] >> 8, t1 = off[tid + 1] >> 8; for (unsigned tt = t0; tt < t1; ++tt) ctl[CW_TILEE + tt] = (unsigned)tid; }
        for (int e = 0; e < NE; ++e) { const unsigned p0 = off[e] + off[32 + e], p1 = off[e + 1]; for (unsigned r = p0 + tid; r < p1; r += 512) ROWINFO[r] = -1; }
    }
    const bf16_t* XB = (const bf16_t*)(ws + WS_XB); bf16_t* XG = (bf16_t*)(ws + WS_XG);
    const unsigned* TOKE = (const unsigned*)(ws + WS_SMALL + SM_TOKE); const unsigned* TOKP = (const unsigned*)(ws + WS_SMALL + SM_TOKP);
    for (int t = gw; t < T; t += NGW) {
        const unsigned ee = TOKE[t]; const unsigned r1 = off[64 + (ee & 255u)] + TOKP[2 * t], r2 = off[64 + ((ee >> 8) & 255u)] + TOKP[2 * t + 1];
        const u32x4 v0 = *(const u32x4*)(XB + (size_t)t * D + 8 * lane), v1 = *(const u32x4*)(XB + (size_t)t * D + 512 + 8 * lane);
        *(u32x4*)(XG + (size_t)r1 * D + 8 * lane) = v0; *(u32x4*)(XG + (size_t)r1 * D + 512 + 8 * lane) = v1;
        *(u32x4*)(XG + (size_t)r2 * D + 8 * lane) = v0; *(u32x4*)(XG + (size_t)r2 * D + 512 + 8 * lane) = v1;
        if (lane == 0) { ROWINFO[r1] = 2 * t; ROWINFO[r2] = 2 * t + 1; }
    }
}

__device__ __forceinline__ void phase_ln2(ArgsP a, int l, unsigned char* ws, float* out, int lane, int gw, int NGW) {
    const float* X1 = (const float*)(ws + WS_X1); const bf16_t* O = (const bf16_t*)(ws + WS_O); bf16_t* XB = (bf16_t*)(ws + WS_XB);
    const float* TOKW = (const float*)(ws + WS_SMALL + SM_TOKW);
    f32x4 gv[4], bv[4];
#pragma unroll
    for (int j = 0; j < 4; ++j) { gv[j] = *(const f32x4*)(a->ln2_g + (size_t)l * D + 4 * lane + 256 * j); bv[j] = *(const f32x4*)(a->ln2_b + (size_t)l * D + 4 * lane + 256 * j); }
    for (int t = gw; t < T; t += NGW) {
        const float w1 = TOKW[2 * t], w2 = TOKW[2 * t + 1];
        f32x4 v[4]; float s = 0.f;
#pragma unroll
        for (int j = 0; j < 4; ++j) { const f32x4 x = *(const f32x4*)(X1 + (size_t)t * D + 4 * lane + 256 * j);
            const u32x2 o1 = *(const u32x2*)(O + (size_t)(2 * t) * D + 4 * lane + 256 * j), o2 = *(const u32x2*)(O + (size_t)(2 * t + 1) * D + 4 * lane + 256 * j);
            f32x4 mo; mo[0] = w1 * bflo(o1.x) + w2 * bflo(o2.x); mo[1] = w1 * bfhi(o1.x) + w2 * bfhi(o2.x); mo[2] = w1 * bflo(o1.y) + w2 * bflo(o2.y); mo[3] = w1 * bfhi(o1.y) + w2 * bfhi(o2.y);
            v[j] = x * DN_ALPHA + mo; s += (v[j][0] + v[j][1]) + (v[j][2] + v[j][3]); }
        const float mean = wave_sum(s) * (1.f / D); float s2 = 0.f;
#pragma unroll
        for (int j = 0; j < 4; ++j) { v[j] = v[j] - mean; s2 += (v[j][0] * v[j][0] + v[j][1] * v[j][1]) + (v[j][2] * v[j][2] + v[j][3] * v[j][3]); }
        const float rstd = 1.f / sqrtf(wave_sum(s2) * (1.f / D) + LN_EPS);
#pragma unroll
        for (int j = 0; j < 4; ++j) { v[j] = v[j] * rstd * gv[j] + bv[j];
            *(f32x4*)(out + (size_t)t * D + 4 * lane + 256 * j) = v[j];
            u32x2 w; w.x = cvt_pk_bf16(v[j][0], v[j][1]); w.y = cvt_pk_bf16(v[j][2], v[j][3]); *(u32x2*)(XB + (size_t)t * D + 4 * lane + 256 * j) = w; }
    }
}

constexpr int STEPS_PER_LAYER = 5 * NCHUNK + 8;
constexpr int N_STEPS = 1 + DEPTH * STEPS_PER_LAYER;

__global__ void __launch_bounds__(512, 2) mk_fwd(Args args_by_value) {
    (void)args_by_value;
    extern __shared__ __attribute__((aligned(16))) unsigned char lds_raw[];
    LAS unsigned char* lds = (LAS unsigned char*)lds_raw;
    volatile LAS unsigned* MISC = (volatile LAS unsigned*)(lds + MISC_OFF);
    const int tid0 = threadIdx.x;
    const int G = gridDim.x; const int bx = blockIdx.x; const int vcu0 = (G % 8 == 0) ? (bx % 8) * (G / 8) + bx / 8 : bx;
    const int NGW = G * 8, nthr = G * 512;
    ArgsP ap0 = (ArgsP)__builtin_amdgcn_kernarg_segment_ptr();
    unsigned char* ws0 = ap0->ws;
    unsigned* ctl = (unsigned*)(ws0 + WS_CTL);
    for (int u = tid0; u < (LDS_BYTES - LDSCTL_OFF) / 4; u += 512) ((LAS unsigned*)(lds + LDSCTL_OFF))[u] = 0u;
    __syncthreads();
    XcdBarrier bar; bar.bar = ctl + CW_BAR; bar.x = 0; bar.st = nullptr;
    if (!MK_PER_STEP_LAUNCH) bar = xcd_barrier_post(ctl + CW_BAR, MISC + 8);
    const int lo = ap0->ph_lo, hi = ap0->ph_hi;
    int step = 0;
#ifndef MK_MASK
#define MK_MASK 0xFFFFFFFFu
#endif
#ifndef MK_REPEAT
#define MK_REPEAT 0u
#endif
#ifndef MK_BAR2
#define MK_BAR2 0
#endif
#define STEP_BEGIN(id) if (((MK_MASK >> (id)) & 1u) && lo <= step && step < hi) { for (int rep = 0; rep < 1 + (int)((MK_REPEAT >> (id)) & 1u); ++rep) { if (rep) __syncthreads(); unsigned char* ws = ws0; asm volatile("" : "+s"(ws)); ArgsP args = ap0; asm volatile("" : "+s"(args)); int tid = tid0; asm volatile("" : "+v"(tid)); int vcu = vcu0; asm volatile("" : "+s"(vcu)); \
    const int lane = tid & 63, wave = __builtin_amdgcn_readfirstlane(tid >> 6), gw = vcu * 8 + wave, gtid = vcu * 512 + tid; LAS float* scr = (LAS float*)(lds + wave * 16384); (void)lane; (void)gw; (void)gtid; (void)scr;
#define STEP_END   } if (step + 1 < hi) { if (MK_PER_STEP_LAUNCH) {} else { xcd_barrier(bar); if (MK_BAR2) xcd_barrier(bar); } } } ++step;

    STEP_BEGIN(0)
        prep_tm_weights(args, 0, ws, scr, gw, NGW, lane);
        cvt_x(args->x, (bf16_t*)(ws + WS_XB), gtid, nthr);
    STEP_END

#pragma unroll 1
    for (int l = 0; l < DEPTH; ++l) {

#pragma unroll 1
        for (int half = 0; half < NCHUNK; ++half) {
            STEP_BEGIN(1)
                pg8::SchedPlain S{TH / 256, DIN / 256, G, bx, (const char*)(ws + WS_XB) + (size_t)half * TH * D * 2, (const char*)(ws + WS_WIN), (size_t)256 * D * 2, (size_t)256 * D * 2, 0};
                pg8::EpiZ E{(bf16_t*)(ws + WS_Z), (bf16_t*)(ws + WS_GG), half * TH};
                pg8::gemm_phase<pg8::EpiZ, pg8::SchedPlain, true>(lds, D, D, D, S, E);
            STEP_END
            STEP_BEGIN(2)
                phase_e1(args, l, half, ws, gtid, nthr);
            STEP_END
            STEP_BEGIN(3)
                pg8::SchedPlain S{TH / 256, NHEAD, G, bx, (const char*)(ws + WS_XC), (const char*)(ws + WS_WG), (size_t)256 * DR * 2, (size_t)256 * 128 * 2, (size_t)128 * 2};
                pg8::EpiRG E{(bf16_t*)(ws + WS_GT), (const bf16_t*)(ws + WS_XC), (const float*)(ws + WS_SMALL + SM_PCONST)};
                pg8::gemm_phase<pg8::EpiRG, pg8::SchedPlain, true>(lds, DR, 128, 128, S, E);
            STEP_END
            STEP_BEGIN(4)
                phase_scan<false>(half, ws, gtid, nthr);
            STEP_END
            STEP_BEGIN(5)
                phase_scan<true>(half, ws, gtid, nthr);
            STEP_END
        }
        STEP_BEGIN(6)
            pg8::SchedPlain S{T / 256, D / 256, G, bx, (const char*)(ws + WS_UA), (const char*)(ws + WS_WA), (size_t)256 * D * 2, (size_t)256 * D * 2, 0};
            pg8::EpiYa E{(float*)(ws + WS_STASH), (const bf16_t*)(ws + WS_GG)};
            pg8::gemm_phase<pg8::EpiYa, pg8::SchedPlain, true>(lds, D, D, D, S, E);
        STEP_END
        STEP_BEGIN(7)
            pg8::SchedPlain S{T / 256, D / 256, G, bx, (const char*)(ws + WS_UR), (const char*)(ws + WS_WR), (size_t)256 * DR * 2, (size_t)256 * DR * 2, 0};
            pg8::EpiMerged E{(const float*)(ws + WS_STASH), (const bf16_t*)(ws + WS_GG), (bf16_t*)(ws + WS_MERGED)};
            pg8::gemm_phase<pg8::EpiMerged, pg8::SchedPlain, true>(lds, DR, DR, DR, S, E);
        STEP_END
        STEP_BEGIN(8)
            pg8::SchedPlain S{T / 256, D / 256, G, bx, (const char*)(ws + WS_MERGED), (const char*)(ws + WS_WO), (size_t)256 * D * 2, (size_t)256 * D * 2, 0};
            pg8::EpiY E{(l == 0) ? args->x : (const float*)args->out, (float*)(ws + WS_Y)};
            pg8::gemm_phase<pg8::EpiY, pg8::SchedPlain, true>(lds, D, D, D, S, E);
        STEP_END
        STEP_BEGIN(9)
            prep_expert_weights(args, l, ws, scr, gw, NGW, lane);
            __syncthreads();
            if (rep == 0) phase_ln1_router(args, l, ws, lds, tid, lane, gw, NGW, vcu);
        STEP_END
        STEP_BEGIN(10)
            phase_moe_lists(ws, lds, tid, lane, gw, NGW, vcu, G);
            __syncthreads();
            if (l + 1 < DEPTH) prep_tm_weights(args, l + 1, ws, scr, gw, NGW, lane);
        STEP_END
        STEP_BEGIN(11)
            const int ntiles = (int)__hip_atomic_load(ctl + CW_NTILES, __ATOMIC_RELAXED, __HIP_MEMORY_SCOPE_AGENT);
            pg8::SchedMoe S{ntiles, 4, G, bx, (const char*)(ws + WS_XG), (const char*)(ws + WS_WEX), (size_t)256 * D * 2, (size_t)256 * D * 2, (size_t)1024 * 1024 * 2, ctl + CW_TILEE};
            pg8::EpiH E{(bf16_t*)(ws + WS_H)};
            pg8::gemm_phase<pg8::EpiH, pg8::SchedMoe, true>(lds, D, D, D, S, E);
        STEP_END
        STEP_BEGIN(12)
            const int ntiles = (int)__hip_atomic_load(ctl + CW_NTILES, __ATOMIC_RELAXED, __HIP_MEMORY_SCOPE_AGENT);
            pg8::SchedMoe S{ntiles, 4, G, bx, (const char*)(ws + WS_H), (const char*)(ws + WS_WEX) + (size_t)NE * 1024 * 1024 * 2, (size_t)256 * FF * 2, (size_t)256 * FF * 2, (size_t)1024 * 512 * 2, ctl + CW_TILEE};
            pg8::EpiO E{(bf16_t*)(ws + WS_O), (const int*)(ws + WS_SMALL + SM_ROWINFO)};
            pg8::gemm_phase<pg8::EpiO, pg8::SchedMoe, true>(lds, FF, FF, FF, S, E);
        STEP_END
        STEP_BEGIN(13)
            phase_ln2(args, l, ws, args->out, lane, gw, NGW);
        STEP_END
    }
#undef STEP_BEGIN
#undef STEP_END
}

extern "C" void kernel_launch(void* const* d_in, const int* in_sizes, int n_in, void* d_out, int out_size, void* d_ws, size_t ws_size, hipStream_t stream) {
    static int grid = 0;
    if (grid == 0) {
        if (n_in != 22 || in_sizes[0] != T * D || out_size != T * D || ws_size < WS_NEED) {
            fprintf(stderr, "kernel_launch: unexpected shapes (n_in %d, in0 %d, out %d, ws %zu, need %zu); nothing launched\n", n_in, n_in > 0 ? in_sizes[0] : -1, out_size, ws_size, (size_t)WS_NEED); grid = -1; return; }
        int dev = 0, cus = 0, per_cu = 0;
        if (hipGetDevice(&dev) != hipSuccess || hipDeviceGetAttribute(&cus, hipDeviceAttributeMultiprocessorCount, dev) != hipSuccess) { grid = -1; return; }
        if (hipFuncSetAttribute((const void*)mk_fwd, hipFuncAttributeMaxDynamicSharedMemorySize, LDS_BYTES) != hipSuccess) { fprintf(stderr, "kernel_launch: hipFuncSetAttribute failed\n"); grid = -1; return; }
        if (hipOccupancyMaxActiveBlocksPerMultiprocessor(&per_cu, (const void*)mk_fwd, 512, LDS_BYTES) != hipSuccess || per_cu < 1) { fprintf(stderr, "kernel_launch: occupancy query says %d blocks per CU\n", per_cu); per_cu = 1; }
        (void)hipGetLastError();
        grid = cus;
    }
    if (grid < 0) return;
    (void)hipMemsetAsync((char*)d_ws + WS_CTL, 0, CTL_ZERO_BYTES, stream);
    Args a{};
    const float** p = (const float**)&a;
    for (int i = 0; i < 22; ++i) p[i] = (const float*)d_in[i];
    a.out = (float*)d_out; a.ws = (unsigned char*)d_ws;
#if MK_PER_STEP_LAUNCH
    for (int s = 0; s < N_STEPS; ++s) { a.ph_lo = s; a.ph_hi = s + 1; hipLaunchKernelGGL(mk_fwd, dim3(grid), dim3(512), LDS_BYTES, stream, a); }
#else
    a.ph_lo = 0; a.ph_hi = N_STEPS;
    hipLaunchKernelGGL(mk_fwd, dim3(grid), dim3(512), LDS_BYTES, stream, a);
#endif
}
```

```cpp
#include <hip/hip_runtime.h>
#include <cstdio>
#include <cstdint>

#ifndef MK_PER_STEP_LAUNCH
#define MK_PER_STEP_LAUNCH 0
#endif

#define LAS __attribute__((address_space(3)))
typedef unsigned short bf16_t;
typedef short bf16x8 __attribute__((ext_vector_type(8)));
typedef float f32x4 __attribute__((ext_vector_type(4)));
typedef float f32x2 __attribute__((ext_vector_type(2)));
typedef unsigned u32x4 __attribute__((ext_vector_type(4)));
typedef unsigned u32x2 __attribute__((ext_vector_type(2)));

constexpr int D = 1024, T = 16384, SEQ = 4096, NBATCH = 4, DR = 1280, NHEAD = 10, DIN = 7680, NE = 16, FF = 512, DEPTH = 2;
constexpr int NCHUNK = 2, TH = T / NCHUNK;
constexpr int ZC = 4608;
constexpr int GGC = 2048;
constexpr int SCH = 64, NSCH = SEQ / SCH;
constexpr int MOE_ROWS = 36864, MOE_TILES = MOE_ROWS / 256;
constexpr float LN_EPS = 1e-5f;
constexpr float DN_ALPHA = 1.4142135623730951f;

constexpr size_t MiB = 1u << 20;
constexpr size_t WS_CTL = 0, CTL_ZERO_BYTES = 128 * 1024;
constexpr size_t WS_WIN = 1 * MiB;
constexpr size_t WS_WA = 16 * MiB;
constexpr size_t WS_WO = 21 * MiB;
constexpr size_t WS_WG = 23 * MiB;
constexpr size_t WS_XB = 24 * MiB;
constexpr size_t WS_U = 56 * MiB;
constexpr int UC = 2304;
constexpr size_t WS_GG = 128 * MiB;
constexpr size_t WS_Z = 192 * MiB;
constexpr size_t WS_XC = 280 * MiB;
constexpr size_t WS_GT = 300 * MiB;
constexpr size_t WS_SMALL = 340 * MiB;
constexpr size_t WS_MERGED = 256 * MiB;
constexpr size_t WS_Y = 56 * MiB;
constexpr size_t WS_X1 = 128 * MiB;
constexpr size_t WS_WEX = 192 * MiB;
constexpr size_t WS_XG = 240 * MiB;
constexpr size_t WS_H = 56 * MiB;
constexpr size_t WS_O = 240 * MiB;
constexpr size_t WS_NEED = 344 * MiB + 512 * 1024;
constexpr size_t SM_AEND = 0;
constexpr size_t SM_HEND = SM_AEND + (size_t)NBATCH * NSCH * DR * 4;
constexpr size_t SM_TOKE = SM_HEND + (size_t)NBATCH * NSCH * DR * 4;
constexpr size_t SM_TOKP = SM_TOKE + (size_t)T * 4;
constexpr size_t SM_TOKW = SM_TOKP + (size_t)T * 8;
constexpr size_t SM_ROWINFO = SM_TOKW + (size_t)T * 8;
constexpr size_t SM_WGCNT = SM_ROWINFO + (size_t)MOE_ROWS * 4;
constexpr size_t SM_PCONST = SM_WGCNT + 256 * 16 * 4;
constexpr size_t SM_END = SM_PCONST + 3 * 1280 * 4;
static_assert(WS_SMALL + SM_END <= WS_NEED, "small region");
constexpr int CW_BAR = 4096;
constexpr int CW_CNT = 8192;
constexpr int CW_NTILES = 8256;
constexpr int CW_TILEE = 8320;

constexpr int RING_BYTES = 131072;
constexpr int LDSCTL_OFF = RING_BYTES, MISC_OFF = LDSCTL_OFF + 320;
constexpr int LDS_BYTES = 147456;

__device__ __forceinline__ unsigned cvt_pk_bf16(float lo, float hi) { unsigned r; asm volatile("v_cvt_pk_bf16_f32 %0, %1, %2" : "=v"(r) : "v"(lo), "v"(hi)); return r; }
__device__ __forceinline__ float bflo(unsigned w) { return __uint_as_float(w << 16); }
__device__ __forceinline__ float bfhi(unsigned w) { return __uint_as_float(w & 0xffff0000u); }
__device__ __forceinline__ float bf1(bf16_t b) { return __uint_as_float((unsigned)b << 16); }
__device__ __forceinline__ float fsigmoid(float x) { return __fdividef(1.0f, 1.0f + __expf(-x)); }
__device__ __forceinline__ float gelu_tanh(float y) { const float u = 1.5957691216057308f * (y + 0.044715f * y * y * y); return y * fsigmoid(u); }
__device__ __forceinline__ float wave_sum(float v) {
#pragma unroll
    for (int o = 1; o < 64; o <<= 1) v += __shfl_xor(v, o);
    return v;
}
#define LDS_WAIT() asm volatile("s_waitcnt lgkmcnt(0)" ::: "memory")
#define VM_WAIT() asm volatile("s_waitcnt vmcnt(0)" ::: "memory")

namespace pg8 {
constexpr int BM = 256, BK = 64, HALF = 128, HTB = HALF * BK * 2, STAGE_BYTES = 8 * HTB, NXCD = 8, WGM = 8;
__host__ __device__ __forceinline__ int lds_byte(int r, int c) { const int st = (r >> 4) * 2 + (c >> 5), rr = r & 15, cc = c & 31, ob = rr * 64 + cc * 2; return st * 1024 + (ob ^ (((ob >> 9) & 1) << 5)); }
__host__ __device__ __forceinline__ void stage_rc(int b, int& R, int& C) { const int st = b / 1024, sb = b % 1024, swz = sb ^ (((sb >> 9) & 1) << 5); R = (st >> 1) * 16 + swz / 64; C = (st & 1) * 32 + (swz % 64) / 2; }
__host__ __device__ __forceinline__ int perm32(int rho) { const int n = rho >> 4, i = rho & 15; return 8 * (i >> 2) + 4 * n + (i & 3); }

struct Unit { const char* a; const char* b; int pm, pn; };

__device__ __forceinline__ bool static_order(int i, int G, int c, int nM, int nN, int& pm, int& pn) {
    const int nwg = nM * nN; const long L = (long)i * G + c; if (L >= nwg) return false;
    int wgid = (int)L; { const int q = nwg / NXCD, r = nwg % NXCD, xcd = wgid % NXCD, off = wgid / NXCD; wgid = (xcd < r ? xcd * (q + 1) : r * (q + 1) + (xcd - r) * q) + off; }
    const int nig = WGM * nN, gid = wgid / nig, fm = gid * WGM, gsz = (nM - fm) < WGM ? (nM - fm) : WGM;
    pm = fm + ((wgid % nig) % gsz); pn = (wgid % nig) / gsz; return true;
}
struct SchedPlain {
    int nM, nN, G, c; const char* A; const char* B; size_t a_tile, b_tile, a_pn;
    __device__ __forceinline__ bool next(int i, Unit& u) const {
        int pm, pn; if (!static_order(i, G, c, nM, nN, pm, pn)) return false;
        u.pm = pm; u.pn = pn; u.a = A + (size_t)pm * a_tile + (size_t)pn * a_pn; u.b = B + (size_t)pn * b_tile; return true;
    }
};
struct SchedMoe {
    int nM, nN, G, c; const char* A; const char* B; size_t a_tile, b_tile, b_exp; const unsigned* tile_e;
    __device__ __forceinline__ bool next(int i, Unit& u) const {
        int pm, pn; if (!static_order(i, G, c, nM, nN, pm, pn)) return false;
        const int e = __builtin_amdgcn_readfirstlane((int)__hip_atomic_load(tile_e + pm, __ATOMIC_RELAXED, __HIP_MEMORY_SCOPE_AGENT));
        u.pm = pm; u.pn = pn; u.a = A + (size_t)pm * a_tile; u.b = B + (size_t)e * b_exp + (size_t)pn * b_tile; return true;
    }
};

template <class Epi, class Sched, bool ALIGN_EPI, int HOOK_T = -1>
__device__ __forceinline__ void gemm_phase(LAS unsigned char* lds, const int lda, const int ldb, const int K, const Sched& S, const Epi& E) {
    int tid = threadIdx.x; asm volatile("" : "+v"(tid));
    const int wid = __builtin_amdgcn_readfirstlane(tid >> 6), lane = tid & 63, wr = wid >> 2, wc = wid & 3, fr = lane & 15, fq = lane >> 4;
    int Kop = K; asm volatile("" : "+s"(Kop));
    const int nt = Kop / BK;
    unsigned voffA[2], voffB[2];
#pragma unroll
    for (int i = 0; i < 2; ++i) { int R, C; stage_rc(tid * 16 + i * 8192, R, C); const int Rb = Epi::PERM ? ((R & ~31) + perm32(R & 31)) : R;
        voffA[i] = (unsigned)(R * lda + C) * 2u; voffB[i] = (unsigned)(Rb * ldb + C) * 2u; }
    const size_t kstep = (size_t)(BK * 2);
    const size_t hstepA = (size_t)HALF * lda * 2, hstepB = (size_t)HALF * ldb * 2;
    const unsigned ldsw = (unsigned)wid * 1024u;
    const int aoff = lds_byte(wr * 64 + fr, fq * 8), boff = lds_byte(wc * 32 + fr, fq * 8);
#define PG8_SA(b, h) (((b) * 2 + (h)) * HTB)
#define PG8_SB(b, h) ((4 + (b) * 2 + (h)) * HTB)
#define PG8_STAGE(bufoff, gbase, voff) do { _Pragma("unroll") for (int _i = 0; _i < 2; ++_i) \
        __builtin_amdgcn_global_load_lds((const unsigned*)((const char*)(gbase) + (voff)[_i]), (LAS unsigned*)(lds + (bufoff) + ldsw + _i * 8192), 16, 0, 0); } while (0)
#define PG8_LDA(dst, b, h) do { _Pragma("unroll") for (int m = 0; m < 4; ++m) _Pragma("unroll") for (int k = 0; k < 2; ++k) dst[m][k] = *(const LAS bf16x8*)(lds + PG8_SA(b, h) + aoff + m * 2048 + k * 1024); } while (0)
#define PG8_LDB(dst, b, h) do { _Pragma("unroll") for (int n = 0; n < 2; ++n) _Pragma("unroll") for (int k = 0; k < 2; ++k) dst[n][k] = *(const LAS bf16x8*)(lds + PG8_SB(b, h) + boff + n * 2048 + k * 1024); } while (0)
#define PG8_MMA(ai, bj, At, Bt) do { __builtin_amdgcn_s_setprio(1); _Pragma("unroll") for (int m = 0; m < 4; ++m) _Pragma("unroll") for (int n = 0; n < 2; ++n) _Pragma("unroll") for (int k = 0; k < 2; ++k) \
        acc[ai][bj][m][n] = __builtin_amdgcn_mfma_f32_16x16x32_bf16(Bt[n][k], At[m][k], acc[ai][bj][m][n], 0, 0, 0); __builtin_amdgcn_s_setprio(0); } while (0)
#define PG8_WAIT_V(n) asm volatile("s_waitcnt vmcnt(" #n ")" ::: "memory")
#define PG8_WAIT_L(n) asm volatile("s_waitcnt lgkmcnt(" #n ")" ::: "memory")
#define PG8_BAR __builtin_amdgcn_s_barrier()
#define PG8_SCHED __builtin_amdgcn_sched_barrier(0)
    Unit cur, nxt; int ui = 0;
    if (!S.next(0, cur)) return;
    f32x4 acc[2][2][4][2];
#pragma unroll
    for (int a = 0; a < 2; ++a)
#pragma unroll
        for (int b = 0; b < 2; ++b)
#pragma unroll
            for (int m = 0; m < 4; ++m)
#pragma unroll
                for (int n = 0; n < 2; ++n) acc[a][b][m][n] = (f32x4){0.f, 0.f, 0.f, 0.f};
    bf16x8 At[4][2], B0[2][2], B1[2][2];
    const char* cA = cur.a; const char* cB = cur.b;
    PG8_STAGE(PG8_SB(0, 0), cB, voffB); PG8_STAGE(PG8_SB(0, 1), cB + hstepB, voffB); PG8_STAGE(PG8_SA(0, 0), cA, voffA); PG8_STAGE(PG8_SA(0, 1), cA + hstepA, voffA);
    if (wr == 1) PG8_BAR;
    PG8_WAIT_V(2); PG8_BAR;
    PG8_STAGE(PG8_SB(1, 0), cB + kstep, voffB); PG8_STAGE(PG8_SA(1, 0), cA + kstep, voffA); PG8_STAGE(PG8_SB(1, 1), cB + hstepB + kstep, voffB);
    PG8_WAIT_V(6); PG8_BAR;
    for (;;) {
        const bool has_next = S.next(ui + 1, nxt);
        const char* nA = has_next ? nxt.a : cA; const char* nB = has_next ? nxt.b : cB;
        for (int t = 0; t < nt; t += 2) {
            const bool last = (t == nt - 2);
            if constexpr (HOOK_T >= 0) { if (t == HOOK_T) E.hook(acc, cur, wr, wc, fr, fq); }
            const char* a1 = cA + (size_t)(t + 1) * kstep;
            const char* a2 = last ? nA : cA + (size_t)(t + 2) * kstep; const char* b2 = last ? nB : cB + (size_t)(t + 2) * kstep;
            const char* a3 = a2 + kstep; const char* b3 = b2 + kstep;
            PG8_LDB(B0, 0, 0); PG8_LDB(B1, 0, 1); PG8_SCHED; PG8_LDA(At, 0, 0); PG8_STAGE(PG8_SA(1, 1), a1 + hstepA, voffA);
            PG8_WAIT_V(8); PG8_WAIT_L(0); PG8_BAR; PG8_MMA(0, 0, At, B0); PG8_MMA(0, 1, At, B1); PG8_BAR; PG8_SCHED;
            PG8_LDA(At, 0, 1); PG8_STAGE(PG8_SB(0, 0), b2, voffB); PG8_STAGE(PG8_SB(0, 1), b2 + hstepB, voffB); PG8_STAGE(PG8_SA(0, 0), a2, voffA);
            PG8_WAIT_V(8); PG8_WAIT_L(0); PG8_BAR; PG8_MMA(1, 0, At, B0); PG8_MMA(1, 1, At, B1); PG8_BAR; PG8_SCHED;
            PG8_LDB(B0, 1, 0); PG8_LDB(B1, 1, 1); PG8_SCHED; PG8_LDA(At, 1, 0); PG8_STAGE(PG8_SA(0, 1), a2 + hstepA, voffA);
            PG8_WAIT_V(8); PG8_WAIT_L(0); PG8_BAR; PG8_MMA(0, 0, At, B0); PG8_MMA(0, 1, At, B1); PG8_BAR; PG8_SCHED;
            PG8_LDA(At, 1, 1); PG8_STAGE(PG8_SB(1, 0), b3, voffB); PG8_STAGE(PG8_SB(1, 1), b3 + hstepB, voffB); PG8_STAGE(PG8_SA(1, 0), a3, voffA);
            PG8_WAIT_V(8); PG8_WAIT_L(0); PG8_BAR; PG8_MMA(1, 0, At, B0); PG8_MMA(1, 1, At, B1); PG8_BAR; PG8_SCHED;
        }
        if constexpr (ALIGN_EPI) { if (wr == 0) PG8_BAR; }
        E(acc, cur, wr, wc, fr, fq);
        if (!has_next) break;
#pragma unroll
        for (int a = 0; a < 2; ++a)
#pragma unroll
            for (int b = 0; b < 2; ++b)
#pragma unroll
                for (int m = 0; m < 4; ++m)
#pragma unroll
                    for (int n = 0; n < 2; ++n) acc[a][b][m][n] = (f32x4){0.f, 0.f, 0.f, 0.f};
        cur = nxt; cA = nA; cB = nB; ++ui;
        if constexpr (ALIGN_EPI) { if (wr == 1) PG8_BAR; }
    }
    PG8_WAIT_V(0);
    if constexpr (!ALIGN_EPI) { if (wr == 0) PG8_BAR; }
    PG8_BAR;
#undef PG8_SA
#undef PG8_SB
#undef PG8_STAGE
#undef PG8_LDA
#undef PG8_LDB
#undef PG8_MMA
#undef PG8_WAIT_V
#undef PG8_WAIT_L
#undef PG8_BAR
#undef PG8_SCHED
}

typedef const f32x4 (&AccRef)[2][2][4][2];
typedef f32x4 (&AccMut)[2][2][4][2];
#define EPI_LOOP_ROWS for (int ai = 0; ai < 2; ++ai) _Pragma("unroll") for (int m = 0; m < 4; ++m)

struct EpiZ {
    static constexpr bool PERM = true;
    bf16_t* Z; bf16_t* GG; int row_base;
    __device__ __forceinline__ void operator()(AccRef acc, const Unit& u, int wr, int wc, int fr, int fq) const {
        const int row0 = u.pm * BM + wr * 64 + fr;
        if (u.pn < 8) {
            bf16_t* base = Z + u.pn * HALF + wc * 32 + 8 * fq;
#pragma unroll
            EPI_LOOP_ROWS { const f32x4 h0 = acc[ai][0][m][0], h1 = acc[ai][0][m][1], c0 = acc[ai][1][m][0], c1 = acc[ai][1][m][1];
                u32x4 w; w.x = cvt_pk_bf16(h0[0] * c0[0], h0[1] * c0[1]); w.y = cvt_pk_bf16(h0[2] * c0[2], h0[3] * c0[3]); w.z = cvt_pk_bf16(h1[0] * c1[0], h1[1] * c1[1]); w.w = cvt_pk_bf16(h1[2] * c1[2], h1[3] * c1[3]);
                *(u32x4*)(base + (size_t)(row0 + ai * HALF + m * 16) * ZC) = w; }
        } else {
            const int colt = u.pn * BM + wc * 32 + 8 * fq; const int act = u.pn < 17 ? 0 : (u.pn < 22 ? 1 : 2);
            bf16_t* base; size_t ldc;
            if (u.pn < 22) { base = Z + (colt - 1024); ldc = ZC; } else { base = GG + (size_t)row_base * GGC + (colt - 5632); ldc = GGC; }
#pragma unroll
            EPI_LOOP_ROWS { bf16_t* rowp = base + (size_t)(row0 + ai * HALF + m * 16) * ldc;
#pragma unroll
                for (int bj = 0; bj < 2; ++bj) { f32x4 v0 = acc[ai][bj][m][0], v1 = acc[ai][bj][m][1];
                    if (act == 1) {
#pragma unroll
                        for (int j = 0; j < 4; ++j) { v0[j] = gelu_tanh(v0[j]); v1[j] = gelu_tanh(v1[j]); } }
                    else if (act == 2) {
#pragma unroll
                        for (int j = 0; j < 4; ++j) { v0[j] = fsigmoid(v0[j]); v1[j] = fsigmoid(v1[j]); } }
                    u32x4 w; w.x = cvt_pk_bf16(v0[0], v0[1]); w.y = cvt_pk_bf16(v0[2], v0[3]); w.z = cvt_pk_bf16(v1[0], v1[1]); w.w = cvt_pk_bf16(v1[2], v1[3]);
                    *(u32x4*)(rowp + bj * HALF) = w; } }
        }
    }
};
struct EpiBf16 {
    static constexpr bool PERM = true;
    bf16_t* O; int ldc;
    __device__ __forceinline__ void operator()(AccRef acc, const Unit& u, int wr, int wc, int fr, int fq) const {
        const int row0 = u.pm * BM + wr * 64 + fr; const int colt = u.pn * BM + wc * 32 + 8 * fq;
#pragma unroll
        EPI_LOOP_ROWS { bf16_t* rowp = O + (size_t)(row0 + ai * HALF + m * 16) * ldc + colt;
#pragma unroll
            for (int bj = 0; bj < 2; ++bj) { const f32x4 v0 = acc[ai][bj][m][0], v1 = acc[ai][bj][m][1];
                u32x4 w; w.x = cvt_pk_bf16(v0[0], v0[1]); w.y = cvt_pk_bf16(v0[2], v0[3]); w.z = cvt_pk_bf16(v1[0], v1[1]); w.w = cvt_pk_bf16(v1[2], v1[3]);
                *(u32x4*)(rowp + bj * HALF) = w; } }
    }
};
struct EpiRG {
    static constexpr bool PERM = true;
    bf16_t* GT; const bf16_t* XC; const float* PC;
    __device__ __forceinline__ void operator()(AccRef acc, const Unit& u, int wr, int wc, int fr, int fq) const {
        const int row0 = u.pm * BM + wr * 64 + fr; const int cc = wc * 32 + 8 * fq, ch = u.pn * HALF + cc;
        float c8[8], ba[8], bx[8];
        { const f32x4 a0 = *(const f32x4*)(PC + ch), a1 = *(const f32x4*)(PC + ch + 4), b0 = *(const f32x4*)(PC + DR + ch), b1 = *(const f32x4*)(PC + DR + ch + 4), x0 = *(const f32x4*)(PC + 2 * DR + ch), x1 = *(const f32x4*)(PC + 2 * DR + ch + 4);
#pragma unroll
          for (int j = 0; j < 4; ++j) { c8[j] = a0[j]; c8[4 + j] = a1[j]; ba[j] = b0[j]; ba[4 + j] = b1[j]; bx[j] = x0[j]; bx[4 + j] = x1[j]; } }
#pragma unroll
        EPI_LOOP_ROWS { const size_t r = (size_t)(row0 + ai * HALF + m * 16);
            const u32x4 xw = *(const u32x4*)(XC + r * DR + ch);
            float xc[8]; xc[0] = bflo(xw.x); xc[1] = bfhi(xw.x); xc[2] = bflo(xw.y); xc[3] = bfhi(xw.y); xc[4] = bflo(xw.z); xc[5] = bfhi(xw.z); xc[6] = bflo(xw.w); xc[7] = bfhi(xw.w);
            float la[8], bb[8];
#pragma unroll
            for (int n = 0; n < 2; ++n)
#pragma unroll
                for (int j = 0; j < 4; ++j) { const int k = 4 * n + j; const float rp = acc[ai][0][m][n][j], ip = acc[ai][1][m][n][j];
                    const float l = -c8[k] * fsigmoid(rp + ba[k]); const float x = 2.0f * l;
                    float em = -x * (1.0f + x * (0.5f + x * (0.16666667f + x * (0.041666668f + x * (0.0083333338f + x * 0.0013888889f)))));
                    if (x < -0.4f) em = 1.0f - __expf(x);
                    la[k] = l; bb[k] = sqrtf(em) * fsigmoid(ip + bx[k]) * xc[k]; }
            u32x4 w0, w1; w0.x = cvt_pk_bf16(la[0], la[1]); w0.y = cvt_pk_bf16(la[2], la[3]); w0.z = cvt_pk_bf16(la[4], la[5]); w0.w = cvt_pk_bf16(la[6], la[7]);
            w1.x = cvt_pk_bf16(bb[0], bb[1]); w1.y = cvt_pk_bf16(bb[2], bb[3]); w1.z = cvt_pk_bf16(bb[4], bb[5]); w1.w = cvt_pk_bf16(bb[6], bb[7]);
            *(u32x4*)(GT + r * 2560 + u.pn * BM + cc) = w0; *(u32x4*)(GT + r * 2560 + u.pn * BM + HALF + cc) = w1;
            if (m & 1) asm volatile("" ::: "memory"); }
    }
};
struct EpiMix {
    static constexpr bool PERM = true;
    const bf16_t* GG; bf16_t* MG;
    __device__ __forceinline__ void hook(AccMut acc, const Unit& u, int wr, int wc, int fr, int fq) const {
        int row0 = u.pm * BM + wr * 64 + fr; asm volatile("" : "+v"(row0));
        const int colt = u.pn * BM + wc * 32 + 8 * fq;
#pragma unroll
        EPI_LOOP_ROWS { const size_t r = (size_t)(row0 + ai * HALF + m * 16);
#pragma unroll
            for (int bj = 0; bj < 2; ++bj) { const int c = colt + bj * HALF; const u32x4 ga = *(const u32x4*)(GG + r * GGC + c), gr = *(const u32x4*)(GG + r * GGC + D + c);
                f32x4 q0, q1;
                q0[0] = __fdividef(bflo(ga.x), bflo(gr.x)); q0[1] = __fdividef(bfhi(ga.x), bfhi(gr.x)); q0[2] = __fdividef(bflo(ga.y), bflo(gr.y)); q0[3] = __fdividef(bfhi(ga.y), bfhi(gr.y));
                q1[0] = __fdividef(bflo(ga.z), bflo(gr.z)); q1[1] = __fdividef(bfhi(ga.z), bfhi(gr.z)); q1[2] = __fdividef(bflo(ga.w), bflo(gr.w)); q1[3] = __fdividef(bfhi(ga.w), bfhi(gr.w));
                acc[ai][bj][m][0] *= q0; acc[ai][bj][m][1] *= q1; }
            asm volatile("" ::: "memory"); }
    }
    __device__ __forceinline__ void operator()(AccRef acc, const Unit& u, int wr, int wc, int fr, int fq) const {
        const int row0 = u.pm * BM + wr * 64 + fr; const int colt = u.pn * BM + wc * 32 + 8 * fq;
#pragma unroll
        EPI_LOOP_ROWS { const size_t r = (size_t)(row0 + ai * HALF + m * 16);
#pragma unroll
            for (int bj = 0; bj < 2; ++bj) { const int c = colt + bj * HALF; const u32x4 g = *(const u32x4*)(GG + r * GGC + D + c);
                const f32x4 v0 = acc[ai][bj][m][0], v1 = acc[ai][bj][m][1];
                u32x4 w; w.x = cvt_pk_bf16(bflo(g.x) * v0[0], bfhi(g.x) * v0[1]); w.y = cvt_pk_bf16(bflo(g.y) * v0[2], bfhi(g.y) * v0[3]);
                w.z = cvt_pk_bf16(bflo(g.z) * v1[0], bfhi(g.z) * v1[1]); w.w = cvt_pk_bf16(bflo(g.w) * v1[2], bfhi(g.w) * v1[3]);
                *(u32x4*)(MG + r * D + c) = w; }
            asm volatile("" ::: "memory"); }
    }
};
struct EpiY {
    static constexpr bool PERM = false;
    const float* X0; float* Y;
    __device__ __forceinline__ void operator()(AccRef acc, const Unit& u, int wr, int wc, int fr, int fq) const {
        const int row0 = u.pm * BM + wr * 64 + fr, col0 = u.pn * BM + wc * 32 + 4 * fq;
#pragma unroll
        EPI_LOOP_ROWS { const size_t r = (size_t)(row0 + ai * HALF + m * 16);
#pragma unroll
            for (int bj = 0; bj < 2; ++bj)
#pragma unroll
                for (int n = 0; n < 2; ++n) { const int c = col0 + bj * HALF + n * 16; const f32x4 x = *(const f32x4*)(X0 + r * D + c);
                    *(f32x4*)(Y + r * D + c) = x * DN_ALPHA + acc[ai][bj][m][n]; }
            asm volatile("" ::: "memory"); }
    }
};
struct EpiH {
    static constexpr bool PERM = true;
    bf16_t* H;
    __device__ __forceinline__ void operator()(AccRef acc, const Unit& u, int wr, int wc, int fr, int fq) const {
        const int row0 = u.pm * BM + wr * 64 + fr; const int col = u.pn * HALF + wc * 32 + 8 * fq;
#pragma unroll
        EPI_LOOP_ROWS { const size_t r = (size_t)(row0 + ai * HALF + m * 16);
            const f32x4 g0 = acc[ai][0][m][0], g1 = acc[ai][0][m][1], u0 = acc[ai][1][m][0], u1 = acc[ai][1][m][1];
            u32x4 w;
            w.x = cvt_pk_bf16(g0[0] * fsigmoid(g0[0]) * u0[0], g0[1] * fsigmoid(g0[1]) * u0[1]);
            w.y = cvt_pk_bf16(g0[2] * fsigmoid(g0[2]) * u0[2], g0[3] * fsigmoid(g0[3]) * u0[3]);
            w.z = cvt_pk_bf16(g1[0] * fsigmoid(g1[0]) * u1[0], g1[1] * fsigmoid(g1[1]) * u1[1]);
            w.w = cvt_pk_bf16(g1[2] * fsigmoid(g1[2]) * u1[2], g1[3] * fsigmoid(g1[3]) * u1[3]);
            *(u32x4*)(H + r * FF + col) = w; }
    }
};
struct EpiO {
    static constexpr bool PERM = true;
    bf16_t* O; const int* rowinfo;
    __device__ __forceinline__ void operator()(AccRef acc, const Unit& u, int wr, int wc, int fr, int fq) const {
        const int row0 = u.pm * BM + wr * 64 + fr; const int colt = u.pn * BM + wc * 32 + 8 * fq;
#pragma unroll
        EPI_LOOP_ROWS { const int dst = rowinfo[row0 + ai * HALF + m * 16];
            if (dst >= 0) { bf16_t* rowp = O + (size_t)dst * D + colt;
#pragma unroll
                for (int bj = 0; bj < 2; ++bj) { const f32x4 v0 = acc[ai][bj][m][0], v1 = acc[ai][bj][m][1];
                    u32x4 w; w.x = cvt_pk_bf16(v0[0], v0[1]); w.y = cvt_pk_bf16(v0[2], v0[3]); w.z = cvt_pk_bf16(v1[0], v1[1]); w.w = cvt_pk_bf16(v1[2], v1[3]);
                    *(u32x4*)(rowp + bj * HALF) = w; } } }
    }
};
}

#define XB_TMO      128
#define XB_XCNT(j)  (256  + 64 * (j))
#define XB_XSUB(j)  (1280 + 64 * (j))
#define XB_XGEN(j)  (2304 + 64 * (j))
#define XB_TOP      3328
#define XB_TOPGEN   3392
#define XCD_BAR_WORDS 3456
#define XB_SPIN_CAP (1u << 18)
__device__ __forceinline__ unsigned xb_ld(unsigned* p)              { return __hip_atomic_load(p, __ATOMIC_RELAXED, __HIP_MEMORY_SCOPE_AGENT); }
__device__ __forceinline__ unsigned xb_add(unsigned* p, unsigned v) { return __hip_atomic_fetch_add(p, v, __ATOMIC_RELAXED, __HIP_MEMORY_SCOPE_AGENT); }
__device__ __forceinline__ unsigned xb_xcc_id() { return (unsigned)__builtin_amdgcn_s_getreg((3 << 11) | 20) & 0xFu; }
#define XB_SPIN(cond, bar) do { unsigned _sp = 0; while (cond) { __builtin_amdgcn_s_sleep(1); \
    if ((++_sp & 255u) == 0u) { if (xb_ld(&(bar)[XB_TMO])) break; if (_sp > XB_SPIN_CAP) { atomicAdd(&(bar)[XB_TMO], 1u); break; } } } } while (0)
struct XcdBarrier { unsigned* bar; unsigned x; volatile LAS unsigned* st; };
__device__ __forceinline__ XcdBarrier xcd_barrier_post(unsigned* bar, volatile LAS unsigned* st) {
    XcdBarrier b; b.bar = bar; b.x = xb_xcc_id(); b.st = st;
    if (threadIdx.x == 0) (void)xb_add(&bar[XB_XCNT(b.x)], 1u);
    return b;
}
__device__ __forceinline__ void xcd_barrier_complete(unsigned* bar, unsigned x, unsigned& nloc, unsigned& nx) {
    const unsigned G = gridDim.x * gridDim.y * gridDim.z;
    unsigned sum, cnt, mine, sp = 0u;
    for (;;) {
        sum = 0u; cnt = 0u; mine = 0u;
#pragma unroll
        for (unsigned j = 0; j < 16; ++j) { const unsigned c = xb_ld(&bar[XB_XCNT(j)]); sum += c; cnt += (c > 0u) ? 1u : 0u; mine = (j == x) ? c : mine; }
        if (sum == G) break;
        __builtin_amdgcn_s_sleep(1);
        if ((++sp & 255u) == 0u) { if (xb_ld(&bar[XB_TMO])) break; if (sp > XB_SPIN_CAP) { atomicAdd(&bar[XB_TMO], 1u); break; } }
    }
    nloc = mine > 0u ? mine : 1u; nx = cnt > 0u ? cnt : 1u;
}
__device__ __forceinline__ void xcd_barrier(const XcdBarrier& b) {
    asm volatile("s_waitcnt vmcnt(0)" ::: "memory");
    __syncthreads();
    if (threadIdx.x == 0) {
        unsigned* bar = b.bar;
        __builtin_amdgcn_s_waitcnt(0);
        unsigned nloc = b.st[0], nx = b.st[1];
        if (nloc == 0u) { xcd_barrier_complete(bar, b.x, nloc, nx); b.st[0] = nloc; b.st[1] = nx; }
        const unsigned old = xb_add(&bar[XB_XSUB(b.x)], 1u);
        const unsigned gen = old / nloc;
        if (old + 1u == (gen + 1u) * nloc) {
            __builtin_amdgcn_fence(__ATOMIC_RELEASE, "agent");
            asm volatile("s_waitcnt vmcnt(0)" ::: "memory");
            const unsigned og = xb_add(&bar[XB_TOP], 1u);
            const unsigned tg = og / nx;
            if (og + 1u == (tg + 1u) * nx) xb_add(&bar[XB_TOPGEN], 1u);
            else XB_SPIN(xb_ld(&bar[XB_TOPGEN]) == tg, bar);
            __builtin_amdgcn_fence(__ATOMIC_ACQUIRE, "agent");
            xb_add(&bar[XB_XGEN(b.x)], 1u);
            asm volatile("s_waitcnt vmcnt(0)" ::: "memory");
        } else {
            XB_SPIN(xb_ld(&bar[XB_XGEN(b.x)]) == gen, bar);
            __builtin_amdgcn_fence(__ATOMIC_ACQUIRE, "agent");
            asm volatile("s_waitcnt vmcnt(0)" ::: "memory");
        }
    }
    __syncthreads();
}

struct Args {
    const float* x; const float* w_in; const float* conv_a_w; const float* w_branch_a; const float* conv_r_w; const float* conv_r_b;
    const float* w_rg_a; const float* b_rg_a; const float* w_rg_x; const float* b_rg_x; const float* rg_lambda; const float* w_branch_r; const float* w_out;
    const float* ln1_g; const float* ln1_b; const float* w_router; const float* b_router; const float* w_exp_gate; const float* w_exp_up; const float* w_exp_down;
    const float* ln2_g; const float* ln2_b;
    float* out; unsigned char* ws; int ph_lo, ph_hi;
};

typedef const Args __attribute__((address_space(4)))* ArgsP;

__device__ __forceinline__ void transpose_item(const float* W, int N, int k0, int n0, bf16_t* WT, int ldk, int drow0, LAS float* scr, int lane) {
    float tv[32];
    { const float* wp = W + (size_t)(k0 + (lane >> 5)) * N + n0 + (lane & 31);
#pragma unroll
      for (int i = 0; i < 32; ++i) tv[i] = wp[(size_t)(2 * i) * N]; }
#pragma unroll
    for (int i = 0; i < 32; ++i) scr[(2 * i + (lane >> 5)) * 33 + (lane & 31)] = tv[i];
    LDS_WAIT(); asm volatile("" ::: "memory");
    const int c = lane & 7;
#pragma unroll
    for (int j = 0; j < 4; ++j) { const int n = (lane >> 3) + 8 * j; const LAS float* s = scr + (8 * c) * 33 + n;
        u32x4 o; o.x = cvt_pk_bf16(s[0 * 33], s[1 * 33]); o.y = cvt_pk_bf16(s[2 * 33], s[3 * 33]); o.z = cvt_pk_bf16(s[4 * 33], s[5 * 33]); o.w = cvt_pk_bf16(s[6 * 33], s[7 * 33]);
        *(u32x4*)(WT + (size_t)(drow0 + n) * ldk + k0 + 8 * c) = o; }
    LDS_WAIT(); asm volatile("" ::: "memory");
}
__device__ __forceinline__ void transpose_plain(const float* W, int K, int N, bf16_t* WT, int item, LAS float* scr, int lane) {
    const int nblk = N / 32, kb = item / nblk, nb = item % nblk;
    transpose_item(W, N, 64 * kb, 32 * nb, WT, K, 32 * nb, scr, lane);
}

__device__ __forceinline__ void prep_tm_weights(ArgsP a, int l, unsigned char* ws, LAS float* scr, int gw, int NGW, int lane) {
    constexpr int I_IN = (D / 64) * (DIN / 32), I_A = (D / 64) * (D / 32), I_R = (DR / 64) * (D / 32), I_O = I_A, I_G = 2 * NHEAD * 2 * 4;
    constexpr int NITEMS = I_IN + I_A + I_R + I_O + I_G;
    if (gw < 20) { const int c = gw * 64 + lane; float* PC = (float*)(ws + WS_SMALL + SM_PCONST);
        PC[c] = 8.0f * log1pf(__expf(-a->rg_lambda[(size_t)l * DR + c])); PC[DR + c] = a->b_rg_a[(size_t)l * DR + c]; PC[2 * DR + c] = a->b_rg_x[(size_t)l * DR + c]; }
    for (int it = gw; it < NITEMS; it += NGW) {
        int r = it;
        if (r < I_IN) { const int nblk = DIN / 32, kb = r / nblk, n0 = 32 * (r % nblk);
            const int drow0 = n0 < 1024 ? (n0 >> 7) * 256 + (n0 & 127) : (n0 < 2048 ? n0 + 1024 : (n0 < 3072 ? ((n0 - 2048) >> 7) * 256 + 128 + (n0 & 127) : n0));
            transpose_item(a->w_in + (size_t)l * D * DIN, DIN, 64 * kb, n0, (bf16_t*)(ws + WS_WIN), D, drow0, scr, lane); continue; } r -= I_IN;
        if (r < I_A) { const int kb = r / (D / 32), nb = r % (D / 32); transpose_item(a->w_branch_a + (size_t)l * D * D, D, 64 * kb, 32 * nb, (bf16_t*)(ws + WS_WA), UC, 32 * nb, scr, lane); continue; } r -= I_A;
        if (r < I_R) { const int kb = r / (D / 32), nb = r % (D / 32); transpose_item(a->w_branch_r + (size_t)l * DR * D, D, 64 * kb, 32 * nb, (bf16_t*)(ws + WS_WA) + D, UC, 32 * nb, scr, lane); continue; } r -= I_R;
        if (r < I_O) { transpose_plain(a->w_out + (size_t)l * D * D, D, D, (bf16_t*)(ws + WS_WO), r, scr, lane); continue; } r -= I_O;
        {
            const int nb = r & 3, kb = (r >> 2) & 1, hw = r >> 3, which = hw & 1, hh = hw >> 1;
            const float* W = (which ? a->w_rg_x : a->w_rg_a) + ((size_t)l * NHEAD + hh) * 128 * 128;
            transpose_item(W, 128, 64 * kb, 32 * nb, (bf16_t*)(ws + WS_WG), 128, hh * 256 + which * 128 + 32 * nb, scr, lane);
        }
    }
}
__device__ __forceinline__ void prep_expert_weights(ArgsP a, int l, unsigned char* ws, LAS float* scr, int gw, int NGW, int lane) {
    constexpr int I_G = (D / 64) * (FF / 32), I_D = (FF / 64) * (D / 32), PER_E = 2 * I_G + I_D;
    bf16_t* WGU = (bf16_t*)(ws + WS_WEX); bf16_t* WDN = WGU + (size_t)NE * 1024 * 1024;
    for (int it = gw; it < NE * PER_E; it += NGW) {
        const int e = it / PER_E; int r = it % PER_E;
        if (r < 2 * I_G) { const int which = r / I_G; r %= I_G; const int nblk = FF / 32, kb = r / nblk, nb = r % nblk, n0 = 32 * nb;
            const float* W = (which ? a->w_exp_up : a->w_exp_gate) + ((size_t)l * NE + e) * D * FF;
            const int drow0 = (n0 >> 7) * 256 + which * 128 + (n0 & 127);
            transpose_item(W, FF, 64 * kb, n0, WGU + (size_t)e * 1024 * 1024, D, drow0, scr, lane);
        } else { r -= 2 * I_G; const float* W = a->w_exp_down + ((size_t)l * NE + e) * FF * D;
            transpose_plain(W, FF, D, WDN + (size_t)e * 1024 * 512, r, scr, lane); }
    }
}
__device__ __forceinline__ void cvt_x(const float* x, bf16_t* xb, int gtid, int nthr) {
    for (size_t i = gtid; i < (size_t)T * D / 8; i += (size_t)4 * nthr) {
        f32x4 a[4], b[4];
#pragma unroll
        for (int k = 0; k < 4; ++k) { a[k] = *(const f32x4*)(x + (i + (size_t)k * nthr) * 8); b[k] = *(const f32x4*)(x + (i + (size_t)k * nthr) * 8 + 4); }
#pragma unroll
        for (int k = 0; k < 4; ++k) { u32x4 w; w.x = cvt_pk_bf16(a[k][0], a[k][1]); w.y = cvt_pk_bf16(a[k][2], a[k][3]); w.z = cvt_pk_bf16(b[k][0], b[k][1]); w.w = cvt_pk_bf16(b[k][2], b[k][3]); *(u32x4*)(xb + (i + (size_t)k * nthr) * 8) = w; } }
}
__device__ __forceinline__ void unpack8(const u32x4 w, float (&f)[8]) { f[0] = bflo(w.x); f[1] = bfhi(w.x); f[2] = bflo(w.y); f[3] = bfhi(w.y); f[4] = bflo(w.z); f[5] = bfhi(w.z); f[6] = bflo(w.w); f[7] = bfhi(w.w); }
__device__ __forceinline__ u32x4 pack8(const float (&f)[8]) { u32x4 w; w.x = cvt_pk_bf16(f[0], f[1]); w.y = cvt_pk_bf16(f[2], f[3]); w.z = cvt_pk_bf16(f[4], f[5]); w.w = cvt_pk_bf16(f[6], f[7]); return w; }

__device__ __forceinline__ void phase_e1(ArgsP a, int l, int half, unsigned char* ws, int gtid, int nthr) {
    const bf16_t* Z = (const bf16_t*)(ws + WS_Z); bf16_t* UA = (bf16_t*)(ws + WS_U) + (size_t)half * TH * UC; bf16_t* XC = (bf16_t*)(ws + WS_XC);
    constexpr int RUN = 8;
    constexpr int NA = (TH / RUN) * (D / 8), NR = (TH / RUN) * (DR / 8);
    for (int it = gtid; it < NA + NR; it += nthr) {
        if (it < NA) {
            const int cg = it % (D / 8), run = it / (D / 8), t0 = run * RUN, c0 = cg * 8;
            const bool first = (t0 & (SEQ - 1)) == 0;
            u32x4 vv[RUN + 2], bw[RUN];
            vv[0] = first ? (u32x4){0u, 0u, 0u, 0u} : *(const u32x4*)(Z + (size_t)(t0 - 2) * ZC + c0);
            vv[1] = first ? (u32x4){0u, 0u, 0u, 0u} : *(const u32x4*)(Z + (size_t)(t0 - 1) * ZC + c0);
#pragma unroll
            for (int i = 0; i < RUN; ++i) { vv[i + 2] = *(const u32x4*)(Z + (size_t)(t0 + i) * ZC + c0); bw[i] = *(const u32x4*)(Z + (size_t)(t0 + i) * ZC + D + c0); }
            float w0[8], w1[8], w2[8];
            { const float* cw = a->conv_a_w + (size_t)l * 3 * D + c0;
#pragma unroll
              for (int j = 0; j < 8; ++j) { w0[j] = cw[j]; w1[j] = cw[D + j]; w2[j] = cw[2 * D + j]; } }
            float vm2[8], vm1[8]; unpack8(vv[0], vm2); unpack8(vv[1], vm1);
#pragma unroll
            for (int i = 0; i < RUN; ++i) { float v[8], bb[8], o[8]; unpack8(vv[i + 2], v); unpack8(bw[i], bb);
#pragma unroll
                for (int j = 0; j < 8; ++j) { o[j] = bb[j] * (w0[j] * vm2[j] + w1[j] * vm1[j] + w2[j] * v[j]); vm2[j] = vm1[j]; vm1[j] = v[j]; }
                *(u32x4*)(UA + (size_t)(t0 + i) * UC + c0) = pack8(o); }
        } else {
            const int r = it - NA; const int cg = r % (DR / 8), run = r / (DR / 8), t0 = run * RUN, c0 = cg * 8;
            const bool first = (t0 & (SEQ - 1)) == 0;
            u32x4 xv[RUN + 3];
#pragma unroll
            for (int i = 0; i < 3; ++i) xv[i] = first ? (u32x4){0u, 0u, 0u, 0u} : *(const u32x4*)(Z + (size_t)(t0 - 3 + i) * ZC + 2 * D + c0);
#pragma unroll
            for (int i = 0; i < RUN; ++i) xv[i + 3] = *(const u32x4*)(Z + (size_t)(t0 + i) * ZC + 2 * D + c0);
            float w0[8], w1[8], w2[8], w3[8], bi[8];
            { const float* cw = a->conv_r_w + (size_t)l * 4 * DR + c0; const float* cb = a->conv_r_b + (size_t)l * DR + c0;
#pragma unroll
              for (int j = 0; j < 8; ++j) { w0[j] = cw[j]; w1[j] = cw[DR + j]; w2[j] = cw[2 * DR + j]; w3[j] = cw[3 * DR + j]; bi[j] = cb[j]; } }
            float x3[8], x2[8], x1[8]; unpack8(xv[0], x3); unpack8(xv[1], x2); unpack8(xv[2], x1);
#pragma unroll
            for (int i = 0; i < RUN; ++i) { float x0[8], o[8]; unpack8(xv[i + 3], x0);
#pragma unroll
                for (int j = 0; j < 8; ++j) { o[j] = w0[j] * x3[j] + w1[j] * x2[j] + w2[j] * x1[j] + w3[j] * x0[j] + bi[j]; x3[j] = x2[j]; x2[j] = x1[j]; x1[j] = x0[j]; }
                *(u32x4*)(XC + (size_t)(t0 + i) * DR + c0) = pack8(o); }
        }
    }
}

template <bool FINAL>
__device__ __forceinline__ void phase_scan(int half, unsigned char* ws, int gtid, int nthr) {
    const bf16_t* GT = (const bf16_t*)(ws + WS_GT); const bf16_t* Z = (const bf16_t*)(ws + WS_Z);
    float* AEND = (float*)(ws + WS_SMALL + SM_AEND); float* HEND = (float*)(ws + WS_SMALL + SM_HEND);
    bf16_t* UR = (bf16_t*)(ws + WS_U) + (size_t)half * TH * UC + D;
    constexpr int NP = DR / 2, NITEMS = (TH / SEQ) * NSCH * NP, BT = 16;
    for (int it = gtid; it < NITEMS; it += nthr) {
        const int cp = it % NP, j = (it / NP) % NSCH, bl = it / (NP * NSCH), c = 2 * cp, hh = c >> 7, cc = c & 127, b = half * (TH / SEQ) + bl;
        float h0 = 0.f, h1 = 0.f, L0 = 0.f, L1 = 0.f;
        if (FINAL) {
            const size_t sb = (size_t)b * NSCH * DR + c; int jj = 0;
            for (; jj + 8 <= j; jj += 8) { f32x2 ae[8], he[8];
#pragma unroll
                for (int k = 0; k < 8; ++k) { ae[k] = *(const f32x2*)(AEND + sb + (size_t)(jj + k) * DR); he[k] = *(const f32x2*)(HEND + sb + (size_t)(jj + k) * DR); }
#pragma unroll
                for (int k = 0; k < 8; ++k) { h0 = ae[k].x * h0 + he[k].x; h1 = ae[k].y * h1 + he[k].y; } }
            for (; jj < j; ++jj) { const f32x2 ae = *(const f32x2*)(AEND + sb + (size_t)jj * DR), he = *(const f32x2*)(HEND + sb + (size_t)jj * DR); h0 = ae.x * h0 + he.x; h1 = ae.y * h1 + he.y; }
        }
        const size_t row0 = (size_t)bl * SEQ + (size_t)j * SCH;
        const bf16_t* gl = GT + row0 * 2560 + hh * 256 + cc; const bf16_t* zy = Z + row0 * ZC + 2 * D + DR + c; bf16_t* ur = UR + row0 * UC + c;
#pragma unroll 1
        for (int t0 = 0; t0 < SCH; t0 += BT) {
            unsigned lw[BT], bw[BT], yw[BT];
#pragma unroll
            for (int k = 0; k < BT; ++k) { lw[k] = *(const unsigned*)(gl + (size_t)(t0 + k) * 2560); bw[k] = *(const unsigned*)(gl + (size_t)(t0 + k) * 2560 + 128);
                if (FINAL) yw[k] = *(const unsigned*)(zy + (size_t)(t0 + k) * ZC); }
#pragma unroll
            for (int k = 0; k < BT; ++k) { const float l0 = bflo(lw[k]), l1 = bfhi(lw[k]);
                h0 = __expf(l0) * h0 + bflo(bw[k]); h1 = __expf(l1) * h1 + bfhi(bw[k]);
                if (FINAL) *(unsigned*)(ur + (size_t)(t0 + k) * UC) = cvt_pk_bf16(h0 * bflo(yw[k]), h1 * bfhi(yw[k]));
                else { L0 += l0; L1 += l1; } }
        }
        if (!FINAL) { const size_t si = ((size_t)b * NSCH + j) * DR + c; *(f32x2*)(AEND + si) = (f32x2){__expf(L0), __expf(L1)}; *(f32x2*)(HEND + si) = (f32x2){h0, h1}; }
    }
}

__device__ __forceinline__ void phase_ln1_router(ArgsP a, int l, unsigned char* ws, LAS unsigned char* lds, int tid, int lane, int gw, int NGW, int vcu) {
    LAS f32x4* wl = (LAS f32x4*)lds;
    for (int idx = tid; idx < 4096; idx += 512) { const int ln = idx & 63, q = (idx >> 6) & 3, jk = idx >> 8, d = 4 * ln + 256 * (jk >> 2) + (jk & 3);
        wl[idx] = *(const f32x4*)(a->w_router + (size_t)d * NE + 4 * q); }
    LAS unsigned* lcnt = (LAS unsigned*)(lds + 65536);
    if (tid < NE) lcnt[tid] = 0u;
    __syncthreads();
    const float* Y = (const float*)(ws + WS_Y); float* X1 = (float*)(ws + WS_X1); bf16_t* XB = (bf16_t*)(ws + WS_XB);
    unsigned* TOKE = (unsigned*)(ws + WS_SMALL + SM_TOKE); unsigned* TOKP = (unsigned*)(ws + WS_SMALL + SM_TOKP); float* TOKW = (float*)(ws + WS_SMALL + SM_TOKW);
    f32x4 gv[4], bv[4];
#pragma unroll
    for (int j = 0; j < 4; ++j) { gv[j] = *(const f32x4*)(a->ln1_g + (size_t)l * D + 4 * lane + 256 * j); bv[j] = *(const f32x4*)(a->ln1_b + (size_t)l * D + 4 * lane + 256 * j); }
    float br[16];
#pragma unroll
    for (int e = 0; e < 16; ++e) br[e] = a->b_router[e];
    for (int t = gw; t < T; t += NGW) {
        f32x4 v[4]; float s = 0.f;
#pragma unroll
        for (int j = 0; j < 4; ++j) { v[j] = *(const f32x4*)(Y + (size_t)t * D + 4 * lane + 256 * j); s += (v[j][0] + v[j][1]) + (v[j][2] + v[j][3]); }
        const float mean = wave_sum(s) * (1.f / D); float s2 = 0.f;
#pragma unroll
        for (int j = 0; j < 4; ++j) { v[j] = v[j] - mean; s2 += (v[j][0] * v[j][0] + v[j][1] * v[j][1]) + (v[j][2] * v[j][2] + v[j][3] * v[j][3]); }
        const float rstd = 1.f / sqrtf(wave_sum(s2) * (1.f / D) + LN_EPS);
        float acc[16];
#pragma unroll
        for (int e = 0; e < 16; ++e) acc[e] = 0.f;
#pragma unroll
        for (int j = 0; j < 4; ++j) { v[j] = v[j] * rstd * gv[j] + bv[j];
            *(f32x4*)(X1 + (size_t)t * D + 4 * lane + 256 * j) = v[j];
            u32x2 w; w.x = cvt_pk_bf16(v[j][0], v[j][1]); w.y = cvt_pk_bf16(v[j][2], v[j][3]); *(u32x2*)(XB + (size_t)t * D + 4 * lane + 256 * j) = w;
#pragma unroll
            for (int k = 0; k < 4; ++k) { const float xv = v[j][k];
#pragma unroll
                for (int q = 0; q < 4; ++q) { const f32x4 w4 = wl[((j * 4 + k) * 4 + q) * 64 + lane]; acc[4 * q] += xv * w4[0]; acc[4 * q + 1] += xv * w4[1]; acc[4 * q + 2] += xv * w4[2]; acc[4 * q + 3] += xv * w4[3]; } } }
        float r8[8], r4[4], r2[2], r1;
        { const bool hi = (lane & 32) != 0;
#pragma unroll
          for (int i = 0; i < 8; ++i) { const float keep = hi ? acc[i + 8] : acc[i], send = hi ? acc[i] : acc[i + 8]; r8[i] = keep + __shfl_xor(send, 32); } }
        { const bool hi = (lane & 16) != 0;
#pragma unroll
          for (int i = 0; i < 4; ++i) { const float keep = hi ? r8[i + 4] : r8[i], send = hi ? r8[i] : r8[i + 4]; r4[i] = keep + __shfl_xor(send, 16); } }
        { const bool hi = (lane & 8) != 0;
#pragma unroll
          for (int i = 0; i < 2; ++i) { const float keep = hi ? r4[i + 2] : r4[i], send = hi ? r4[i] : r4[i + 2]; r2[i] = keep + __shfl_xor(send, 8); } }
        { const bool hi = (lane & 4) != 0; const float keep = hi ? r2[1] : r2[0], send = hi ? r2[0] : r2[1]; r1 = keep + __shfl_xor(send, 4); }
        r1 += __shfl_xor(r1, 2); r1 += __shfl_xor(r1, 1);
        float lg[16]; float mx = -3.0e38f;
#pragma unroll
        for (int e = 0; e < 16; ++e) { lg[e] = __shfl(r1, 4 * e) + br[e]; mx = fmaxf(mx, lg[e]); }
        float p[16];
#pragma unroll
        for (int e = 0; e < 16; ++e) p[e] = __expf(lg[e] - mx);
        int gsel = 0; float gbest = -1.f;
#pragma unroll
        for (int g = 0; g < 4; ++g) { const float p0 = p[4 * g], p1 = p[4 * g + 1], p2 = p[4 * g + 2], p3 = p[4 * g + 3];
            const float sum = (p0 + p1) + (p2 + p3), mn1 = fminf(fminf(p0, p1), fminf(p2, p3));
            const float hi01 = fmaxf(p0, p1), lo01 = fminf(p0, p1), hi23 = fmaxf(p2, p3), lo23 = fminf(p2, p3);
            const float top1 = fmaxf(hi01, hi23), top2 = fmaxf(fminf(hi01, hi23), fmaxf(lo01, lo23));
            (void)sum; (void)mn1;
            const float sc = top1 + top2; if (sc > gbest) { gbest = sc; gsel = g; } }
        float q0, q1, q2, q3;
        q0 = gsel == 0 ? p[0] : gsel == 1 ? p[4] : gsel == 2 ? p[8] : p[12];
        q1 = gsel == 0 ? p[1] : gsel == 1 ? p[5] : gsel == 2 ? p[9] : p[13];
        q2 = gsel == 0 ? p[2] : gsel == 1 ? p[6] : gsel == 2 ? p[10] : p[14];
        q3 = gsel == 0 ? p[3] : gsel == 1 ? p[7] : gsel == 2 ? p[11] : p[15];
        int i1 = 0; float v1 = q0;
        if (q1 > v1) { v1 = q1; i1 = 1; } if (q2 > v1) { v1 = q2; i1 = 2; } if (q3 > v1) { v1 = q3; i1 = 3; }
        int i2 = -1; float v2 = -1.f;
        if (i1 != 0 && q0 > v2) { v2 = q0; i2 = 0; } if (i1 != 1 && q1 > v2) { v2 = q1; i2 = 1; } if (i1 != 2 && q2 > v2) { v2 = q2; i2 = 2; } if (i1 != 3 && q3 > v2) { v2 = q3; i2 = 3; }
        const float inv = 1.0f / (v1 + v2);
        if (lane == 0) { const int e1 = 4 * gsel + i1, e2 = 4 * gsel + i2;
            const unsigned pos1 = __hip_atomic_fetch_add(lcnt + e1, 1u, __ATOMIC_RELAXED, __HIP_MEMORY_SCOPE_WORKGROUP);
            const unsigned pos2 = __hip_atomic_fetch_add(lcnt + e2, 1u, __ATOMIC_RELAXED, __HIP_MEMORY_SCOPE_WORKGROUP);
            TOKE[t] = (unsigned)e1 | ((unsigned)e2 << 8); TOKP[2 * t] = pos1; TOKP[2 * t + 1] = pos2; TOKW[2 * t] = v1 * inv; TOKW[2 * t + 1] = v2 * inv; }
    }
    __syncthreads();
    if (tid < NE) ((unsigned*)(ws + WS_SMALL + SM_WGCNT))[vcu * NE + tid] = lcnt[tid];
}

__device__ __forceinline__ void phase_moe_lists(unsigned char* ws, LAS unsigned char* lds, int tid, int lane, int gw, int NGW, int vcu, int G) {
    unsigned* ctl = (unsigned*)(ws + WS_CTL);
    LAS unsigned* off = (LAS unsigned*)lds;
    { const unsigned* WGCNT = (const unsigned*)(ws + WS_SMALL + SM_WGCNT);
      const int e = tid & 15, p = tid >> 4; unsigned tot = 0, pre = 0;
      for (int v = p; v < G; v += 32) { const unsigned c = WGCNT[v * NE + e]; tot += c; pre += (v < vcu) ? c : 0u; }
      off[128 + p * 16 + e] = tot; off[128 + 512 + p * 16 + e] = pre; }
    __syncthreads();
    if (tid < NE) { unsigned tot = 0, pre = 0; for (int p = 0; p < 32; ++p) { tot += off[128 + p * 16 + tid]; pre += off[128 + 512 + p * 16 + tid]; } off[32 + tid] = tot; off[48 + tid] = pre; }
    __syncthreads();
    if (tid == 0) { unsigned o = 0;
        for (int e = 0; e < NE; ++e) { const unsigned c = off[32 + e]; off[e] = o; off[64 + e] = o + off[48 + e]; o += (c + 255u) & ~255u; }
        off[16] = o; }
    __syncthreads();
    int* ROWINFO = (int*)(ws + WS_SMALL + SM_ROWINFO);
    if (blockIdx.x == 0) {
        if (tid == 0) ctl[CW_NTILES] = off[16] >> 8;
        if (tid < NE) { const unsigned t0 = off[tid] >> 8, t1 = off[tid + 1] >> 8; for (unsigned tt = t0; tt < t1; ++tt) ctl[CW_TILEE + tt] = (unsigned)tid; }
        for (int e = 0; e < NE; ++e) { const unsigned p0 = off[e] + off[32 + e], p1 = off[e + 1]; for (unsigned r = p0 + tid; r < p1; r += 512) ROWINFO[r] = -1; }
    }
    const bf16_t* XB = (const bf16_t*)(ws + WS_XB); bf16_t* XG = (bf16_t*)(ws + WS_XG);
    const unsigned* TOKE = (const unsigned*)(ws + WS_SMALL + SM_TOKE); const unsigned* TOKP = (const unsigned*)(ws + WS_SMALL + SM_TOKP);
    for (int t = gw; t < T; t += NGW) {
        const unsigned ee = TOKE[t]; const unsigned r1 = off[64 + (ee & 255u)] + TOKP[2 * t], r2 = off[64 + ((ee >> 8) & 255u)] + TOKP[2 * t + 1];
        const u32x4 v0 = *(const u32x4*)(XB + (size_t)t * D + 8 * lane), v1 = *(const u32x4*)(XB + (size_t)t * D + 512 + 8 * lane);
        *(u32x4*)(XG + (size_t)r1 * D + 8 * lane) = v0; *(u32x4*)(XG + (size_t)r1 * D + 512 + 8 * lane) = v1;
        *(u32x4*)(XG + (size_t)r2 * D + 8 * lane) = v0; *(u32x4*)(XG + (size_t)r2 * D + 512 + 8 * lane) = v1;
        if (lane == 0) { ROWINFO[r1] = 2 * t; ROWINFO[r2] = 2 * t + 1; }
    }
}

__device__ __forceinline__ void phase_ln2(ArgsP a, int l, unsigned char* ws, float* out, int lane, int gw, int NGW) {
    const float* X1 = (const float*)(ws + WS_X1); const bf16_t* O = (const bf16_t*)(ws + WS_O); bf16_t* XB = (bf16_t*)(ws + WS_XB);
    const float* TOKW = (const float*)(ws + WS_SMALL + SM_TOKW);
    f32x4 gv[4], bv[4];
#pragma unroll
    for (int j = 0; j < 4; ++j) { gv[j] = *(const f32x4*)(a->ln2_g + (size_t)l * D + 4 * lane + 256 * j); bv[j] = *(const f32x4*)(a->ln2_b + (size_t)l * D + 4 * lane + 256 * j); }
    for (int t = gw; t < T; t += NGW) {
        const float w1 = TOKW[2 * t], w2 = TOKW[2 * t + 1];
        f32x4 v[4]; float s = 0.f;
#pragma unroll
        for (int j = 0; j < 4; ++j) { const f32x4 x = *(const f32x4*)(X1 + (size_t)t * D + 4 * lane + 256 * j);
            const u32x2 o1 = *(const u32x2*)(O + (size_t)(2 * t) * D + 4 * lane + 256 * j), o2 = *(const u32x2*)(O + (size_t)(2 * t + 1) * D + 4 * lane + 256 * j);
            f32x4 mo; mo[0] = w1 * bflo(o1.x) + w2 * bflo(o2.x); mo[1] = w1 * bfhi(o1.x) + w2 * bfhi(o2.x); mo[2] = w1 * bflo(o1.y) + w2 * bflo(o2.y); mo[3] = w1 * bfhi(o1.y) + w2 * bfhi(o2.y);
            v[j] = x * DN_ALPHA + mo; s += (v[j][0] + v[j][1]) + (v[j][2] + v[j][3]); }
        const float mean = wave_sum(s) * (1.f / D); float s2 = 0.f;
#pragma unroll
        for (int j = 0; j < 4; ++j) { v[j] = v[j] - mean; s2 += (v[j][0] * v[j][0] + v[j][1] * v[j][1]) + (v[j][2] * v[j][2] + v[j][3] * v[j][3]); }
        const float rstd = 1.f / sqrtf(wave_sum(s2) * (1.f / D) + LN_EPS);
#pragma unroll
        for (int j = 0; j < 4; ++j) { v[j] = v[j] * rstd * gv[j] + bv[j];
            *(f32x4*)(out + (size_t)t * D + 4 * lane + 256 * j) = v[j];
            u32x2 w; w.x = cvt_pk_bf16(v[j][0], v[j][1]); w.y = cvt_pk_bf16(v[j][2], v[j][3]); *(u32x2*)(XB + (size_t)t * D + 4 * lane + 256 * j) = w; }
    }
}

constexpr int STEPS_PER_LAYER = 5 * NCHUNK + 7;
constexpr int N_STEPS = 1 + DEPTH * STEPS_PER_LAYER;

__global__ void __launch_bounds__(512, 2) mk_fwd(Args args_by_value) {
    (void)args_by_value;
    extern __shared__ __attribute__((aligned(16))) unsigned char lds_raw[];
    LAS unsigned char* lds = (LAS unsigned char*)lds_raw;
    volatile LAS unsigned* MISC = (volatile LAS unsigned*)(lds + MISC_OFF);
    const int tid0 = threadIdx.x;
    const int G = gridDim.x; const int bx = blockIdx.x; const int vcu0 = (G % 8 == 0) ? (bx % 8) * (G / 8) + bx / 8 : bx;
    const int NGW = G * 8, nthr = G * 512;
    ArgsP ap0 = (ArgsP)__builtin_amdgcn_kernarg_segment_ptr();
    unsigned char* ws0 = ap0->ws;
    unsigned* ctl = (unsigned*)(ws0 + WS_CTL);
    for (int u = tid0; u < (LDS_BYTES - LDSCTL_OFF) / 4; u += 512) ((LAS unsigned*)(lds + LDSCTL_OFF))[u] = 0u;
    __syncthreads();
    XcdBarrier bar; bar.bar = ctl + CW_BAR; bar.x = 0; bar.st = nullptr;
    if (!MK_PER_STEP_LAUNCH) bar = xcd_barrier_post(ctl + CW_BAR, MISC + 8);
    const int lo = ap0->ph_lo, hi = ap0->ph_hi;
    int step = 0;
#ifndef MK_MASK
#define MK_MASK 0xFFFFFFFFu
#endif
#ifndef MK_REPEAT
#define MK_REPEAT 0u
#endif
#ifndef MK_BAR2
#define MK_BAR2 0
#endif
#define STEP_BEGIN(id) if (((MK_MASK >> (id)) & 1u) && lo <= step && step < hi) { for (int rep = 0; rep < 1 + (int)((MK_REPEAT >> (id)) & 1u); ++rep) { if (rep) __syncthreads(); unsigned char* ws = ws0; asm volatile("" : "+s"(ws)); ArgsP args = ap0; asm volatile("" : "+s"(args)); int tid = tid0; asm volatile("" : "+v"(tid)); int vcu = vcu0; asm volatile("" : "+s"(vcu)); \
    const int lane = tid & 63, wave = __builtin_amdgcn_readfirstlane(tid >> 6), gw = vcu * 8 + wave, gtid = vcu * 512 + tid; LAS float* scr = (LAS float*)(lds + wave * 16384); (void)lane; (void)gw; (void)gtid; (void)scr;
#define STEP_END   } if (step + 1 < hi) { if (MK_PER_STEP_LAUNCH) {} else { xcd_barrier(bar); if (MK_BAR2) xcd_barrier(bar); } } } ++step;

    STEP_BEGIN(0)
        prep_tm_weights(args, 0, ws, scr, gw, NGW, lane);
        cvt_x(args->x, (bf16_t*)(ws + WS_XB), gtid, nthr);
    STEP_END

#pragma unroll 1
    for (int l = 0; l < DEPTH; ++l) {

#pragma unroll 1
        for (int half = 0; half < NCHUNK; ++half) {
            STEP_BEGIN(1)
                pg8::SchedPlain S{TH / 256, DIN / 256, G, bx, (const char*)(ws + WS_XB) + (size_t)half * TH * D * 2, (const char*)(ws + WS_WIN), (size_t)256 * D * 2, (size_t)256 * D * 2, 0};
                pg8::EpiZ E{(bf16_t*)(ws + WS_Z), (bf16_t*)(ws + WS_GG), half * TH};
                pg8::gemm_phase<pg8::EpiZ, pg8::SchedPlain, true>(lds, D, D, D, S, E);
            STEP_END
            STEP_BEGIN(2)
                phase_e1(args, l, half, ws, gtid, nthr);
            STEP_END
            STEP_BEGIN(3)
                pg8::SchedPlain S{TH / 256, NHEAD, G, bx, (const char*)(ws + WS_XC), (const char*)(ws + WS_WG), (size_t)256 * DR * 2, (size_t)256 * 128 * 2, (size_t)128 * 2};
                pg8::EpiRG E{(bf16_t*)(ws + WS_GT), (const bf16_t*)(ws + WS_XC), (const float*)(ws + WS_SMALL + SM_PCONST)};
                pg8::gemm_phase<pg8::EpiRG, pg8::SchedPlain, true>(lds, DR, 128, 128, S, E);
            STEP_END
            STEP_BEGIN(4)
                phase_scan<false>(half, ws, gtid, nthr);
            STEP_END
            STEP_BEGIN(5)
                phase_scan<true>(half, ws, gtid, nthr);
            STEP_END
        }
        STEP_BEGIN(6)
            pg8::SchedPlain S{T / 256, D / 256, G, bx, (const char*)(ws + WS_U), (const char*)(ws + WS_WA), (size_t)256 * UC * 2, (size_t)256 * UC * 2, 0};
            pg8::EpiMix E{(const bf16_t*)(ws + WS_GG), (bf16_t*)(ws + WS_MERGED)};
            pg8::gemm_phase<pg8::EpiMix, pg8::SchedPlain, true, 16>(lds, UC, UC, UC, S, E);
        STEP_END
        STEP_BEGIN(8)
            pg8::SchedPlain S{T / 256, D / 256, G, bx, (const char*)(ws + WS_MERGED), (const char*)(ws + WS_WO), (size_t)256 * D * 2, (size_t)256 * D * 2, 0};
            pg8::EpiY E{(l == 0) ? args->x : (const float*)args->out, (float*)(ws + WS_Y)};
            pg8::gemm_phase<pg8::EpiY, pg8::SchedPlain, true>(lds, D, D, D, S, E);
        STEP_END
        STEP_BEGIN(9)
            prep_expert_weights(args, l, ws, scr, gw, NGW, lane);
            __syncthreads();
            if (rep == 0) phase_ln1_router(args, l, ws, lds, tid, lane, gw, NGW, vcu);
        STEP_END
        STEP_BEGIN(10)
            phase_moe_lists(ws, lds, tid, lane, gw, NGW, vcu, G);
            __syncthreads();
            if (l + 1 < DEPTH) prep_tm_weights(args, l + 1, ws, scr, gw, NGW, lane);
        STEP_END
        STEP_BEGIN(11)
            const int ntiles = (int)__hip_atomic_load(ctl + CW_NTILES, __ATOMIC_RELAXED, __HIP_MEMORY_SCOPE_AGENT);
            pg8::SchedMoe S{ntiles, 4, G, bx, (const char*)(ws + WS_XG), (const char*)(ws + WS_WEX), (size_t)256 * D * 2, (size_t)256 * D * 2, (size_t)1024 * 1024 * 2, ctl + CW_TILEE};
            pg8::EpiH E{(bf16_t*)(ws + WS_H)};
            pg8::gemm_phase<pg8::EpiH, pg8::SchedMoe, true>(lds, D, D, D, S, E);
        STEP_END
        STEP_BEGIN(12)
            const int ntiles = (int)__hip_atomic_load(ctl + CW_NTILES, __ATOMIC_RELAXED, __HIP_MEMORY_SCOPE_AGENT);
            pg8::SchedMoe S{ntiles, 4, G, bx, (const char*)(ws + WS_H), (const char*)(ws + WS_WEX) + (size_t)NE * 1024 * 1024 * 2, (size_t)256 * FF * 2, (size_t)256 * FF * 2, (size_t)1024 * 512 * 2, ctl + CW_TILEE};
            pg8::EpiO E{(bf16_t*)(ws + WS_O), (const int*)(ws + WS_SMALL + SM_ROWINFO)};
            pg8::gemm_phase<pg8::EpiO, pg8::SchedMoe, true>(lds, FF, FF, FF, S, E);
        STEP_END
        STEP_BEGIN(13)
            phase_ln2(args, l, ws, args->out, lane, gw, NGW);
        STEP_END
    }
#undef STEP_BEGIN
#undef STEP_END
}

extern "C" void kernel_launch(void* const* d_in, const int* in_sizes, int n_in, void* d_out, int out_size, void* d_ws, size_t ws_size, hipStream_t stream) {
    static int grid = 0;
    if (grid == 0) {
        if (n_in != 22 || in_sizes[0] != T * D || out_size != T * D || ws_size < WS_NEED) {
            fprintf(stderr, "kernel_launch: unexpected shapes (n_in %d, in0 %d, out %d, ws %zu, need %zu); nothing launched\n", n_in, n_in > 0 ? in_sizes[0] : -1, out_size, ws_size, (size_t)WS_NEED); grid = -1; return; }
        int dev = 0, cus = 0, per_cu = 0;
        if (hipGetDevice(&dev) != hipSuccess || hipDeviceGetAttribute(&cus, hipDeviceAttributeMultiprocessorCount, dev) != hipSuccess) { grid = -1; return; }
        if (hipFuncSetAttribute((const void*)mk_fwd, hipFuncAttributeMaxDynamicSharedMemorySize, LDS_BYTES) != hipSuccess) { fprintf(stderr, "kernel_launch: hipFuncSetAttribute failed\n"); grid = -1; return; }
        if (hipOccupancyMaxActiveBlocksPerMultiprocessor(&per_cu, (const void*)mk_fwd, 512, LDS_BYTES) != hipSuccess || per_cu < 1) { fprintf(stderr, "kernel_launch: occupancy query says %d blocks per CU\n", per_cu); per_cu = 1; }
        (void)hipGetLastError();
        grid = cus;
    }
    if (grid < 0) return;
    (void)hipMemsetAsync((char*)d_ws + WS_CTL, 0, CTL_ZERO_BYTES, stream);
    Args a{};
    const float** p = (const float**)&a;
    for (int i = 0; i < 22; ++i) p[i] = (const float*)d_in[i];
    a.out = (float*)d_out; a.ws = (unsigned char*)d_ws;
#if MK_PER_STEP_LAUNCH
    for (int s = 0; s < N_STEPS; ++s) { a.ph_lo = s; a.ph_hi = s + 1; hipLaunchKernelGGL(mk_fwd, dim3(grid), dim3(512), LDS_BYTES, stream, a); }
#else
    a.ph_lo = 0; a.ph_hi = N_STEPS;
    hipLaunchKernelGGL(mk_fwd, dim3(grid), dim3(512), LDS_BYTES, stream, a);
#endif
}
```

```cpp
#include <hip/hip_runtime.h>
#include <cstdio>
#include <cstdint>

#ifndef MK_PER_STEP_LAUNCH
#define MK_PER_STEP_LAUNCH 0
#endif

#define LAS __attribute__((address_space(3)))
typedef unsigned short bf16_t;
typedef short bf16x8 __attribute__((ext_vector_type(8)));
typedef float f32x4 __attribute__((ext_vector_type(4)));
typedef float f32x2 __attribute__((ext_vector_type(2)));
typedef unsigned u32x4 __attribute__((ext_vector_type(4)));
typedef unsigned u32x2 __attribute__((ext_vector_type(2)));

constexpr int D = 1024, T = 16384, SEQ = 4096, NBATCH = 4, DR = 1280, NHEAD = 10, DIN = 7680, NE = 16, FF = 512, DEPTH = 2;
constexpr int NCHUNK = 2, TH = T / NCHUNK;
constexpr int ZC = 4608;
constexpr int GGC = 2048;
constexpr int SCH = 64, NSCH = SEQ / SCH;
constexpr int MOE_ROWS = 36864, MOE_TILES = MOE_ROWS / 256;
constexpr float LN_EPS = 1e-5f;
constexpr float DN_ALPHA = 1.4142135623730951f;

constexpr size_t MiB = 1u << 20;
constexpr size_t WS_CTL = 0, CTL_ZERO_BYTES = 128 * 1024;
constexpr size_t WS_WIN = 1 * MiB;
constexpr size_t WS_WA = 16 * MiB;
constexpr size_t WS_WO = 21 * MiB;
constexpr size_t WS_WG = 23 * MiB;
constexpr size_t WS_XB = 24 * MiB;
constexpr size_t WS_U = 56 * MiB;
constexpr int UC = 2304;
constexpr size_t WS_GG = 128 * MiB;
constexpr size_t WS_Z = 192 * MiB;
constexpr size_t WS_XC = 280 * MiB;
constexpr size_t WS_GT = 300 * MiB;
constexpr size_t WS_SMALL = 340 * MiB;
constexpr size_t WS_MERGED = 256 * MiB;
constexpr size_t WS_Y = 56 * MiB;
constexpr size_t WS_X1 = 128 * MiB;
constexpr size_t WS_WEX = 192 * MiB;
constexpr size_t WS_XG = 240 * MiB;
constexpr size_t WS_H = 56 * MiB;
constexpr size_t WS_O = 240 * MiB;
constexpr size_t WS_NEED = 344 * MiB + 512 * 1024;
constexpr size_t SM_AEND = 0;
constexpr size_t SM_HEND = SM_AEND + (size_t)NBATCH * NSCH * DR * 4;
constexpr size_t SM_TOKE = SM_HEND + (size_t)NBATCH * NSCH * DR * 4;
constexpr size_t SM_TOKP = SM_TOKE + (size_t)T * 4;
constexpr size_t SM_TOKW = SM_TOKP + (size_t)T * 8;
constexpr size_t SM_ROWINFO = SM_TOKW + (size_t)T * 8;
constexpr size_t SM_WGCNT = SM_ROWINFO + (size_t)MOE_ROWS * 4;
constexpr size_t SM_PCONST = SM_WGCNT + 256 * 16 * 4;
constexpr size_t SM_END = SM_PCONST + 3 * 1280 * 4;
static_assert(WS_SMALL + SM_END <= WS_NEED, "small region");
constexpr int CW_BAR = 4096;
constexpr int CW_CNT = 8192;
constexpr int CW_NTILES = 8256;
constexpr int CW_TILEE = 8320;

constexpr int RING_BYTES = 131072;
constexpr int LDSCTL_OFF = RING_BYTES, MISC_OFF = LDSCTL_OFF + 320;
constexpr int LDS_BYTES = 147456;

__device__ __forceinline__ unsigned cvt_pk_bf16(float lo, float hi) { unsigned r; asm volatile("v_cvt_pk_bf16_f32 %0, %1, %2" : "=v"(r) : "v"(lo), "v"(hi)); return r; }
__device__ __forceinline__ float bflo(unsigned w) { return __uint_as_float(w << 16); }
__device__ __forceinline__ float bfhi(unsigned w) { return __uint_as_float(w & 0xffff0000u); }
__device__ __forceinline__ float bf1(bf16_t b) { return __uint_as_float((unsigned)b << 16); }
__device__ __forceinline__ float fsigmoid(float x) { return __fdividef(1.0f, 1.0f + __expf(-x)); }
__device__ __forceinline__ float gelu_tanh(float y) { const float u = 1.5957691216057308f * (y + 0.044715f * y * y * y); return y * fsigmoid(u); }
__device__ __forceinline__ float wave_sum(float v) {
#pragma unroll
    for (int o = 1; o < 64; o <<= 1) v += __shfl_xor(v, o);
    return v;
}
typedef int v8i __attribute__((ext_vector_type(8)));
typedef int v4i __attribute__((ext_vector_type(4)));
__device__ __forceinline__ unsigned pk4_fp8(float a, float b, float c, float d) {
    a = __builtin_amdgcn_fmed3f(a, -448.f, 448.f); b = __builtin_amdgcn_fmed3f(b, -448.f, 448.f); c = __builtin_amdgcn_fmed3f(c, -448.f, 448.f); d = __builtin_amdgcn_fmed3f(d, -448.f, 448.f);
    int w = __builtin_amdgcn_cvt_pk_fp8_f32(a, b, 0, false); w = __builtin_amdgcn_cvt_pk_fp8_f32(c, d, w, true); return (unsigned)w; }
#define LDS_WAIT() asm volatile("s_waitcnt lgkmcnt(0)" ::: "memory")
#define VM_WAIT() asm volatile("s_waitcnt vmcnt(0)" ::: "memory")

namespace pg8 {
constexpr int BM = 256, BK = 64, HALF = 128, HTB = HALF * BK * 2, STAGE_BYTES = 8 * HTB, NXCD = 8, WGM = 8;
__host__ __device__ __forceinline__ int lds_byte(int r, int c) { const int st = (r >> 4) * 2 + (c >> 5), rr = r & 15, cc = c & 31, ob = rr * 64 + cc * 2; return st * 1024 + (ob ^ (((ob >> 9) & 1) << 5)); }
__host__ __device__ __forceinline__ void stage_rc(int b, int& R, int& C) { const int st = b / 1024, sb = b % 1024, swz = sb ^ (((sb >> 9) & 1) << 5); R = (st >> 1) * 16 + swz / 64; C = (st & 1) * 32 + (swz % 64) / 2; }
__host__ __device__ __forceinline__ int perm32(int rho) { const int n = rho >> 4, i = rho & 15; return 8 * (i >> 2) + 4 * n + (i & 3); }

struct Unit { const char* a; const char* b; int pm, pn; };

__device__ __forceinline__ bool static_order(int i, int G, int c, int nM, int nN, int& pm, int& pn) {
    const int nwg = nM * nN; const long L = (long)i * G + c; if (L >= nwg) return false;
    int wgid = (int)L; { const int q = nwg / NXCD, r = nwg % NXCD, xcd = wgid % NXCD, off = wgid / NXCD; wgid = (xcd < r ? xcd * (q + 1) : r * (q + 1) + (xcd - r) * q) + off; }
    const int nig = WGM * nN, gid = wgid / nig, fm = gid * WGM, gsz = (nM - fm) < WGM ? (nM - fm) : WGM;
    pm = fm + ((wgid % nig) % gsz); pn = (wgid % nig) / gsz; return true;
}
struct SchedPlain {
    int nM, nN, G, c; const char* A; const char* B; size_t a_tile, b_tile, a_pn;
    __device__ __forceinline__ bool next(int i, Unit& u) const {
        int pm, pn; if (!static_order(i, G, c, nM, nN, pm, pn)) return false;
        u.pm = pm; u.pn = pn; u.a = A + (size_t)pm * a_tile + (size_t)pn * a_pn; u.b = B + (size_t)pn * b_tile; return true;
    }
};
struct SchedMoe {
    int nM, nN, G, c; const char* A; const char* B; size_t a_tile, b_tile, b_exp; const unsigned* tile_e;
    __device__ __forceinline__ bool next(int i, Unit& u) const {
        int pm, pn; if (!static_order(i, G, c, nM, nN, pm, pn)) return false;
        const int e = __builtin_amdgcn_readfirstlane((int)__hip_atomic_load(tile_e + pm, __ATOMIC_RELAXED, __HIP_MEMORY_SCOPE_AGENT));
        u.pm = pm; u.pn = pn; u.a = A + (size_t)pm * a_tile; u.b = B + (size_t)e * b_exp + (size_t)pn * b_tile; return true;
    }
};

template <class Epi, class Sched, bool ALIGN_EPI, int HOOK_T = -1, bool FP8 = false>
__device__ __forceinline__ void gemm_phase(LAS unsigned char* lds, const int lda, const int ldb, const int K, const Sched& S, const Epi& E, const int scale = 0x7f7f7f7f) {
    int tid = threadIdx.x; asm volatile("" : "+v"(tid));
    const int wid = __builtin_amdgcn_readfirstlane(tid >> 6), lane = tid & 63, wr = wid >> 2, wc = wid & 3, fr = lane & 15, fq = lane >> 4;
    int Kop = K; asm volatile("" : "+s"(Kop));
    const int nt = Kop / 128;
    unsigned voffA[2], voffB[2];
#pragma unroll
    for (int i = 0; i < 2; ++i) { int R, C; stage_rc(tid * 16 + i * 8192, R, C); const int Rb = Epi::PERM ? ((R & ~31) + perm32(R & 31)) : R;
        voffA[i] = (unsigned)(R * lda + 2 * C); voffB[i] = (unsigned)(Rb * ldb + 2 * C); }
    const size_t kstep = (size_t)(BK * 2);
    const size_t hstepA = (size_t)HALF * lda, hstepB = (size_t)HALF * ldb;
    const unsigned ldsw = (unsigned)wid * 1024u;
    const int aoff = FP8 ? lds_byte(wr * 64 + fr, fq * 16) : lds_byte(wr * 64 + fr, fq * 8), boff = FP8 ? lds_byte(wc * 32 + fr, fq * 16) : lds_byte(wc * 32 + fr, fq * 8);
    const int f0 = FP8 ? ((fq >> 1) & 1) * 16 : 0, f1 = 16 - f0;
    const LAS unsigned char* pa0 = lds + aoff + f0; const LAS unsigned char* pa1 = lds + aoff + f1; const LAS unsigned char* pb0 = lds + 4 * HTB + boff + f0; const LAS unsigned char* pb1 = lds + 4 * HTB + boff + f1;
    (void)pa1; (void)pb1;
#define PG8_SA(b, h) (((b) * 2 + (h)) * HTB)
#define PG8_SB(b, h) ((4 + (b) * 2 + (h)) * HTB)
#define PG8_STAGE(bufoff, gbase, voff) do { _Pragma("unroll") for (int _i = 0; _i < 2; ++_i) \
        __builtin_amdgcn_global_load_lds((const unsigned*)((const char*)(gbase) + (voff)[_i]), (LAS unsigned*)(lds + (bufoff) + ldsw + _i * 8192), 16, 0, 0); } while (0)
#define PG8_LD8(dst, i_, p0_, p1_, off_) do { const v4i lo_ = *(const LAS v4i*)((p0_) + (off_)), hi_ = *(const LAS v4i*)((p1_) + (off_)); dst[i_] = __builtin_shufflevector(lo_, hi_, 0, 1, 2, 3, 4, 5, 6, 7); } while (0)
#define PG8_LDA(dst, b, h) do { if constexpr (FP8) { _Pragma("unroll") for (int m = 0; m < 4; ++m) PG8_LD8(dst##8, m, pa0, pa1, PG8_SA(b, h) + m * 2048); } \
        else { _Pragma("unroll") for (int m = 0; m < 4; ++m) _Pragma("unroll") for (int k = 0; k < 2; ++k) dst[m][k] = *(const LAS bf16x8*)(pa0 + PG8_SA(b, h) + m * 2048 + k * 1024); } } while (0)
#define PG8_LDB(dst, b, h) do { if constexpr (FP8) { _Pragma("unroll") for (int n = 0; n < 2; ++n) PG8_LD8(dst##8, n, pb0, pb1, PG8_SA(b, h) + n * 2048); } \
        else { _Pragma("unroll") for (int n = 0; n < 2; ++n) _Pragma("unroll") for (int k = 0; k < 2; ++k) dst[n][k] = *(const LAS bf16x8*)(pb0 + PG8_SA(b, h) + n * 2048 + k * 1024); } } while (0)
#define PG8_MMA(ai, bj, At, Bt) do { __builtin_amdgcn_s_setprio(1); _Pragma("unroll") for (int m = 0; m < 4; ++m) _Pragma("unroll") for (int n = 0; n < 2; ++n) { \
        if constexpr (FP8) asm volatile("v_mfma_scale_f32_16x16x128_f8f6f4 %0, %1, %2, %0, %3, %4 op_sel_hi:[0,0,0]" : "+v"(acc[ai][bj][m][n]) : "v"(Bt##8[n]), "v"(At##8[m]), "v"(scale_v), "v"(one_v)); \
        else { _Pragma("unroll") for (int k = 0; k < 2; ++k) acc[ai][bj][m][n] = __builtin_amdgcn_mfma_f32_16x16x32_bf16(Bt[n][k], At[m][k], acc[ai][bj][m][n], 0, 0, 0); } } \
        __builtin_amdgcn_s_setprio(0); } while (0)
#define PG8_WAIT_V(n) asm volatile("s_waitcnt vmcnt(" #n ")" ::: "memory")
#define PG8_WAIT_L(n) asm volatile("s_waitcnt lgkmcnt(" #n ")" ::: "memory")
#define PG8_BAR __builtin_amdgcn_s_barrier()
#define PG8_SCHED __builtin_amdgcn_sched_barrier(0)
    int scale_v = scale, one_v = 0x7f7f7f7f; asm volatile("" : "+v"(scale_v), "+v"(one_v));
    (void)scale_v; (void)one_v;
    Unit cur, nxt; int ui = 0;
    if (!S.next(0, cur)) return;
    f32x4 acc[2][2][4][2];
#pragma unroll
    for (int a = 0; a < 2; ++a)
#pragma unroll
        for (int b = 0; b < 2; ++b)
#pragma unroll
            for (int m = 0; m < 4; ++m)
#pragma unroll
                for (int n = 0; n < 2; ++n) acc[a][b][m][n] = (f32x4){0.f, 0.f, 0.f, 0.f};
    bf16x8 At[4][2], B0[2][2], B1[2][2];
    v8i At8[4], B08[2], B18[2];
    const char* cA = cur.a; const char* cB = cur.b;
    PG8_STAGE(PG8_SB(0, 0), cB, voffB); PG8_STAGE(PG8_SB(0, 1), cB + hstepB, voffB); PG8_STAGE(PG8_SA(0, 0), cA, voffA); PG8_STAGE(PG8_SA(0, 1), cA + hstepA, voffA);
    if (wr == 1) PG8_BAR;
    PG8_WAIT_V(2); PG8_BAR;
    PG8_STAGE(PG8_SB(1, 0), cB + kstep, voffB); PG8_STAGE(PG8_SA(1, 0), cA + kstep, voffA); PG8_STAGE(PG8_SB(1, 1), cB + hstepB + kstep, voffB);
    PG8_WAIT_V(6); PG8_BAR;
    for (;;) {
        const bool has_next = S.next(ui + 1, nxt);
        const char* nA = has_next ? nxt.a : cA; const char* nB = has_next ? nxt.b : cB;
        for (int t = 0; t < nt; t += 2) {
            const bool last = (t == nt - 2);
            if constexpr (HOOK_T >= 0) { if (t == HOOK_T) { if constexpr (FP8) asm volatile("s_nop 15\n\ts_nop 15" ::: "memory"); int fr2 = fr, fq2 = fq; asm volatile("" : "+v"(fr2), "+v"(fq2)); E.hook(acc, cur, wr, wc, fr2, fq2); } }
            const char* a1 = cA + (size_t)(t + 1) * kstep;
            const char* a2 = last ? nA : cA + (size_t)(t + 2) * kstep; const char* b2 = last ? nB : cB + (size_t)(t + 2) * kstep;
            const char* a3 = a2 + kstep; const char* b3 = b2 + kstep;
            PG8_LDB(B0, 0, 0); PG8_LDB(B1, 0, 1); PG8_SCHED; PG8_LDA(At, 0, 0); PG8_STAGE(PG8_SA(1, 1), a1 + hstepA, voffA);
            PG8_WAIT_V(8); PG8_WAIT_L(0); PG8_BAR; PG8_MMA(0, 0, At, B0); PG8_MMA(0, 1, At, B1); PG8_BAR; PG8_SCHED;
            PG8_LDA(At, 0, 1); PG8_STAGE(PG8_SB(0, 0), b2, voffB); PG8_STAGE(PG8_SB(0, 1), b2 + hstepB, voffB); PG8_STAGE(PG8_SA(0, 0), a2, voffA);
            PG8_WAIT_V(8); PG8_WAIT_L(0); PG8_BAR; PG8_MMA(1, 0, At, B0); PG8_MMA(1, 1, At, B1); PG8_BAR; PG8_SCHED;
            PG8_LDB(B0, 1, 0); PG8_LDB(B1, 1, 1); PG8_SCHED; PG8_LDA(At, 1, 0); PG8_STAGE(PG8_SA(0, 1), a2 + hstepA, voffA);
            PG8_WAIT_V(8); PG8_WAIT_L(0); PG8_BAR; PG8_MMA(0, 0, At, B0); PG8_MMA(0, 1, At, B1); PG8_BAR; PG8_SCHED;
            PG8_LDA(At, 1, 1); PG8_STAGE(PG8_SB(1, 0), b3, voffB); PG8_STAGE(PG8_SB(1, 1), b3 + hstepB, voffB); PG8_STAGE(PG8_SA(1, 0), a3, voffA);
            PG8_WAIT_V(8); PG8_WAIT_L(0); PG8_BAR; PG8_MMA(1, 0, At, B0); PG8_MMA(1, 1, At, B1); PG8_BAR; PG8_SCHED;
        }
        if constexpr (ALIGN_EPI) { if (wr == 0) PG8_BAR; }
        if constexpr (FP8) asm volatile("s_nop 15\n\ts_nop 15" ::: "memory");
        { int fr2 = fr, fq2 = fq; asm volatile("" : "+v"(fr2), "+v"(fq2));
          E(acc, cur, wr, wc, fr2, fq2); }
        if (!has_next) break;
#pragma unroll
        for (int a = 0; a < 2; ++a)
#pragma unroll
            for (int b = 0; b < 2; ++b)
#pragma unroll
                for (int m = 0; m < 4; ++m)
#pragma unroll
                    for (int n = 0; n < 2; ++n) acc[a][b][m][n] = (f32x4){0.f, 0.f, 0.f, 0.f};
        cur = nxt; cA = nA; cB = nB; ++ui;
        if constexpr (ALIGN_EPI) { if (wr == 1) PG8_BAR; }
    }
    PG8_WAIT_V(0);
    if constexpr (!ALIGN_EPI) { if (wr == 0) PG8_BAR; }
    PG8_BAR;
#undef PG8_SA
#undef PG8_SB
#undef PG8_STAGE
#undef PG8_LDA
#undef PG8_LDB
#undef PG8_MMA
#undef PG8_LD8
#undef PG8_WAIT_V
#undef PG8_WAIT_L
#undef PG8_BAR
#undef PG8_SCHED
}

typedef const f32x4 (&AccRef)[2][2][4][2];
typedef f32x4 (&AccMut)[2][2][4][2];
#define EPI_LOOP_ROWS for (int ai = 0; ai < 2; ++ai) _Pragma("unroll") for (int m = 0; m < 4; ++m)

struct EpiZ {
    static constexpr bool PERM = true;
    bf16_t* Z; bf16_t* GG; int row_base;
    __device__ __forceinline__ void operator()(AccRef acc, const Unit& u, int wr, int wc, int fr, int fq) const {
        const int row0 = u.pm * BM + wr * 64 + fr;
        if (u.pn < 8) {
            bf16_t* base = Z + u.pn * HALF + wc * 32 + 8 * fq;
#pragma unroll
            EPI_LOOP_ROWS { const f32x4 h0 = acc[ai][0][m][0], h1 = acc[ai][0][m][1], c0 = acc[ai][1][m][0], c1 = acc[ai][1][m][1];
                u32x4 w; w.x = cvt_pk_bf16(h0[0] * c0[0], h0[1] * c0[1]); w.y = cvt_pk_bf16(h0[2] * c0[2], h0[3] * c0[3]); w.z = cvt_pk_bf16(h1[0] * c1[0], h1[1] * c1[1]); w.w = cvt_pk_bf16(h1[2] * c1[2], h1[3] * c1[3]);
                *(u32x4*)(base + (size_t)(row0 + ai * HALF + m * 16) * ZC) = w; }
        } else {
            const int colt = u.pn * BM + wc * 32 + 8 * fq; const int act = u.pn < 17 ? 0 : (u.pn < 22 ? 1 : 2);
            bf16_t* base; size_t ldc;
            if (u.pn < 22) { base = Z + (colt - 1024); ldc = ZC; } else { base = GG + (size_t)row_base * GGC + (colt - 5632); ldc = GGC; }
#pragma unroll
            EPI_LOOP_ROWS { bf16_t* rowp = base + (size_t)(row0 + ai * HALF + m * 16) * ldc;
#pragma unroll
                for (int bj = 0; bj < 2; ++bj) { f32x4 v0 = acc[ai][bj][m][0], v1 = acc[ai][bj][m][1];
                    if (act == 1) {
#pragma unroll
                        for (int j = 0; j < 4; ++j) { v0[j] = gelu_tanh(v0[j]); v1[j] = gelu_tanh(v1[j]); } }
                    else if (act == 2) {
#pragma unroll
                        for (int j = 0; j < 4; ++j) { v0[j] = fsigmoid(v0[j]); v1[j] = fsigmoid(v1[j]); } }
                    u32x4 w; w.x = cvt_pk_bf16(v0[0], v0[1]); w.y = cvt_pk_bf16(v0[2], v0[3]); w.z = cvt_pk_bf16(v1[0], v1[1]); w.w = cvt_pk_bf16(v1[2], v1[3]);
                    *(u32x4*)(rowp + bj * HALF) = w; } }
        }
    }
};
struct EpiBf16 {
    static constexpr bool PERM = true;
    bf16_t* O; int ldc;
    __device__ __forceinline__ void operator()(AccRef acc, const Unit& u, int wr, int wc, int fr, int fq) const {
        const int row0 = u.pm * BM + wr * 64 + fr; const int colt = u.pn * BM + wc * 32 + 8 * fq;
#pragma unroll
        EPI_LOOP_ROWS { bf16_t* rowp = O + (size_t)(row0 + ai * HALF + m * 16) * ldc + colt;
#pragma unroll
            for (int bj = 0; bj < 2; ++bj) { const f32x4 v0 = acc[ai][bj][m][0], v1 = acc[ai][bj][m][1];
                u32x4 w; w.x = cvt_pk_bf16(v0[0], v0[1]); w.y = cvt_pk_bf16(v0[2], v0[3]); w.z = cvt_pk_bf16(v1[0], v1[1]); w.w = cvt_pk_bf16(v1[2], v1[3]);
                *(u32x4*)(rowp + bj * HALF) = w; } }
    }
};
struct EpiRG {
    static constexpr bool PERM = true;
    bf16_t* GT; const bf16_t* XC; const float* PC;
    __device__ __forceinline__ void operator()(AccRef acc, const Unit& u, int wr, int wc, int fr, int fq) const {
        const int row0 = u.pm * BM + wr * 64 + fr; const int cc = wc * 32 + 8 * fq, ch = u.pn * HALF + cc;
        float c8[8], ba[8], bx[8];
        { const f32x4 a0 = *(const f32x4*)(PC + ch), a1 = *(const f32x4*)(PC + ch + 4), b0 = *(const f32x4*)(PC + DR + ch), b1 = *(const f32x4*)(PC + DR + ch + 4), x0 = *(const f32x4*)(PC + 2 * DR + ch), x1 = *(const f32x4*)(PC + 2 * DR + ch + 4);
#pragma unroll
          for (int j = 0; j < 4; ++j) { c8[j] = a0[j]; c8[4 + j] = a1[j]; ba[j] = b0[j]; ba[4 + j] = b1[j]; bx[j] = x0[j]; bx[4 + j] = x1[j]; } }
#pragma unroll
        EPI_LOOP_ROWS { const size_t r = (size_t)(row0 + ai * HALF + m * 16);
            const u32x4 xw = *(const u32x4*)(XC + r * DR + ch);
            float xc[8]; xc[0] = bflo(xw.x); xc[1] = bfhi(xw.x); xc[2] = bflo(xw.y); xc[3] = bfhi(xw.y); xc[4] = bflo(xw.z); xc[5] = bfhi(xw.z); xc[6] = bflo(xw.w); xc[7] = bfhi(xw.w);
            float la[8], bb[8];
#pragma unroll
            for (int n = 0; n < 2; ++n)
#pragma unroll
                for (int j = 0; j < 4; ++j) { const int k = 4 * n + j; const float rp = acc[ai][0][m][n][j], ip = acc[ai][1][m][n][j];
                    const float l = -c8[k] * fsigmoid(rp + ba[k]); const float x = 2.0f * l;
                    float em = -x * (1.0f + x * (0.5f + x * (0.16666667f + x * (0.041666668f + x * (0.0083333338f + x * 0.0013888889f)))));
                    if (x < -0.4f) em = 1.0f - __expf(x);
                    la[k] = l; bb[k] = sqrtf(em) * fsigmoid(ip + bx[k]) * xc[k]; }
            u32x4 w0, w1; w0.x = cvt_pk_bf16(la[0], la[1]); w0.y = cvt_pk_bf16(la[2], la[3]); w0.z = cvt_pk_bf16(la[4], la[5]); w0.w = cvt_pk_bf16(la[6], la[7]);
            w1.x = cvt_pk_bf16(bb[0], bb[1]); w1.y = cvt_pk_bf16(bb[2], bb[3]); w1.z = cvt_pk_bf16(bb[4], bb[5]); w1.w = cvt_pk_bf16(bb[6], bb[7]);
            *(u32x4*)(GT + r * 2560 + u.pn * BM + cc) = w0; *(u32x4*)(GT + r * 2560 + u.pn * BM + HALF + cc) = w1;
            if (m & 1) asm volatile("" ::: "memory"); }
    }
};
struct EpiMix {
    static constexpr bool PERM = true;
    const bf16_t* GG; unsigned char* MG;
    __device__ __forceinline__ void hook(AccMut acc, const Unit& u, int wr, int wc, int fr, int fq) const {
        const int row0 = u.pm * BM + wr * 64 + fr;
        const int colt = u.pn * BM + wc * 32 + 8 * fq;
#pragma unroll
        EPI_LOOP_ROWS { const size_t r = (size_t)(row0 + ai * HALF + m * 16);
#pragma unroll
            for (int bj = 0; bj < 2; ++bj) { const int c = colt + bj * HALF; const u32x4 ga = *(const u32x4*)(GG + r * GGC + c), gr = *(const u32x4*)(GG + r * GGC + D + c);
                f32x4 q0, q1;
                q0[0] = __fdividef(bflo(ga.x), bflo(gr.x)); q0[1] = __fdividef(bfhi(ga.x), bfhi(gr.x)); q0[2] = __fdividef(bflo(ga.y), bflo(gr.y)); q0[3] = __fdividef(bfhi(ga.y), bfhi(gr.y));
                q1[0] = __fdividef(bflo(ga.z), bflo(gr.z)); q1[1] = __fdividef(bfhi(ga.z), bfhi(gr.z)); q1[2] = __fdividef(bflo(ga.w), bflo(gr.w)); q1[3] = __fdividef(bfhi(ga.w), bfhi(gr.w));
                acc[ai][bj][m][0] *= q0; acc[ai][bj][m][1] *= q1; }
            asm volatile("" ::: "memory"); }
    }
    __device__ __forceinline__ void operator()(AccRef acc, const Unit& u, int wr, int wc, int fr, int fq) const {
        const int row0 = u.pm * BM + wr * 64 + fr; const int colt = u.pn * BM + wc * 32 + 8 * fq;
#pragma unroll
        EPI_LOOP_ROWS { const size_t r = (size_t)(row0 + ai * HALF + m * 16);
#pragma unroll
            for (int bj = 0; bj < 2; ++bj) { const int c = colt + bj * HALF; const u32x4 g = *(const u32x4*)(GG + r * GGC + D + c);
                const f32x4 v0 = acc[ai][bj][m][0], v1 = acc[ai][bj][m][1];
                u32x2 w; w.x = pk4_fp8(4.f * bflo(g.x) * v0[0], 4.f * bfhi(g.x) * v0[1], 4.f * bflo(g.y) * v0[2], 4.f * bfhi(g.y) * v0[3]);
                w.y = pk4_fp8(4.f * bflo(g.z) * v1[0], 4.f * bfhi(g.z) * v1[1], 4.f * bflo(g.w) * v1[2], 4.f * bfhi(g.w) * v1[3]);
                *(u32x2*)(MG + r * D + c) = w; }
            asm volatile("" ::: "memory"); }
    }
};
struct EpiY {
    static constexpr bool PERM = false;
    const float* X0; float* Y;
    __device__ __forceinline__ void operator()(AccRef acc, const Unit& u, int wr, int wc, int fr, int fq) const {
        const int row0 = u.pm * BM + wr * 64 + fr, col0 = u.pn * BM + wc * 32 + 4 * fq;
#pragma unroll
        EPI_LOOP_ROWS { const size_t r = (size_t)(row0 + ai * HALF + m * 16);
#pragma unroll
            for (int bj = 0; bj < 2; ++bj)
#pragma unroll
                for (int n = 0; n < 2; ++n) { const int c = col0 + bj * HALF + n * 16; const f32x4 x = *(const f32x4*)(X0 + r * D + c);
                    *(f32x4*)(Y + r * D + c) = x * DN_ALPHA + acc[ai][bj][m][n]; }
            asm volatile("" ::: "memory"); }
    }
};
struct EpiH {
    static constexpr bool PERM = true;
    bf16_t* H;
    __device__ __forceinline__ void operator()(AccRef acc, const Unit& u, int wr, int wc, int fr, int fq) const {
        const int row0 = u.pm * BM + wr * 64 + fr; const int col = u.pn * HALF + wc * 32 + 8 * fq;
#pragma unroll
        EPI_LOOP_ROWS { const size_t r = (size_t)(row0 + ai * HALF + m * 16);
            const f32x4 g0 = acc[ai][0][m][0], g1 = acc[ai][0][m][1], u0 = acc[ai][1][m][0], u1 = acc[ai][1][m][1];
            u32x4 w;
            w.x = cvt_pk_bf16(g0[0] * fsigmoid(g0[0]) * u0[0], g0[1] * fsigmoid(g0[1]) * u0[1]);
            w.y = cvt_pk_bf16(g0[2] * fsigmoid(g0[2]) * u0[2], g0[3] * fsigmoid(g0[3]) * u0[3]);
            w.z = cvt_pk_bf16(g1[0] * fsigmoid(g1[0]) * u1[0], g1[1] * fsigmoid(g1[1]) * u1[1]);
            w.w = cvt_pk_bf16(g1[2] * fsigmoid(g1[2]) * u1[2], g1[3] * fsigmoid(g1[3]) * u1[3]);
            *(u32x4*)(H + r * FF + col) = w; }
    }
};
struct EpiO {
    static constexpr bool PERM = true;
    bf16_t* O; const int* rowinfo;
    __device__ __forceinline__ void operator()(AccRef acc, const Unit& u, int wr, int wc, int fr, int fq) const {
        const int row0 = u.pm * BM + wr * 64 + fr; const int colt = u.pn * BM + wc * 32 + 8 * fq;
#pragma unroll
        EPI_LOOP_ROWS { const int dst = rowinfo[row0 + ai * HALF + m * 16];
            if (dst >= 0) { bf16_t* rowp = O + (size_t)dst * D + colt;
#pragma unroll
                for (int bj = 0; bj < 2; ++bj) { const f32x4 v0 = acc[ai][bj][m][0], v1 = acc[ai][bj][m][1];
                    u32x4 w; w.x = cvt_pk_bf16(v0[0], v0[1]); w.y = cvt_pk_bf16(v0[2], v0[3]); w.z = cvt_pk_bf16(v1[0], v1[1]); w.w = cvt_pk_bf16(v1[2], v1[3]);
                    *(u32x4*)(rowp + bj * HALF) = w; } } }
    }
};
}

#define XB_TMO      128
#define XB_XCNT(j)  (256  + 64 * (j))
#define XB_XSUB(j)  (1280 + 64 * (j))
#define XB_XGEN(j)  (2304 + 64 * (j))
#define XB_TOP      3328
#define XB_TOPGEN   3392
#define XCD_BAR_WORDS 3456
#define XB_SPIN_CAP (1u << 18)
__device__ __forceinline__ unsigned xb_ld(unsigned* p)              { return __hip_atomic_load(p, __ATOMIC_RELAXED, __HIP_MEMORY_SCOPE_AGENT); }
__device__ __forceinline__ unsigned xb_add(unsigned* p, unsigned v) { return __hip_atomic_fetch_add(p, v, __ATOMIC_RELAXED, __HIP_MEMORY_SCOPE_AGENT); }
__device__ __forceinline__ unsigned xb_xcc_id() { return (unsigned)__builtin_amdgcn_s_getreg((3 << 11) | 20) & 0xFu; }
#define XB_SPIN(cond, bar) do { unsigned _sp = 0; while (cond) { __builtin_amdgcn_s_sleep(1); \
    if ((++_sp & 255u) == 0u) { if (xb_ld(&(bar)[XB_TMO])) break; if (_sp > XB_SPIN_CAP) { atomicAdd(&(bar)[XB_TMO], 1u); break; } } } } while (0)
struct XcdBarrier { unsigned* bar; unsigned x; volatile LAS unsigned* st; };
__device__ __forceinline__ XcdBarrier xcd_barrier_post(unsigned* bar, volatile LAS unsigned* st) {
    XcdBarrier b; b.bar = bar; b.x = xb_xcc_id(); b.st = st;
    if (threadIdx.x == 0) (void)xb_add(&bar[XB_XCNT(b.x)], 1u);
    return b;
}
__device__ __forceinline__ void xcd_barrier_complete(unsigned* bar, unsigned x, unsigned& nloc, unsigned& nx) {
    const unsigned G = gridDim.x * gridDim.y * gridDim.z;
    unsigned sum, cnt, mine, sp = 0u;
    for (;;) {
        sum = 0u; cnt = 0u; mine = 0u;
#pragma unroll
        for (unsigned j = 0; j < 16; ++j) { const unsigned c = xb_ld(&bar[XB_XCNT(j)]); sum += c; cnt += (c > 0u) ? 1u : 0u; mine = (j == x) ? c : mine; }
        if (sum == G) break;
        __builtin_amdgcn_s_sleep(1);
        if ((++sp & 255u) == 0u) { if (xb_ld(&bar[XB_TMO])) break; if (sp > XB_SPIN_CAP) { atomicAdd(&bar[XB_TMO], 1u); break; } }
    }
    nloc = mine > 0u ? mine : 1u; nx = cnt > 0u ? cnt : 1u;
}
__device__ __forceinline__ void xcd_barrier(const XcdBarrier& b) {
    asm volatile("s_waitcnt vmcnt(0)" ::: "memory");
    __syncthreads();
    if (threadIdx.x == 0) {
        unsigned* bar = b.bar;
        __builtin_amdgcn_s_waitcnt(0);
        unsigned nloc = b.st[0], nx = b.st[1];
        if (nloc == 0u) { xcd_barrier_complete(bar, b.x, nloc, nx); b.st[0] = nloc; b.st[1] = nx; }
        const unsigned old = xb_add(&bar[XB_XSUB(b.x)], 1u);
        const unsigned gen = old / nloc;
        if (old + 1u == (gen + 1u) * nloc) {
            __builtin_amdgcn_fence(__ATOMIC_RELEASE, "agent");
            asm volatile("s_waitcnt vmcnt(0)" ::: "memory");
            const unsigned og = xb_add(&bar[XB_TOP], 1u);
            const unsigned tg = og / nx;
            if (og + 1u == (tg + 1u) * nx) xb_add(&bar[XB_TOPGEN], 1u);
            else XB_SPIN(xb_ld(&bar[XB_TOPGEN]) == tg, bar);
            __builtin_amdgcn_fence(__ATOMIC_ACQUIRE, "agent");
            xb_add(&bar[XB_XGEN(b.x)], 1u);
            asm volatile("s_waitcnt vmcnt(0)" ::: "memory");
        } else {
            XB_SPIN(xb_ld(&bar[XB_XGEN(b.x)]) == gen, bar);
            __builtin_amdgcn_fence(__ATOMIC_ACQUIRE, "agent");
            asm volatile("s_waitcnt vmcnt(0)" ::: "memory");
        }
    }
    __syncthreads();
}

struct Args {
    const float* x; const float* w_in; const float* conv_a_w; const float* w_branch_a; const float* conv_r_w; const float* conv_r_b;
    const float* w_rg_a; const float* b_rg_a; const float* w_rg_x; const float* b_rg_x; const float* rg_lambda; const float* w_branch_r; const float* w_out;
    const float* ln1_g; const float* ln1_b; const float* w_router; const float* b_router; const float* w_exp_gate; const float* w_exp_up; const float* w_exp_down;
    const float* ln2_g; const float* ln2_b;
    float* out; unsigned char* ws; int ph_lo, ph_hi;
};

typedef const Args __attribute__((address_space(4)))* ArgsP;

__device__ __forceinline__ void transpose_item(const float* W, int N, int k0, int n0, bf16_t* WT, int ldk, int drow0, LAS float* scr, int lane) {
    float tv[32];
    { const float* wp = W + (size_t)(k0 + (lane >> 5)) * N + n0 + (lane & 31);
#pragma unroll
      for (int i = 0; i < 32; ++i) tv[i] = wp[(size_t)(2 * i) * N]; }
#pragma unroll
    for (int i = 0; i < 32; ++i) scr[(2 * i + (lane >> 5)) * 33 + (lane & 31)] = tv[i];
    LDS_WAIT(); asm volatile("" ::: "memory");
    const int c = lane & 7;
#pragma unroll
    for (int j = 0; j < 4; ++j) { const int n = (lane >> 3) + 8 * j; const LAS float* s = scr + (8 * c) * 33 + n;
        u32x4 o; o.x = cvt_pk_bf16(s[0 * 33], s[1 * 33]); o.y = cvt_pk_bf16(s[2 * 33], s[3 * 33]); o.z = cvt_pk_bf16(s[4 * 33], s[5 * 33]); o.w = cvt_pk_bf16(s[6 * 33], s[7 * 33]);
        *(u32x4*)(WT + (size_t)(drow0 + n) * ldk + k0 + 8 * c) = o; }
    LDS_WAIT(); asm volatile("" ::: "memory");
}
__device__ __forceinline__ void transpose_item8(const float* W, int N, int k0, int n0, unsigned char* WT, int ldk, int drow0, float sc, LAS float* scr, int lane) {
    float tv[32];
    { const float* wp = W + (size_t)(k0 + (lane >> 5)) * N + n0 + (lane & 31);
#pragma unroll
      for (int i = 0; i < 32; ++i) tv[i] = wp[(size_t)(2 * i) * N]; }
#pragma unroll
    for (int i = 0; i < 32; ++i) scr[(2 * i + (lane >> 5)) * 33 + (lane & 31)] = tv[i];
    LDS_WAIT(); asm volatile("" ::: "memory");
    const int c = lane & 7;
#pragma unroll
    for (int j = 0; j < 4; ++j) { const int n = (lane >> 3) + 8 * j; const LAS float* s = scr + (8 * c) * 33 + n;
        u32x2 o; o.x = pk4_fp8(sc * s[0 * 33], sc * s[1 * 33], sc * s[2 * 33], sc * s[3 * 33]); o.y = pk4_fp8(sc * s[4 * 33], sc * s[5 * 33], sc * s[6 * 33], sc * s[7 * 33]);
        *(u32x2*)(WT + (size_t)(drow0 + n) * ldk + k0 + 8 * c) = o; }
    LDS_WAIT(); asm volatile("" ::: "memory");
}
__device__ __forceinline__ void transpose_plain(const float* W, int K, int N, bf16_t* WT, int item, LAS float* scr, int lane) {
    const int nblk = N / 32, kb = item / nblk, nb = item % nblk;
    transpose_item(W, N, 64 * kb, 32 * nb, WT, K, 32 * nb, scr, lane);
}

__device__ __forceinline__ void prep_tm_weights(ArgsP a, int l, unsigned char* ws, LAS float* scr, int gw, int NGW, int lane) {
    constexpr int I_IN = (D / 64) * (DIN / 32), I_A = (D / 64) * (D / 32), I_R = (DR / 64) * (D / 32), I_O = I_A, I_G = 2 * NHEAD * 2 * 4;
    constexpr int NITEMS = I_IN + I_A + I_R + I_O + I_G;
    if (gw < 20) { const int c = gw * 64 + lane; float* PC = (float*)(ws + WS_SMALL + SM_PCONST);
        PC[c] = 8.0f * log1pf(__expf(-a->rg_lambda[(size_t)l * DR + c])); PC[DR + c] = a->b_rg_a[(size_t)l * DR + c]; PC[2 * DR + c] = a->b_rg_x[(size_t)l * DR + c]; }
    for (int it = gw; it < NITEMS; it += NGW) {
        int r = it;
        if (r < I_IN) { const int nblk = DIN / 32, kb = r / nblk, n0 = 32 * (r % nblk);
            const int drow0 = n0 < 1024 ? (n0 >> 7) * 256 + (n0 & 127) : (n0 < 2048 ? n0 + 1024 : (n0 < 3072 ? ((n0 - 2048) >> 7) * 256 + 128 + (n0 & 127) : n0));
            transpose_item8(a->w_in + (size_t)l * D * DIN, DIN, 64 * kb, n0, ws + WS_WIN, D, drow0, 32.f, scr, lane); continue; } r -= I_IN;
        if (r < I_A) { const int kb = r / (D / 32), nb = r % (D / 32); transpose_item8(a->w_branch_a + (size_t)l * D * D, D, 64 * kb, 32 * nb, ws + WS_WA, UC, 32 * nb, 64.f, scr, lane); continue; } r -= I_A;
        if (r < I_R) { const int kb = r / (D / 32), nb = r % (D / 32); transpose_item8(a->w_branch_r + (size_t)l * DR * D, D, 64 * kb, 32 * nb, ws + WS_WA + D, UC, 32 * nb, 16.f, scr, lane); continue; } r -= I_R;
        if (r < I_O) { const int kb = r / (D / 32), nb = r % (D / 32); transpose_item8(a->w_out + (size_t)l * D * D, D, 64 * kb, 32 * nb, ws + WS_WO, D, 32 * nb, 64.f, scr, lane); continue; } r -= I_O;
        {
            const int nb = r & 3, kb = (r >> 2) & 1, hw = r >> 3, which = hw & 1, hh = hw >> 1;
            const float* W = (which ? a->w_rg_x : a->w_rg_a) + ((size_t)l * NHEAD + hh) * 128 * 128;
            transpose_item(W, 128, 64 * kb, 32 * nb, (bf16_t*)(ws + WS_WG), 128, hh * 256 + which * 128 + 32 * nb, scr, lane);
        }
    }
}
__device__ __forceinline__ void prep_expert_weights(ArgsP a, int l, unsigned char* ws, LAS float* scr, int gw, int NGW, int lane) {
    constexpr int I_G = (D / 64) * (FF / 32), I_D = (FF / 64) * (D / 32), PER_E = 2 * I_G + I_D;
    bf16_t* WGU = (bf16_t*)(ws + WS_WEX); bf16_t* WDN = WGU + (size_t)NE * 1024 * 1024;
    for (int it = gw; it < NE * PER_E; it += NGW) {
        const int e = it / PER_E; int r = it % PER_E;
        if (r < 2 * I_G) { const int which = r / I_G; r %= I_G; const int nblk = FF / 32, kb = r / nblk, nb = r % nblk, n0 = 32 * nb;
            const float* W = (which ? a->w_exp_up : a->w_exp_gate) + ((size_t)l * NE + e) * D * FF;
            const int drow0 = (n0 >> 7) * 256 + which * 128 + (n0 & 127);
            transpose_item(W, FF, 64 * kb, n0, WGU + (size_t)e * 1024 * 1024, D, drow0, scr, lane);
        } else { r -= 2 * I_G; const float* W = a->w_exp_down + ((size_t)l * NE + e) * FF * D;
            transpose_plain(W, FF, D, WDN + (size_t)e * 1024 * 512, r, scr, lane); }
    }
}
__device__ __forceinline__ void cvt_x(const float* x, unsigned char* xb, int gtid, int nthr) {
    for (size_t i = gtid; i < (size_t)T * D / 8; i += (size_t)4 * nthr) {
        f32x4 a[4], b[4];
#pragma unroll
        for (int k = 0; k < 4; ++k) { a[k] = *(const f32x4*)(x + (i + (size_t)k * nthr) * 8); b[k] = *(const f32x4*)(x + (i + (size_t)k * nthr) * 8 + 4); }
#pragma unroll
        for (int k = 0; k < 4; ++k) { u32x2 w; w.x = pk4_fp8(a[k][0], a[k][1], a[k][2], a[k][3]); w.y = pk4_fp8(b[k][0], b[k][1], b[k][2], b[k][3]); *(u32x2*)(xb + (i + (size_t)k * nthr) * 8) = w; } }
}
__device__ __forceinline__ void unpack8(const u32x4 w, float (&f)[8]) { f[0] = bflo(w.x); f[1] = bfhi(w.x); f[2] = bflo(w.y); f[3] = bfhi(w.y); f[4] = bflo(w.z); f[5] = bfhi(w.z); f[6] = bflo(w.w); f[7] = bfhi(w.w); }
__device__ __forceinline__ u32x4 pack8(const float (&f)[8]) { u32x4 w; w.x = cvt_pk_bf16(f[0], f[1]); w.y = cvt_pk_bf16(f[2], f[3]); w.z = cvt_pk_bf16(f[4], f[5]); w.w = cvt_pk_bf16(f[6], f[7]); return w; }

__device__ __forceinline__ void phase_e1(ArgsP a, int l, int half, unsigned char* ws, int gtid, int nthr) {
    const bf16_t* Z = (const bf16_t*)(ws + WS_Z); unsigned char* UA = ws + WS_U + (size_t)half * TH * UC; bf16_t* XC = (bf16_t*)(ws + WS_XC);
    constexpr int RUN = 8;
    constexpr int NA = (TH / RUN) * (D / 8), NR = (TH / RUN) * (DR / 8);
    for (int it = gtid; it < NA + NR; it += nthr) {
        if (it < NA) {
            const int cg = it % (D / 8), run = it / (D / 8), t0 = run * RUN, c0 = cg * 8;
            const bool first = (t0 & (SEQ - 1)) == 0;
            u32x4 vv[RUN + 2], bw[RUN];
            vv[0] = first ? (u32x4){0u, 0u, 0u, 0u} : *(const u32x4*)(Z + (size_t)(t0 - 2) * ZC + c0);
            vv[1] = first ? (u32x4){0u, 0u, 0u, 0u} : *(const u32x4*)(Z + (size_t)(t0 - 1) * ZC + c0);
#pragma unroll
            for (int i = 0; i < RUN; ++i) { vv[i + 2] = *(const u32x4*)(Z + (size_t)(t0 + i) * ZC + c0); bw[i] = *(const u32x4*)(Z + (size_t)(t0 + i) * ZC + D + c0); }
            float w0[8], w1[8], w2[8];
            { const float* cw = a->conv_a_w + (size_t)l * 3 * D + c0;
#pragma unroll
              for (int j = 0; j < 8; ++j) { w0[j] = cw[j]; w1[j] = cw[D + j]; w2[j] = cw[2 * D + j]; } }
            float vm2[8], vm1[8]; unpack8(vv[0], vm2); unpack8(vv[1], vm1);
#pragma unroll
            for (int i = 0; i < RUN; ++i) { float v[8], bb[8], o[8]; unpack8(vv[i + 2], v); unpack8(bw[i], bb);
#pragma unroll
                for (int j = 0; j < 8; ++j) { o[j] = bb[j] * (w0[j] * vm2[j] + w1[j] * vm1[j] + w2[j] * v[j]); vm2[j] = vm1[j]; vm1[j] = v[j]; }
                u32x2 w8; w8.x = pk4_fp8(o[0], o[1], o[2], o[3]); w8.y = pk4_fp8(o[4], o[5], o[6], o[7]); *(u32x2*)(UA + (size_t)(t0 + i) * UC + c0) = w8; }
        } else {
            const int r = it - NA; const int cg = r % (DR / 8), run = r / (DR / 8), t0 = run * RUN, c0 = cg * 8;
            const bool first = (t0 & (SEQ - 1)) == 0;
            u32x4 xv[RUN + 3];
#pragma unroll
            for (int i = 0; i < 3; ++i) xv[i] = first ? (u32x4){0u, 0u, 0u, 0u} : *(const u32x4*)(Z + (size_t)(t0 - 3 + i) * ZC + 2 * D + c0);
#pragma unroll
            for (int i = 0; i < RUN; ++i) xv[i + 3] = *(const u32x4*)(Z + (size_t)(t0 + i) * ZC + 2 * D + c0);
            float w0[8], w1[8], w2[8], w3[8], bi[8];
            { const float* cw = a->conv_r_w + (size_t)l * 4 * DR + c0; const float* cb = a->conv_r_b + (size_t)l * DR + c0;
#pragma unroll
              for (int j = 0; j < 8; ++j) { w0[j] = cw[j]; w1[j] = cw[DR + j]; w2[j] = cw[2 * DR + j]; w3[j] = cw[3 * DR + j]; bi[j] = cb[j]; } }
            float x3[8], x2[8], x1[8]; unpack8(xv[0], x3); unpack8(xv[1], x2); unpack8(xv[2], x1);
#pragma unroll
            for (int i = 0; i < RUN; ++i) { float x0[8], o[8]; unpack8(xv[i + 3], x0);
#pragma unroll
                for (int j = 0; j < 8; ++j) { o[j] = w0[j] * x3[j] + w1[j] * x2[j] + w2[j] * x1[j] + w3[j] * x0[j] + bi[j]; x3[j] = x2[j]; x2[j] = x1[j]; x1[j] = x0[j]; }
                *(u32x4*)(XC + (size_t)(t0 + i) * DR + c0) = pack8(o); }
        }
    }
}

template <bool FINAL>
__device__ __forceinline__ void phase_scan(int half, unsigned char* ws, int gtid, int nthr) {
    const bf16_t* GT = (const bf16_t*)(ws + WS_GT); const bf16_t* Z = (const bf16_t*)(ws + WS_Z);
    float* AEND = (float*)(ws + WS_SMALL + SM_AEND); float* HEND = (float*)(ws + WS_SMALL + SM_HEND);
    unsigned char* UR = ws + WS_U + (size_t)half * TH * UC + D;
    constexpr int NP = DR / 2, NITEMS = (TH / SEQ) * NSCH * NP, BT = 16;
    for (int it = gtid; it < NITEMS; it += nthr) {
        const int cp = it % NP, j = (it / NP) % NSCH, bl = it / (NP * NSCH), c = 2 * cp, hh = c >> 7, cc = c & 127, b = half * (TH / SEQ) + bl;
        float h0 = 0.f, h1 = 0.f, L0 = 0.f, L1 = 0.f;
        if (FINAL) {
            const size_t sb = (size_t)b * NSCH * DR + c; int jj = 0;
            for (; jj + 8 <= j; jj += 8) { f32x2 ae[8], he[8];
#pragma unroll
                for (int k = 0; k < 8; ++k) { ae[k] = *(const f32x2*)(AEND + sb + (size_t)(jj + k) * DR); he[k] = *(const f32x2*)(HEND + sb + (size_t)(jj + k) * DR); }
#pragma unroll
                for (int k = 0; k < 8; ++k) { h0 = ae[k].x * h0 + he[k].x; h1 = ae[k].y * h1 + he[k].y; } }
            for (; jj < j; ++jj) { const f32x2 ae = *(const f32x2*)(AEND + sb + (size_t)jj * DR), he = *(const f32x2*)(HEND + sb + (size_t)jj * DR); h0 = ae.x * h0 + he.x; h1 = ae.y * h1 + he.y; }
        }
        const size_t row0 = (size_t)bl * SEQ + (size_t)j * SCH;
        const bf16_t* gl = GT + row0 * 2560 + hh * 256 + cc; const bf16_t* zy = Z + row0 * ZC + 2 * D + DR + c; unsigned char* ur = UR + row0 * UC + c;
#pragma unroll 1
        for (int t0 = 0; t0 < SCH; t0 += BT) {
            unsigned lw[BT], bw[BT], yw[BT];
#pragma unroll
            for (int k = 0; k < BT; ++k) { lw[k] = *(const unsigned*)(gl + (size_t)(t0 + k) * 2560); bw[k] = *(const unsigned*)(gl + (size_t)(t0 + k) * 2560 + 128);
                if (FINAL) yw[k] = *(const unsigned*)(zy + (size_t)(t0 + k) * ZC); }
#pragma unroll
            for (int k = 0; k < BT; ++k) { const float l0 = bflo(lw[k]), l1 = bfhi(lw[k]);
                h0 = __expf(l0) * h0 + bflo(bw[k]); h1 = __expf(l1) * h1 + bfhi(bw[k]);
                if (FINAL) *(unsigned short*)(ur + (size_t)(t0 + k) * UC) = (unsigned short)pk4_fp8(4.f * h0 * bflo(yw[k]), 4.f * h1 * bfhi(yw[k]), 0.f, 0.f);
                else { L0 += l0; L1 += l1; } }
        }
        if (!FINAL) { const size_t si = ((size_t)b * NSCH + j) * DR + c; *(f32x2*)(AEND + si) = (f32x2){__expf(L0), __expf(L1)}; *(f32x2*)(HEND + si) = (f32x2){h0, h1}; }
    }
}

__device__ __forceinline__ void phase_ln1_router(ArgsP a, int l, unsigned char* ws, LAS unsigned char* lds, int tid, int lane, int gw, int NGW, int vcu) {
    LAS f32x4* wl = (LAS f32x4*)lds;
    for (int idx = tid; idx < 4096; idx += 512) { const int ln = idx & 63, q = (idx >> 6) & 3, jk = idx >> 8, d = 4 * ln + 256 * (jk >> 2) + (jk & 3);
        wl[idx] = *(const f32x4*)(a->w_router + (size_t)d * NE + 4 * q); }
    LAS unsigned* lcnt = (LAS unsigned*)(lds + 65536);
    if (tid < NE) lcnt[tid] = 0u;
    __syncthreads();
    const float* Y = (const float*)(ws + WS_Y); float* X1 = (float*)(ws + WS_X1); bf16_t* XB = (bf16_t*)(ws + WS_XB);
    unsigned* TOKE = (unsigned*)(ws + WS_SMALL + SM_TOKE); unsigned* TOKP = (unsigned*)(ws + WS_SMALL + SM_TOKP); float* TOKW = (float*)(ws + WS_SMALL + SM_TOKW);
    f32x4 gv[4], bv[4];
#pragma unroll
    for (int j = 0; j < 4; ++j) { gv[j] = *(const f32x4*)(a->ln1_g + (size_t)l * D + 4 * lane + 256 * j); bv[j] = *(const f32x4*)(a->ln1_b + (size_t)l * D + 4 * lane + 256 * j); }
    float br[16];
#pragma unroll
    for (int e = 0; e < 16; ++e) br[e] = a->b_router[e];
    for (int t = gw; t < T; t += NGW) {
        f32x4 v[4]; float s = 0.f;
#pragma unroll
        for (int j = 0; j < 4; ++j) { v[j] = *(const f32x4*)(Y + (size_t)t * D + 4 * lane + 256 * j); s += (v[j][0] + v[j][1]) + (v[j][2] + v[j][3]); }
        const float mean = wave_sum(s) * (1.f / D); float s2 = 0.f;
#pragma unroll
        for (int j = 0; j < 4; ++j) { v[j] = v[j] - mean; s2 += (v[j][0] * v[j][0] + v[j][1] * v[j][1]) + (v[j][2] * v[j][2] + v[j][3] * v[j][3]); }
        const float rstd = 1.f / sqrtf(wave_sum(s2) * (1.f / D) + LN_EPS);
        float acc[16];
#pragma unroll
        for (int e = 0; e < 16; ++e) acc[e] = 0.f;
#pragma unroll
        for (int j = 0; j < 4; ++j) { v[j] = v[j] * rstd * gv[j] + bv[j];
            *(f32x4*)(X1 + (size_t)t * D + 4 * lane + 256 * j) = v[j];
            u32x2 w; w.x = cvt_pk_bf16(v[j][0], v[j][1]); w.y = cvt_pk_bf16(v[j][2], v[j][3]); *(u32x2*)(XB + (size_t)t * D + 4 * lane + 256 * j) = w;
#pragma unroll
            for (int k = 0; k < 4; ++k) { const float xv = v[j][k];
#pragma unroll
                for (int q = 0; q < 4; ++q) { const f32x4 w4 = wl[((j * 4 + k) * 4 + q) * 64 + lane]; acc[4 * q] += xv * w4[0]; acc[4 * q + 1] += xv * w4[1]; acc[4 * q + 2] += xv * w4[2]; acc[4 * q + 3] += xv * w4[3]; } } }
        float r8[8], r4[4], r2[2], r1;
        { const bool hi = (lane & 32) != 0;
#pragma unroll
          for (int i = 0; i < 8; ++i) { const float keep = hi ? acc[i + 8] : acc[i], send = hi ? acc[i] : acc[i + 8]; r8[i] = keep + __shfl_xor(send, 32); } }
        { const bool hi = (lane & 16) != 0;
#pragma unroll
          for (int i = 0; i < 4; ++i) { const float keep = hi ? r8[i + 4] : r8[i], send = hi ? r8[i] : r8[i + 4]; r4[i] = keep + __shfl_xor(send, 16); } }
        { const bool hi = (lane & 8) != 0;
#pragma unroll
          for (int i = 0; i < 2; ++i) { const float keep = hi ? r4[i + 2] : r4[i], send = hi ? r4[i] : r4[i + 2]; r2[i] = keep + __shfl_xor(send, 8); } }
        { const bool hi = (lane & 4) != 0; const float keep = hi ? r2[1] : r2[0], send = hi ? r2[0] : r2[1]; r1 = keep + __shfl_xor(send, 4); }
        r1 += __shfl_xor(r1, 2); r1 += __shfl_xor(r1, 1);
        float lg[16]; float mx = -3.0e38f;
#pragma unroll
        for (int e = 0; e < 16; ++e) { lg[e] = __shfl(r1, 4 * e) + br[e]; mx = fmaxf(mx, lg[e]); }
        float p[16];
#pragma unroll
        for (int e = 0; e < 16; ++e) p[e] = __expf(lg[e] - mx);
        int gsel = 0; float gbest = -1.f;
#pragma unroll
        for (int g = 0; g < 4; ++g) { const float p0 = p[4 * g], p1 = p[4 * g + 1], p2 = p[4 * g + 2], p3 = p[4 * g + 3];
            const float sum = (p0 + p1) + (p2 + p3), mn1 = fminf(fminf(p0, p1), fminf(p2, p3));
            const float hi01 = fmaxf(p0, p1), lo01 = fminf(p0, p1), hi23 = fmaxf(p2, p3), lo23 = fminf(p2, p3);
            const float top1 = fmaxf(hi01, hi23), top2 = fmaxf(fminf(hi01, hi23), fmaxf(lo01, lo23));
            (void)sum; (void)mn1;
            const float sc = top1 + top2; if (sc > gbest) { gbest = sc; gsel = g; } }
        float q0, q1, q2, q3;
        q0 = gsel == 0 ? p[0] : gsel == 1 ? p[4] : gsel == 2 ? p[8] : p[12];
        q1 = gsel == 0 ? p[1] : gsel == 1 ? p[5] : gsel == 2 ? p[9] : p[13];
        q2 = gsel == 0 ? p[2] : gsel == 1 ? p[6] : gsel == 2 ? p[10] : p[14];
        q3 = gsel == 0 ? p[3] : gsel == 1 ? p[7] : gsel == 2 ? p[11] : p[15];
        int i1 = 0; float v1 = q0;
        if (q1 > v1) { v1 = q1; i1 = 1; } if (q2 > v1) { v1 = q2; i1 = 2; } if (q3 > v1) { v1 = q3; i1 = 3; }
        int i2 = -1; float v2 = -1.f;
        if (i1 != 0 && q0 > v2) { v2 = q0; i2 = 0; } if (i1 != 1 && q1 > v2) { v2 = q1; i2 = 1; } if (i1 != 2 && q2 > v2) { v2 = q2; i2 = 2; } if (i1 != 3 && q3 > v2) { v2 = q3; i2 = 3; }
        const float inv = 1.0f / (v1 + v2);
        if (lane == 0) { const int e1 = 4 * gsel + i1, e2 = 4 * gsel + i2;
            const unsigned pos1 = __hip_atomic_fetch_add(lcnt + e1, 1u, __ATOMIC_RELAXED, __HIP_MEMORY_SCOPE_WORKGROUP);
            const unsigned pos2 = __hip_atomic_fetch_add(lcnt + e2, 1u, __ATOMIC_RELAXED, __HIP_MEMORY_SCOPE_WORKGROUP);
            TOKE[t] = (unsigned)e1 | ((unsigned)e2 << 8); TOKP[2 * t] = pos1; TOKP[2 * t + 1] = pos2; TOKW[2 * t] = v1 * inv; TOKW[2 * t + 1] = v2 * inv; }
    }
    __syncthreads();
    if (tid < NE) ((unsigned*)(ws + WS_SMALL + SM_WGCNT))[vcu * NE + tid] = lcnt[tid];
}

__device__ __forceinline__ void phase_moe_lists(unsigned char* ws, LAS unsigned char* lds, int tid, int lane, int gw, int NGW, int vcu, int G) {
    unsigned* ctl = (unsigned*)(ws + WS_CTL);
    LAS unsigned* off = (LAS unsigned*)lds;
    { const unsigned* WGCNT = (const unsigned*)(ws + WS_SMALL + SM_WGCNT);
      const int e = tid & 15, p = tid >> 4; unsigned tot = 0, pre = 0;
      for (int v = p; v < G; v += 32) { const unsigned c = WGCNT[v * NE + e]; tot += c; pre += (v < vcu) ? c : 0u; }
      off[128 + p * 16 + e] = tot; off[128 + 512 + p * 16 + e] = pre; }
    __syncthreads();
    if (tid < NE) { unsigned tot = 0, pre = 0; for (int p = 0; p < 32; ++p) { tot += off[128 + p * 16 + tid]; pre += off[128 + 512 + p * 16 + tid]; } off[32 + tid] = tot; off[48 + tid] = pre; }
    __syncthreads();
    if (tid == 0) { unsigned o = 0;
        for (int e = 0; e < NE; ++e) { const unsigned c = off[32 + e]; off[e] = o; off[64 + e] = o + off[48 + e]; o += (c + 255u) & ~255u; }
        off[16] = o; }
    __syncthreads();
    int* ROWINFO = (int*)(ws + WS_SMALL + SM_ROWINFO);
    if (blockIdx.x == 0) {
        if (tid == 0) ctl[CW_NTILES] = off[16] >> 8;
        if (tid < NE) { const unsigned t0 = off[tid] >> 8, t1 = off[tid + 1] >> 8; for (unsigned tt = t0; tt < t1; ++tt) ctl[CW_TILEE + tt] = (unsigned)tid; }
        for (int e = 0; e < NE; ++e) { const unsigned p0 = off[e] + off[32 + e], p1 = off[e + 1]; for (unsigned r = p0 + tid; r < p1; r += 512) ROWINFO[r] = -1; }
    }
    const bf16_t* XB = (const bf16_t*)(ws + WS_XB); bf16_t* XG = (bf16_t*)(ws + WS_XG);
    const unsigned* TOKE = (const unsigned*)(ws + WS_SMALL + SM_TOKE); const unsigned* TOKP = (const unsigned*)(ws + WS_SMALL + SM_TOKP);
    for (int t = gw; t < T; t += NGW) {
        const unsigned ee = TOKE[t]; const unsigned r1 = off[64 + (ee & 255u)] + TOKP[2 * t], r2 = off[64 + ((ee >> 8) & 255u)] + TOKP[2 * t + 1];
        const u32x4 v0 = *(const u32x4*)(XB + (size_t)t * D + 8 * lane), v1 = *(const u32x4*)(XB + (size_t)t * D + 512 + 8 * lane);
        *(u32x4*)(XG + (size_t)r1 * D + 8 * lane) = v0; *(u32x4*)(XG + (size_t)r1 * D + 512 + 8 * lane) = v1;
        *(u32x4*)(XG + (size_t)r2 * D + 8 * lane) = v0; *(u32x4*)(XG + (size_t)r2 * D + 512 + 8 * lane) = v1;
        if (lane == 0) { ROWINFO[r1] = 2 * t; ROWINFO[r2] = 2 * t + 1; }
    }
}

__device__ __forceinline__ void phase_ln2(ArgsP a, int l, unsigned char* ws, float* out, int lane, int gw, int NGW) {
    const float* X1 = (const float*)(ws + WS_X1); const bf16_t* O = (const bf16_t*)(ws + WS_O); unsigned char* X8 = ws + WS_XB;
    const float* TOKW = (const float*)(ws + WS_SMALL + SM_TOKW);
    f32x4 gv[4], bv[4];
#pragma unroll
    for (int j = 0; j < 4; ++j) { gv[j] = *(const f32x4*)(a->ln2_g + (size_t)l * D + 4 * lane + 256 * j); bv[j] = *(const f32x4*)(a->ln2_b + (size_t)l * D + 4 * lane + 256 * j); }
    for (int t = gw; t < T; t += NGW) {
        const float w1 = TOKW[2 * t], w2 = TOKW[2 * t + 1];
        f32x4 v[4]; float s = 0.f;
#pragma unroll
        for (int j = 0; j < 4; ++j) { const f32x4 x = *(const f32x4*)(X1 + (size_t)t * D + 4 * lane + 256 * j);
            const u32x2 o1 = *(const u32x2*)(O + (size_t)(2 * t) * D + 4 * lane + 256 * j), o2 = *(const u32x2*)(O + (size_t)(2 * t + 1) * D + 4 * lane + 256 * j);
            f32x4 mo; mo[0] = w1 * bflo(o1.x) + w2 * bflo(o2.x); mo[1] = w1 * bfhi(o1.x) + w2 * bfhi(o2.x); mo[2] = w1 * bflo(o1.y) + w2 * bflo(o2.y); mo[3] = w1 * bfhi(o1.y) + w2 * bfhi(o2.y);
            v[j] = x * DN_ALPHA + mo; s += (v[j][0] + v[j][1]) + (v[j][2] + v[j][3]); }
        const float mean = wave_sum(s) * (1.f / D); float s2 = 0.f;
#pragma unroll
        for (int j = 0; j < 4; ++j) { v[j] = v[j] - mean; s2 += (v[j][0] * v[j][0] + v[j][1] * v[j][1]) + (v[j][2] * v[j][2] + v[j][3] * v[j][3]); }
        const float rstd = 1.f / sqrtf(wave_sum(s2) * (1.f / D) + LN_EPS);
#pragma unroll
        for (int j = 0; j < 4; ++j) { v[j] = v[j] * rstd * gv[j] + bv[j];
            *(f32x4*)(out + (size_t)t * D + 4 * lane + 256 * j) = v[j];
            *(unsigned*)(X8 + (size_t)t * D + 4 * lane + 256 * j) = pk4_fp8(v[j][0], v[j][1], v[j][2], v[j][3]); }
    }
}

constexpr int STEPS_PER_LAYER = 5 * NCHUNK + 7;
constexpr int N_STEPS = 1 + DEPTH * STEPS_PER_LAYER;

__global__ void __launch_bounds__(512, 2) mk_fwd(Args args_by_value) {
    (void)args_by_value;
    extern __shared__ __attribute__((aligned(16))) unsigned char lds_raw[];
    LAS unsigned char* lds = (LAS unsigned char*)lds_raw;
    volatile LAS unsigned* MISC = (volatile LAS unsigned*)(lds + MISC_OFF);
    const int tid0 = threadIdx.x;
    const int G = gridDim.x; const int bx = blockIdx.x; const int vcu0 = (G % 8 == 0) ? (bx % 8) * (G / 8) + bx / 8 : bx;
    const int NGW = G * 8, nthr = G * 512;
    ArgsP ap0 = (ArgsP)__builtin_amdgcn_kernarg_segment_ptr();
    unsigned char* ws0 = ap0->ws;
    unsigned* ctl = (unsigned*)(ws0 + WS_CTL);
    for (int u = tid0; u < (LDS_BYTES - LDSCTL_OFF) / 4; u += 512) ((LAS unsigned*)(lds + LDSCTL_OFF))[u] = 0u;
    __syncthreads();
    XcdBarrier bar; bar.bar = ctl + CW_BAR; bar.x = 0; bar.st = nullptr;
    if (!MK_PER_STEP_LAUNCH) bar = xcd_barrier_post(ctl + CW_BAR, MISC + 8);
    const int lo = ap0->ph_lo, hi = ap0->ph_hi;
    int step = 0;
#ifndef MK_MASK
#define MK_MASK 0xFFFFFFFFu
#endif
#ifndef MK_REPEAT
#define MK_REPEAT 0u
#endif
#ifndef MK_BAR2
#define MK_BAR2 0
#endif
#define STEP_BEGIN(id) if (((MK_MASK >> (id)) & 1u) && lo <= step && step < hi) { for (int rep = 0; rep < 1 + (int)((MK_REPEAT >> (id)) & 1u); ++rep) { if (rep) __syncthreads(); unsigned char* ws = ws0; asm volatile("" : "+s"(ws)); ArgsP args = ap0; asm volatile("" : "+s"(args)); int tid = tid0; asm volatile("" : "+v"(tid)); int vcu = vcu0; asm volatile("" : "+s"(vcu)); \
    const int lane = tid & 63, wave = __builtin_amdgcn_readfirstlane(tid >> 6), gw = vcu * 8 + wave, gtid = vcu * 512 + tid; LAS float* scr = (LAS float*)(lds + wave * 16384); (void)lane; (void)gw; (void)gtid; (void)scr;
#define STEP_END   } if (step + 1 < hi) { if (MK_PER_STEP_LAUNCH) {} else { xcd_barrier(bar); if (MK_BAR2) xcd_barrier(bar); } } } ++step;

    STEP_BEGIN(0)
        prep_tm_weights(args, 0, ws, scr, gw, NGW, lane);
        cvt_x(args->x, ws + WS_XB, gtid, nthr);
    STEP_END

#pragma unroll 1
    for (int l = 0; l < DEPTH; ++l) {

#pragma unroll 1
        for (int half = 0; half < NCHUNK; ++half) {
            STEP_BEGIN(1)
                pg8::SchedPlain S{TH / 256, DIN / 256, G, bx, (const char*)(ws + WS_XB) + (size_t)half * TH * D, (const char*)(ws + WS_WIN), (size_t)256 * D, (size_t)256 * D, 0};
                pg8::EpiZ E{(bf16_t*)(ws + WS_Z), (bf16_t*)(ws + WS_GG), half * TH};
                pg8::gemm_phase<pg8::EpiZ, pg8::SchedPlain, true, -1, true>(lds, D, D, D, S, E, 0x7a7a7a7a);
            STEP_END
            STEP_BEGIN(2)
                phase_e1(args, l, half, ws, gtid, nthr);
            STEP_END
            STEP_BEGIN(3)
                pg8::SchedPlain S{TH / 256, NHEAD, G, bx, (const char*)(ws + WS_XC), (const char*)(ws + WS_WG), (size_t)256 * DR * 2, (size_t)256 * 128 * 2, (size_t)128 * 2};
                pg8::EpiRG E{(bf16_t*)(ws + WS_GT), (const bf16_t*)(ws + WS_XC), (const float*)(ws + WS_SMALL + SM_PCONST)};
                pg8::gemm_phase<pg8::EpiRG, pg8::SchedPlain, true>(lds, DR * 2, 128 * 2, 128 * 2, S, E);
            STEP_END
            STEP_BEGIN(4)
                phase_scan<false>(half, ws, gtid, nthr);
            STEP_END
            STEP_BEGIN(5)
                phase_scan<true>(half, ws, gtid, nthr);
            STEP_END
        }
        STEP_BEGIN(6)
            pg8::SchedPlain S{T / 256, D / 256, G, bx, (const char*)(ws + WS_U), (const char*)(ws + WS_WA), (size_t)256 * UC, (size_t)256 * UC, 0};
            pg8::EpiMix E{(const bf16_t*)(ws + WS_GG), (unsigned char*)(ws + WS_MERGED)};
            pg8::gemm_phase<pg8::EpiMix, pg8::SchedPlain, true, 8, true>(lds, UC, UC, UC, S, E, 0x79797979);
        STEP_END
        STEP_BEGIN(8)
            pg8::SchedPlain S{T / 256, D / 256, G, bx, (const char*)(ws + WS_MERGED), (const char*)(ws + WS_WO), (size_t)256 * D, (size_t)256 * D, 0};
            pg8::EpiY E{(l == 0) ? args->x : (const float*)args->out, (float*)(ws + WS_Y)};
            pg8::gemm_phase<pg8::EpiY, pg8::SchedPlain, true, -1, true>(lds, D, D, D, S, E, 0x77777777);
        STEP_END
        STEP_BEGIN(9)
            prep_expert_weights(args, l, ws, scr, gw, NGW, lane);
            __syncthreads();
            if (rep == 0) phase_ln1_router(args, l, ws, lds, tid, lane, gw, NGW, vcu);
        STEP_END
        STEP_BEGIN(10)
            phase_moe_lists(ws, lds, tid, lane, gw, NGW, vcu, G);
            __syncthreads();
            if (l + 1 < DEPTH) prep_tm_weights(args, l + 1, ws, scr, gw, NGW, lane);
        STEP_END
        STEP_BEGIN(11)
            const int ntiles = (int)__hip_atomic_load(ctl + CW_NTILES, __ATOMIC_RELAXED, __HIP_MEMORY_SCOPE_AGENT);
            pg8::SchedMoe S{ntiles, 4, G, bx, (const char*)(ws + WS_XG), (const char*)(ws + WS_WEX), (size_t)256 * D * 2, (size_t)256 * D * 2, (size_t)1024 * 1024 * 2, ctl + CW_TILEE};
            pg8::EpiH E{(bf16_t*)(ws + WS_H)};
            pg8::gemm_phase<pg8::EpiH, pg8::SchedMoe, true>(lds, D * 2, D * 2, D * 2, S, E);
        STEP_END
        STEP_BEGIN(12)
            const int ntiles = (int)__hip_atomic_load(ctl + CW_NTILES, __ATOMIC_RELAXED, __HIP_MEMORY_SCOPE_AGENT);
            pg8::SchedMoe S{ntiles, 4, G, bx, (const char*)(ws + WS_H), (const char*)(ws + WS_WEX) + (size_t)NE * 1024 * 1024 * 2, (size_t)256 * FF * 2, (size_t)256 * FF * 2, (size_t)1024 * 512 * 2, ctl + CW_TILEE};
            pg8::EpiO E{(bf16_t*)(ws + WS_O), (const int*)(ws + WS_SMALL + SM_ROWINFO)};
            pg8::gemm_phase<pg8::EpiO, pg8::SchedMoe, true>(lds, FF * 2, FF * 2, FF * 2, S, E);
        STEP_END
        STEP_BEGIN(13)
            phase_ln2(args, l, ws, args->out, lane, gw, NGW);
        STEP_END
    }
#undef STEP_BEGIN
#undef STEP_END
}

extern "C" void kernel_launch(void* const* d_in, const int* in_sizes, int n_in, void* d_out, int out_size, void* d_ws, size_t ws_size, hipStream_t stream) {
    static int grid = 0;
    if (grid == 0) {
        if (n_in != 22 || in_sizes[0] != T * D || out_size != T * D || ws_size < WS_NEED) {
            fprintf(stderr, "kernel_launch: unexpected shapes (n_in %d, in0 %d, out %d, ws %zu, need %zu); nothing launched\n", n_in, n_in > 0 ? in_sizes[0] : -1, out_size, ws_size, (size_t)WS_NEED); grid = -1; return; }
        int dev = 0, cus = 0, per_cu = 0;
        if (hipGetDevice(&dev) != hipSuccess || hipDeviceGetAttribute(&cus, hipDeviceAttributeMultiprocessorCount, dev) != hipSuccess) { grid = -1; return; }
        if (hipFuncSetAttribute((const void*)mk_fwd, hipFuncAttributeMaxDynamicSharedMemorySize, LDS_BYTES) != hipSuccess) { fprintf(stderr, "kernel_launch: hipFuncSetAttribute failed\n"); grid = -1; return; }
        if (hipOccupancyMaxActiveBlocksPerMultiprocessor(&per_cu, (const void*)mk_fwd, 512, LDS_BYTES) != hipSuccess || per_cu < 1) { fprintf(stderr, "kernel_launch: occupancy query says %d blocks per CU\n", per_cu); per_cu = 1; }
        (void)hipGetLastError();
        grid = cus;
    }
    if (grid < 0) return;
    (void)hipMemsetAsync((char*)d_ws + WS_CTL, 0, CTL_ZERO_BYTES, stream);
    Args a{};
    const float** p = (const float**)&a;
    for (int i = 0; i < 22; ++i) p[i] = (const float*)d_in[i];
    a.out = (float*)d_out; a.ws = (unsigned char*)d_ws;
#if MK_PER_STEP_LAUNCH
    for (int s = 0; s < N_STEPS; ++s) { a.ph_lo = s; a.ph_hi = s + 1; hipLaunchKernelGGL(mk_fwd, dim3(grid), dim3(512), LDS_BYTES, stream, a); }
#else
    a.ph_lo = 0; a.ph_hi = N_STEPS;
    hipLaunchKernelGGL(mk_fwd, dim3(grid), dim3(512), LDS_BYTES, stream, a);
#endif
}
```

```cpp
#include <hip/hip_runtime.h>
#include <cstdio>
#include <cstdint>

#ifndef MK_PER_STEP_LAUNCH
#define MK_PER_STEP_LAUNCH 0
#endif

#define LAS __attribute__((address_space(3)))
typedef unsigned short bf16_t;
typedef short bf16x8 __attribute__((ext_vector_type(8)));
typedef float f32x4 __attribute__((ext_vector_type(4)));
typedef float f32x2 __attribute__((ext_vector_type(2)));
typedef unsigned u32x4 __attribute__((ext_vector_type(4)));
typedef unsigned u32x2 __attribute__((ext_vector_type(2)));

constexpr int D = 1024, T = 16384, SEQ = 4096, NBATCH = 4, DR = 1280, NHEAD = 10, DIN = 7680, NE = 16, FF = 512, DEPTH = 2;
constexpr int NCHUNK = 2, TH = T / NCHUNK;
constexpr int ZC = 4608;
constexpr int GGC = 2048;
constexpr int SCH = 64, NSCH = SEQ / SCH;
constexpr int MOE_ROWS = 36864, MOE_TILES = MOE_ROWS / 256;
constexpr float LN_EPS = 1e-5f;
constexpr float DN_ALPHA = 1.4142135623730951f;

constexpr size_t MiB = 1u << 20;
constexpr size_t WS_CTL = 0, CTL_ZERO_BYTES = 128 * 1024;
constexpr size_t WS_WIN = 1 * MiB;
constexpr size_t WS_WA = 16 * MiB;
constexpr size_t WS_WO = 21 * MiB;
constexpr size_t WS_WG = 23 * MiB;
constexpr size_t WS_XB = 24 * MiB;
constexpr size_t WS_U = 56 * MiB;
constexpr int UC = 2304;
constexpr size_t WS_GG = 128 * MiB;
constexpr size_t WS_Z = 192 * MiB;
constexpr size_t WS_XC = 280 * MiB;
constexpr size_t WS_GT = 300 * MiB;
constexpr size_t WS_SMALL = 340 * MiB;
constexpr size_t WS_MERGED = 256 * MiB;
constexpr size_t WS_Y = 56 * MiB;
constexpr size_t WS_X1 = 128 * MiB;
constexpr size_t WS_WEX = 192 * MiB;
constexpr size_t WS_XG = 240 * MiB;
constexpr size_t WS_H = 56 * MiB;
constexpr size_t WS_O = 240 * MiB;
constexpr size_t WS_NEED = 344 * MiB + 512 * 1024;
constexpr size_t SM_AEND = 0;
constexpr size_t SM_HEND = SM_AEND + (size_t)NBATCH * NSCH * DR * 4;
constexpr size_t SM_TOKE = SM_HEND + (size_t)NBATCH * NSCH * DR * 4;
constexpr size_t SM_TOKP = SM_TOKE + (size_t)T * 4;
constexpr size_t SM_TOKW = SM_TOKP + (size_t)T * 8;
constexpr size_t SM_ROWINFO = SM_TOKW + (size_t)T * 8;
constexpr size_t SM_WGCNT = SM_ROWINFO + (size_t)MOE_ROWS * 4;
constexpr size_t SM_PCONST = SM_WGCNT + 256 * 16 * 4;
constexpr size_t SM_END = SM_PCONST + 3 * 1280 * 4;
static_assert(WS_SMALL + SM_END <= WS_NEED, "small region");
constexpr int CW_BAR = 4096;
constexpr int CW_CNT = 8192;
constexpr int CW_NTILES = 8256;
constexpr int CW_TILEE = 8320;

constexpr int RING_BYTES = 131072;
constexpr int LDSCTL_OFF = RING_BYTES, MISC_OFF = LDSCTL_OFF + 320;
constexpr int LDS_BYTES = 147456;

__device__ __forceinline__ unsigned cvt_pk_bf16(float lo, float hi) { unsigned r; asm volatile("v_cvt_pk_bf16_f32 %0, %1, %2" : "=v"(r) : "v"(lo), "v"(hi)); return r; }
__device__ __forceinline__ float bflo(unsigned w) { return __uint_as_float(w << 16); }
__device__ __forceinline__ float bfhi(unsigned w) { return __uint_as_float(w & 0xffff0000u); }
__device__ __forceinline__ float bf1(bf16_t b) { return __uint_as_float((unsigned)b << 16); }
__device__ __forceinline__ float fsigmoid(float x) { return __builtin_amdgcn_rcpf(1.0f + __builtin_amdgcn_exp2f(-1.4426950408889634f * x)); }
__device__ __forceinline__ float gelu_tanh(float y) { const float u = 1.5957691216057308f * (y + 0.044715f * y * y * y); return y * fsigmoid(u); }
__device__ __forceinline__ float wave_sum(float v) {
#pragma unroll
    for (int o = 1; o < 64; o <<= 1) v += __shfl_xor(v, o);
    return v;
}
typedef int v8i __attribute__((ext_vector_type(8)));
typedef int v4i __attribute__((ext_vector_type(4)));
__device__ __forceinline__ unsigned pk4_fp8(float a, float b, float c, float d) {
    a = __builtin_amdgcn_fmed3f(a, -448.f, 448.f); b = __builtin_amdgcn_fmed3f(b, -448.f, 448.f); c = __builtin_amdgcn_fmed3f(c, -448.f, 448.f); d = __builtin_amdgcn_fmed3f(d, -448.f, 448.f);
    int w = __builtin_amdgcn_cvt_pk_fp8_f32(a, b, 0, false); w = __builtin_amdgcn_cvt_pk_fp8_f32(c, d, w, true); return (unsigned)w; }
#define LDS_WAIT() asm volatile("s_waitcnt lgkmcnt(0)" ::: "memory")
#define VM_WAIT() asm volatile("s_waitcnt vmcnt(0)" ::: "memory")

namespace pg8 {
constexpr int BM = 256, BK = 64, HALF = 128, HTB = HALF * BK * 2, STAGE_BYTES = 8 * HTB, NXCD = 8, WGM = 8;
__host__ __device__ __forceinline__ int lds_byte(int r, int c) { const int st = (r >> 4) * 2 + (c >> 5), rr = r & 15, cc = c & 31, ob = rr * 64 + cc * 2; return st * 1024 + (ob ^ (((ob >> 9) & 1) << 5)); }
__host__ __device__ __forceinline__ void stage_rc(int b, int& R, int& C) { const int st = b / 1024, sb = b % 1024, swz = sb ^ (((sb >> 9) & 1) << 5); R = (st >> 1) * 16 + swz / 64; C = (st & 1) * 32 + (swz % 64) / 2; }
__host__ __device__ __forceinline__ int perm32(int rho) { const int n = rho >> 4, i = rho & 15; return 8 * (i >> 2) + 4 * n + (i & 3); }

struct Unit { const char* a; const char* b; int pm, pn; };

__device__ __forceinline__ bool static_order(int i, int G, int c, int nM, int nN, int& pm, int& pn) {
    const int nwg = nM * nN; const long L = (long)i * G + c; if (L >= nwg) return false;
    int wgid = (int)L; { const int q = nwg / NXCD, r = nwg % NXCD, xcd = wgid % NXCD, off = wgid / NXCD; wgid = (xcd < r ? xcd * (q + 1) : r * (q + 1) + (xcd - r) * q) + off; }
    const int nig = WGM * nN, gid = wgid / nig, fm = gid * WGM, gsz = (nM - fm) < WGM ? (nM - fm) : WGM;
    pm = fm + ((wgid % nig) % gsz); pn = (wgid % nig) / gsz; return true;
}
struct SchedPlain {
    int nM, nN, G, c; const char* A; const char* B; size_t a_tile, b_tile, a_pn;
    __device__ __forceinline__ bool next(int i, Unit& u) const {
        int pm, pn; if (!static_order(i, G, c, nM, nN, pm, pn)) return false;
        u.pm = pm; u.pn = pn; u.a = A + (size_t)pm * a_tile + (size_t)pn * a_pn; u.b = B + (size_t)pn * b_tile; return true;
    }
};
struct SchedMoe {
    int nM, nN, G, c; const char* A; const char* B; size_t a_tile, b_tile, b_exp; const unsigned* tile_e;
    __device__ __forceinline__ bool next(int i, Unit& u) const {
        int pm, pn; if (!static_order(i, G, c, nM, nN, pm, pn)) return false;
        const int e = __builtin_amdgcn_readfirstlane((int)__hip_atomic_load(tile_e + pm, __ATOMIC_RELAXED, __HIP_MEMORY_SCOPE_AGENT));
        u.pm = pm; u.pn = pn; u.a = A + (size_t)pm * a_tile; u.b = B + (size_t)e * b_exp + (size_t)pn * b_tile; return true;
    }
};

template <class Epi, class Sched, bool ALIGN_EPI, int HOOK_T = -1, bool FP8 = false>
__device__ __forceinline__ void gemm_phase(LAS unsigned char* lds, const int lda, const int ldb, const int K, const Sched& S, const Epi& E, const int scale = 0x7f7f7f7f) {
    int tid = threadIdx.x; asm volatile("" : "+v"(tid));
    const int wid = __builtin_amdgcn_readfirstlane(tid >> 6), lane = tid & 63, wr = wid >> 2, wc = wid & 3, fr = lane & 15, fq = lane >> 4;
    int Kop = K; asm volatile("" : "+s"(Kop));
    const int nt = Kop / 128;
    unsigned voffA[2], voffB[2];
#pragma unroll
    for (int i = 0; i < 2; ++i) { int R, C; stage_rc(tid * 16 + i * 8192, R, C); const int Rb = Epi::PERM ? ((R & ~31) + perm32(R & 31)) : R;
        voffA[i] = (unsigned)(R * lda + 2 * C); voffB[i] = (unsigned)(Rb * ldb + 2 * C); }
    const size_t kstep = (size_t)(BK * 2);
    const size_t hstepA = (size_t)HALF * lda, hstepB = (size_t)HALF * ldb;
    const unsigned ldsw = (unsigned)wid * 1024u;
    const int aoff = FP8 ? lds_byte(wr * 64 + fr, fq * 16) : lds_byte(wr * 64 + fr, fq * 8), boff = FP8 ? lds_byte(wc * 32 + fr, fq * 16) : lds_byte(wc * 32 + fr, fq * 8);
    const int f0 = FP8 ? ((fq >> 1) & 1) * 16 : 0, f1 = 16 - f0;
    const LAS unsigned char* pa0 = lds + aoff + f0; const LAS unsigned char* pa1 = lds + aoff + f1; const LAS unsigned char* pb0 = lds + 4 * HTB + boff + f0; const LAS unsigned char* pb1 = lds + 4 * HTB + boff + f1;
    (void)pa1; (void)pb1;
#define PG8_SA(b, h) (((b) * 2 + (h)) * HTB)
#define PG8_SB(b, h) ((4 + (b) * 2 + (h)) * HTB)
#define PG8_STAGE(bufoff, gbase, voff) do { _Pragma("unroll") for (int _i = 0; _i < 2; ++_i) \
        __builtin_amdgcn_global_load_lds((const unsigned*)((const char*)(gbase) + (voff)[_i]), (LAS unsigned*)(lds + (bufoff) + ldsw + _i * 8192), 16, 0, 0); } while (0)
#define PG8_LD8(dst, i_, p0_, p1_, off_) do { const v4i lo_ = *(const LAS v4i*)((p0_) + (off_)), hi_ = *(const LAS v4i*)((p1_) + (off_)); dst[i_] = __builtin_shufflevector(lo_, hi_, 0, 1, 2, 3, 4, 5, 6, 7); } while (0)
#define PG8_LDA(dst, b, h) do { if constexpr (FP8) { _Pragma("unroll") for (int m = 0; m < 4; ++m) PG8_LD8(dst##8, m, pa0, pa1, PG8_SA(b, h) + m * 2048); } \
        else { _Pragma("unroll") for (int m = 0; m < 4; ++m) _Pragma("unroll") for (int k = 0; k < 2; ++k) dst[m][k] = *(const LAS bf16x8*)(pa0 + PG8_SA(b, h) + m * 2048 + k * 1024); } } while (0)
#define PG8_LDB(dst, b, h) do { if constexpr (FP8) { _Pragma("unroll") for (int n = 0; n < 2; ++n) PG8_LD8(dst##8, n, pb0, pb1, PG8_SA(b, h) + n * 2048); } \
        else { _Pragma("unroll") for (int n = 0; n < 2; ++n) _Pragma("unroll") for (int k = 0; k < 2; ++k) dst[n][k] = *(const LAS bf16x8*)(pb0 + PG8_SA(b, h) + n * 2048 + k * 1024); } } while (0)
#define PG8_MMA(ai, bj, At, Bt) do { __builtin_amdgcn_s_setprio(1); _Pragma("unroll") for (int m = 0; m < 4; ++m) _Pragma("unroll") for (int n = 0; n < 2; ++n) { \
        if constexpr (FP8) asm volatile("v_mfma_scale_f32_16x16x128_f8f6f4 %0, %1, %2, %0, %3, %4 op_sel_hi:[0,0,0]" : "+v"(acc[ai][bj][m][n]) : "v"(Bt##8[n]), "v"(At##8[m]), "v"(scale_v), "v"(one_v)); \
        else { _Pragma("unroll") for (int k = 0; k < 2; ++k) acc[ai][bj][m][n] = __builtin_amdgcn_mfma_f32_16x16x32_bf16(Bt[n][k], At[m][k], acc[ai][bj][m][n], 0, 0, 0); } } \
        __builtin_amdgcn_s_setprio(0); } while (0)
#define PG8_WAIT_V(n) asm volatile("s_waitcnt vmcnt(" #n ")" ::: "memory")
#define PG8_WAIT_L(n) asm volatile("s_waitcnt lgkmcnt(" #n ")" ::: "memory")
#define PG8_BAR __builtin_amdgcn_s_barrier()
#define PG8_SCHED __builtin_amdgcn_sched_barrier(0)
    int scale_v = scale, one_v = 0x7f7f7f7f; asm volatile("" : "+v"(scale_v), "+v"(one_v));
    (void)scale_v; (void)one_v;
    Unit cur, nxt; int ui = 0;
    if (!S.next(0, cur)) return;
    f32x4 acc[2][2][4][2];
#pragma unroll
    for (int a = 0; a < 2; ++a)
#pragma unroll
        for (int b = 0; b < 2; ++b)
#pragma unroll
            for (int m = 0; m < 4; ++m)
#pragma unroll
                for (int n = 0; n < 2; ++n) acc[a][b][m][n] = (f32x4){0.f, 0.f, 0.f, 0.f};
    bf16x8 At[4][2], B0[2][2], B1[2][2];
    v8i At8[4], B08[2], B18[2];
    const char* cA = cur.a; const char* cB = cur.b;
    PG8_STAGE(PG8_SB(0, 0), cB, voffB); PG8_STAGE(PG8_SB(0, 1), cB + hstepB, voffB); PG8_STAGE(PG8_SA(0, 0), cA, voffA); PG8_STAGE(PG8_SA(0, 1), cA + hstepA, voffA);
    if (wr == 1) PG8_BAR;
    PG8_WAIT_V(2); PG8_BAR;
    PG8_STAGE(PG8_SB(1, 0), cB + kstep, voffB); PG8_STAGE(PG8_SA(1, 0), cA + kstep, voffA); PG8_STAGE(PG8_SB(1, 1), cB + hstepB + kstep, voffB);
    PG8_WAIT_V(6); PG8_BAR;
    for (;;) {
        const bool has_next = S.next(ui + 1, nxt);
        const char* nA = has_next ? nxt.a : cA; const char* nB = has_next ? nxt.b : cB;
        for (int t = 0; t < nt; t += 2) {
            const bool last = (t == nt - 2);
            if constexpr (HOOK_T >= 0) { if (t == HOOK_T) { if constexpr (FP8) asm volatile("s_nop 15\n\ts_nop 15" ::: "memory"); int fr2 = fr, fq2 = fq; asm volatile("" : "+v"(fr2), "+v"(fq2)); E.hook(acc, cur, wr, wc, fr2, fq2); } }
            const char* a1 = cA + (size_t)(t + 1) * kstep;
            const char* a2 = last ? nA : cA + (size_t)(t + 2) * kstep; const char* b2 = last ? nB : cB + (size_t)(t + 2) * kstep;
            const char* a3 = a2 + kstep; const char* b3 = b2 + kstep;
            PG8_LDB(B0, 0, 0); PG8_LDB(B1, 0, 1); PG8_SCHED; PG8_LDA(At, 0, 0); PG8_STAGE(PG8_SA(1, 1), a1 + hstepA, voffA);
            PG8_WAIT_V(8); PG8_WAIT_L(0); PG8_BAR; PG8_MMA(0, 0, At, B0); PG8_MMA(0, 1, At, B1); PG8_BAR; PG8_SCHED;
            PG8_LDA(At, 0, 1); PG8_STAGE(PG8_SB(0, 0), b2, voffB); PG8_STAGE(PG8_SB(0, 1), b2 + hstepB, voffB); PG8_STAGE(PG8_SA(0, 0), a2, voffA);
            PG8_WAIT_V(8); PG8_WAIT_L(0); PG8_BAR; PG8_MMA(1, 0, At, B0); PG8_MMA(1, 1, At, B1); PG8_BAR; PG8_SCHED;
            PG8_LDB(B0, 1, 0); PG8_LDB(B1, 1, 1); PG8_SCHED; PG8_LDA(At, 1, 0); PG8_STAGE(PG8_SA(0, 1), a2 + hstepA, voffA);
            PG8_WAIT_V(8); PG8_WAIT_L(0); PG8_BAR; PG8_MMA(0, 0, At, B0); PG8_MMA(0, 1, At, B1); PG8_BAR; PG8_SCHED;
            PG8_LDA(At, 1, 1); PG8_STAGE(PG8_SB(1, 0), b3, voffB); PG8_STAGE(PG8_SB(1, 1), b3 + hstepB, voffB); PG8_STAGE(PG8_SA(1, 0), a3, voffA);
            PG8_WAIT_V(8); PG8_WAIT_L(0); PG8_BAR; PG8_MMA(1, 0, At, B0); PG8_MMA(1, 1, At, B1); PG8_BAR; PG8_SCHED;
        }
        if constexpr (ALIGN_EPI) { if (wr == 0) PG8_BAR; }
        if constexpr (FP8) asm volatile("s_nop 15\n\ts_nop 15" ::: "memory");
        { int fr2 = fr, fq2 = fq; asm volatile("" : "+v"(fr2), "+v"(fq2));
          E(acc, cur, wr, wc, fr2, fq2); }
        if (!has_next) break;
#pragma unroll
        for (int a = 0; a < 2; ++a)
#pragma unroll
            for (int b = 0; b < 2; ++b)
#pragma unroll
                for (int m = 0; m < 4; ++m)
#pragma unroll
                    for (int n = 0; n < 2; ++n) acc[a][b][m][n] = (f32x4){0.f, 0.f, 0.f, 0.f};
        cur = nxt; cA = nA; cB = nB; ++ui;
        if constexpr (ALIGN_EPI) { if (wr == 1) PG8_BAR; }
    }
    PG8_WAIT_V(0);
    if constexpr (!ALIGN_EPI) { if (wr == 0) PG8_BAR; }
    PG8_BAR;
#undef PG8_SA
#undef PG8_SB
#undef PG8_STAGE
#undef PG8_LDA
#undef PG8_LDB
#undef PG8_MMA
#undef PG8_LD8
#undef PG8_WAIT_V
#undef PG8_WAIT_L
#undef PG8_BAR
#undef PG8_SCHED
}

typedef const f32x4 (&AccRef)[2][2][4][2];
typedef f32x4 (&AccMut)[2][2][4][2];
#define EPI_LOOP_ROWS for (int ai = 0; ai < 2; ++ai) _Pragma("unroll") for (int m = 0; m < 4; ++m)

struct EpiZ {
    static constexpr bool PERM = true;
    bf16_t* Z; bf16_t* GG; int row_base;
    __device__ __forceinline__ void operator()(AccRef acc, const Unit& u, int wr, int wc, int fr, int fq) const {
        const int row0 = u.pm * BM + wr * 64 + fr;
        if (u.pn < 8) {
            bf16_t* base = Z + u.pn * HALF + wc * 32 + 8 * fq;
#pragma unroll
            EPI_LOOP_ROWS { const f32x4 h0 = acc[ai][0][m][0], h1 = acc[ai][0][m][1], c0 = acc[ai][1][m][0], c1 = acc[ai][1][m][1];
                u32x4 w; w.x = cvt_pk_bf16(h0[0] * c0[0], h0[1] * c0[1]); w.y = cvt_pk_bf16(h0[2] * c0[2], h0[3] * c0[3]); w.z = cvt_pk_bf16(h1[0] * c1[0], h1[1] * c1[1]); w.w = cvt_pk_bf16(h1[2] * c1[2], h1[3] * c1[3]);
                *(u32x4*)(base + (size_t)(row0 + ai * HALF + m * 16) * ZC) = w; }
        } else {
            const int colt = u.pn * BM + wc * 32 + 8 * fq; const int act = u.pn < 17 ? 0 : (u.pn < 22 ? 1 : 2);
            bf16_t* base; size_t ldc;
            if (u.pn < 22) { base = Z + (colt - 1024); ldc = ZC; } else { base = GG + (size_t)row_base * GGC + (colt - 5632); ldc = GGC; }
#pragma unroll
            EPI_LOOP_ROWS { bf16_t* rowp = base + (size_t)(row0 + ai * HALF + m * 16) * ldc;
#pragma unroll
                for (int bj = 0; bj < 2; ++bj) { f32x4 v0 = acc[ai][bj][m][0], v1 = acc[ai][bj][m][1];
                    if (act == 1) {
#pragma unroll
                        for (int j = 0; j < 4; ++j) { v0[j] = gelu_tanh(v0[j]); v1[j] = gelu_tanh(v1[j]); } }
                    else if (act == 2) {
#pragma unroll
                        for (int j = 0; j < 4; ++j) { v0[j] = fsigmoid(v0[j]); v1[j] = fsigmoid(v1[j]); } }
                    u32x4 w; w.x = cvt_pk_bf16(v0[0], v0[1]); w.y = cvt_pk_bf16(v0[2], v0[3]); w.z = cvt_pk_bf16(v1[0], v1[1]); w.w = cvt_pk_bf16(v1[2], v1[3]);
                    *(u32x4*)(rowp + bj * HALF) = w; } }
        }
    }
};
struct EpiBf16 {
    static constexpr bool PERM = true;
    bf16_t* O; int ldc;
    __device__ __forceinline__ void operator()(AccRef acc, const Unit& u, int wr, int wc, int fr, int fq) const {
        const int row0 = u.pm * BM + wr * 64 + fr; const int colt = u.pn * BM + wc * 32 + 8 * fq;
#pragma unroll
        EPI_LOOP_ROWS { bf16_t* rowp = O + (size_t)(row0 + ai * HALF + m * 16) * ldc + colt;
#pragma unroll
            for (int bj = 0; bj < 2; ++bj) { const f32x4 v0 = acc[ai][bj][m][0], v1 = acc[ai][bj][m][1];
                u32x4 w; w.x = cvt_pk_bf16(v0[0], v0[1]); w.y = cvt_pk_bf16(v0[2], v0[3]); w.z = cvt_pk_bf16(v1[0], v1[1]); w.w = cvt_pk_bf16(v1[2], v1[3]);
                *(u32x4*)(rowp + bj * HALF) = w; } }
    }
};
struct EpiRG {
    static constexpr bool PERM = true;
    bf16_t* GT; const bf16_t* XC; const float* PC;
    __device__ __forceinline__ void operator()(AccRef acc, const Unit& u, int wr, int wc, int fr, int fq) const {
        const int row0 = u.pm * BM + wr * 64 + fr; const int cc = wc * 32 + 8 * fq, ch = u.pn * HALF + cc;
        float c8[8], ba[8], bx[8];
        { const f32x4 a0 = *(const f32x4*)(PC + ch), a1 = *(const f32x4*)(PC + ch + 4), b0 = *(const f32x4*)(PC + DR + ch), b1 = *(const f32x4*)(PC + DR + ch + 4), x0 = *(const f32x4*)(PC + 2 * DR + ch), x1 = *(const f32x4*)(PC + 2 * DR + ch + 4);
#pragma unroll
          for (int j = 0; j < 4; ++j) { c8[j] = a0[j]; c8[4 + j] = a1[j]; ba[j] = b0[j]; ba[4 + j] = b1[j]; bx[j] = x0[j]; bx[4 + j] = x1[j]; } }
        u32x4 xwv[2][4];
#pragma unroll
        EPI_LOOP_ROWS xwv[ai][m] = *(const u32x4*)(XC + (size_t)(row0 + ai * HALF + m * 16) * DR + ch);
#pragma unroll
        EPI_LOOP_ROWS { const size_t r = (size_t)(row0 + ai * HALF + m * 16);
            const u32x4 xw = xwv[ai][m];
            float xc[8]; xc[0] = bflo(xw.x); xc[1] = bfhi(xw.x); xc[2] = bflo(xw.y); xc[3] = bfhi(xw.y); xc[4] = bflo(xw.z); xc[5] = bfhi(xw.z); xc[6] = bflo(xw.w); xc[7] = bfhi(xw.w);
            float la[8], bb[8];
#pragma unroll
            for (int n = 0; n < 2; ++n)
#pragma unroll
                for (int j = 0; j < 4; ++j) { const int k = 4 * n + j; const float rp = acc[ai][0][m][n][j], ip = acc[ai][1][m][n][j];
                    const float l = -c8[k] * fsigmoid(rp + ba[k]); const float x = 2.0f * l;
                    float em = -x * (1.0f + x * (0.5f + x * (0.16666667f + x * (0.041666668f + x * (0.0083333338f + x * 0.0013888889f)))));
                    if (x < -0.4f) em = 1.0f - __builtin_amdgcn_exp2f(1.4426950408889634f * x);
                    la[k] = l; bb[k] = __builtin_amdgcn_sqrtf(em) * fsigmoid(ip + bx[k]) * xc[k]; }
            u32x4 w0, w1; w0.x = cvt_pk_bf16(la[0], la[1]); w0.y = cvt_pk_bf16(la[2], la[3]); w0.z = cvt_pk_bf16(la[4], la[5]); w0.w = cvt_pk_bf16(la[6], la[7]);
            w1.x = cvt_pk_bf16(bb[0], bb[1]); w1.y = cvt_pk_bf16(bb[2], bb[3]); w1.z = cvt_pk_bf16(bb[4], bb[5]); w1.w = cvt_pk_bf16(bb[6], bb[7]);
            *(u32x4*)(GT + r * 2560 + u.pn * BM + cc) = w0; *(u32x4*)(GT + r * 2560 + u.pn * BM + HALF + cc) = w1; }
    }
};
struct EpiMix {
    static constexpr bool PERM = true;
    const bf16_t* GG; unsigned char* MG;
    __device__ __forceinline__ void hook(AccMut acc, const Unit& u, int wr, int wc, int fr, int fq) const {
        const int row0 = u.pm * BM + wr * 64 + fr;
        const int colt = u.pn * BM + wc * 32 + 8 * fq;
#pragma unroll
        EPI_LOOP_ROWS { const size_t r = (size_t)(row0 + ai * HALF + m * 16);
#pragma unroll
            for (int bj = 0; bj < 2; ++bj) { const int c = colt + bj * HALF; const u32x4 ga = *(const u32x4*)(GG + r * GGC + c), gr = *(const u32x4*)(GG + r * GGC + D + c);
                f32x4 q0, q1;
                q0[0] = bflo(ga.x) * __builtin_amdgcn_rcpf(bflo(gr.x)); q0[1] = bfhi(ga.x) * __builtin_amdgcn_rcpf(bfhi(gr.x)); q0[2] = bflo(ga.y) * __builtin_amdgcn_rcpf(bflo(gr.y)); q0[3] = bfhi(ga.y) * __builtin_amdgcn_rcpf(bfhi(gr.y));
                q1[0] = bflo(ga.z) * __builtin_amdgcn_rcpf(bflo(gr.z)); q1[1] = bfhi(ga.z) * __builtin_amdgcn_rcpf(bfhi(gr.z)); q1[2] = bflo(ga.w) * __builtin_amdgcn_rcpf(bflo(gr.w)); q1[3] = bfhi(ga.w) * __builtin_amdgcn_rcpf(bfhi(gr.w));
                acc[ai][bj][m][0] *= q0; acc[ai][bj][m][1] *= q1; }
            asm volatile("" ::: "memory"); }
    }
    __device__ __forceinline__ void operator()(AccRef acc, const Unit& u, int wr, int wc, int fr, int fq) const {
        const int row0 = u.pm * BM + wr * 64 + fr; const int colt = u.pn * BM + wc * 32 + 8 * fq;
#pragma unroll
        EPI_LOOP_ROWS { const size_t r = (size_t)(row0 + ai * HALF + m * 16);
#pragma unroll
            for (int bj = 0; bj < 2; ++bj) { const int c = colt + bj * HALF; const u32x4 g = *(const u32x4*)(GG + r * GGC + D + c);
                const f32x4 v0 = acc[ai][bj][m][0], v1 = acc[ai][bj][m][1];
                u32x2 w; w.x = pk4_fp8(4.f * bflo(g.x) * v0[0], 4.f * bfhi(g.x) * v0[1], 4.f * bflo(g.y) * v0[2], 4.f * bfhi(g.y) * v0[3]);
                w.y = pk4_fp8(4.f * bflo(g.z) * v1[0], 4.f * bfhi(g.z) * v1[1], 4.f * bflo(g.w) * v1[2], 4.f * bfhi(g.w) * v1[3]);
                *(u32x2*)(MG + r * D + c) = w; }
            asm volatile("" ::: "memory"); }
    }
};
struct EpiY {
    static constexpr bool PERM = false;
    const float* X0; float* Y;
    __device__ __forceinline__ void operator()(AccRef acc, const Unit& u, int wr, int wc, int fr, int fq) const {
        const int row0 = u.pm * BM + wr * 64 + fr, col0 = u.pn * BM + wc * 32 + 4 * fq;
#pragma unroll
        EPI_LOOP_ROWS { const size_t r = (size_t)(row0 + ai * HALF + m * 16);
#pragma unroll
            for (int bj = 0; bj < 2; ++bj)
#pragma unroll
                for (int n = 0; n < 2; ++n) { const int c = col0 + bj * HALF + n * 16; const f32x4 x = *(const f32x4*)(X0 + r * D + c);
                    *(f32x4*)(Y + r * D + c) = x * DN_ALPHA + acc[ai][bj][m][n]; }
            asm volatile("" ::: "memory"); }
    }
};
struct EpiH {
    static constexpr bool PERM = true;
    bf16_t* H;
    __device__ __forceinline__ void operator()(AccRef acc, const Unit& u, int wr, int wc, int fr, int fq) const {
        const int row0 = u.pm * BM + wr * 64 + fr; const int col = u.pn * HALF + wc * 32 + 8 * fq;
#pragma unroll
        EPI_LOOP_ROWS { const size_t r = (size_t)(row0 + ai * HALF + m * 16);
            const f32x4 g0 = acc[ai][0][m][0], g1 = acc[ai][0][m][1], u0 = acc[ai][1][m][0], u1 = acc[ai][1][m][1];
            u32x4 w;
            w.x = cvt_pk_bf16(g0[0] * fsigmoid(g0[0]) * u0[0], g0[1] * fsigmoid(g0[1]) * u0[1]);
            w.y = cvt_pk_bf16(g0[2] * fsigmoid(g0[2]) * u0[2], g0[3] * fsigmoid(g0[3]) * u0[3]);
            w.z = cvt_pk_bf16(g1[0] * fsigmoid(g1[0]) * u1[0], g1[1] * fsigmoid(g1[1]) * u1[1]);
            w.w = cvt_pk_bf16(g1[2] * fsigmoid(g1[2]) * u1[2], g1[3] * fsigmoid(g1[3]) * u1[3]);
            *(u32x4*)(H + r * FF + col) = w; }
    }
};
struct EpiO {
    static constexpr bool PERM = true;
    bf16_t* O; const int* rowinfo;
    __device__ __forceinline__ void operator()(AccRef acc, const Unit& u, int wr, int wc, int fr, int fq) const {
        const int row0 = u.pm * BM + wr * 64 + fr; const int colt = u.pn * BM + wc * 32 + 8 * fq;
#pragma unroll
        EPI_LOOP_ROWS { const int dst = rowinfo[row0 + ai * HALF + m * 16];
            if (dst >= 0) { bf16_t* rowp = O + (size_t)dst * D + colt;
#pragma unroll
                for (int bj = 0; bj < 2; ++bj) { const f32x4 v0 = acc[ai][bj][m][0], v1 = acc[ai][bj][m][1];
                    u32x4 w; w.x = cvt_pk_bf16(v0[0], v0[1]); w.y = cvt_pk_bf16(v0[2], v0[3]); w.z = cvt_pk_bf16(v1[0], v1[1]); w.w = cvt_pk_bf16(v1[2], v1[3]);
                    *(u32x4*)(rowp + bj * HALF) = w; } } }
    }
};
}

#define XB_TMO      128
#define XB_XCNT(j)  (256  + 64 * (j))
#define XB_XSUB(j)  (1280 + 64 * (j))
#define XB_XGEN(j)  (2304 + 64 * (j))
#define XB_TOP      3328
#define XB_TOPGEN   3392
#define XCD_BAR_WORDS 3456
#define XB_SPIN_CAP (1u << 18)
__device__ __forceinline__ unsigned xb_ld(unsigned* p)              { return __hip_atomic_load(p, __ATOMIC_RELAXED, __HIP_MEMORY_SCOPE_AGENT); }
__device__ __forceinline__ unsigned xb_add(unsigned* p, unsigned v) { return __hip_atomic_fetch_add(p, v, __ATOMIC_RELAXED, __HIP_MEMORY_SCOPE_AGENT); }
__device__ __forceinline__ unsigned xb_xcc_id() { return (unsigned)__builtin_amdgcn_s_getreg((3 << 11) | 20) & 0xFu; }
#define XB_SPIN(cond, bar) do { unsigned _sp = 0; while (cond) { __builtin_amdgcn_s_sleep(1); \
    if ((++_sp & 255u) == 0u) { if (xb_ld(&(bar)[XB_TMO])) break; if (_sp > XB_SPIN_CAP) { atomicAdd(&(bar)[XB_TMO], 1u); break; } } } } while (0)
struct XcdBarrier { unsigned* bar; unsigned x; volatile LAS unsigned* st; };
__device__ __forceinline__ XcdBarrier xcd_barrier_post(unsigned* bar, volatile LAS unsigned* st) {
    XcdBarrier b; b.bar = bar; b.x = xb_xcc_id(); b.st = st;
    if (threadIdx.x == 0) (void)xb_add(&bar[XB_XCNT(b.x)], 1u);
    return b;
}
__device__ __forceinline__ void xcd_barrier_complete(unsigned* bar, unsigned x, unsigned& nloc, unsigned& nx) {
    const unsigned G = gridDim.x * gridDim.y * gridDim.z;
    unsigned sum, cnt, mine, sp = 0u;
    for (;;) {
        sum = 0u; cnt = 0u; mine = 0u;
#pragma unroll
        for (unsigned j = 0; j < 16; ++j) { const unsigned c = xb_ld(&bar[XB_XCNT(j)]); sum += c; cnt += (c > 0u) ? 1u : 0u; mine = (j == x) ? c : mine; }
        if (sum == G) break;
        __builtin_amdgcn_s_sleep(1);
        if ((++sp & 255u) == 0u) { if (xb_ld(&bar[XB_TMO])) break; if (sp > XB_SPIN_CAP) { atomicAdd(&bar[XB_TMO], 1u); break; } }
    }
    nloc = mine > 0u ? mine : 1u; nx = cnt > 0u ? cnt : 1u;
}
__device__ __forceinline__ void xcd_barrier(const XcdBarrier& b) {
    asm volatile("s_waitcnt vmcnt(0)" ::: "memory");
    __syncthreads();
    if (threadIdx.x == 0) {
        unsigned* bar = b.bar;
        __builtin_amdgcn_s_waitcnt(0);
        unsigned nloc = b.st[0], nx = b.st[1];
        if (nloc == 0u) { xcd_barrier_complete(bar, b.x, nloc, nx); b.st[0] = nloc; b.st[1] = nx; }
        const unsigned old = xb_add(&bar[XB_XSUB(b.x)], 1u);
        const unsigned gen = old / nloc;
        if (old + 1u == (gen + 1u) * nloc) {
            __builtin_amdgcn_fence(__ATOMIC_RELEASE, "agent");
            asm volatile("s_waitcnt vmcnt(0)" ::: "memory");
            const unsigned og = xb_add(&bar[XB_TOP], 1u);
            const unsigned tg = og / nx;
            if (og + 1u == (tg + 1u) * nx) xb_add(&bar[XB_TOPGEN], 1u);
            else XB_SPIN(xb_ld(&bar[XB_TOPGEN]) == tg, bar);
            __builtin_amdgcn_fence(__ATOMIC_ACQUIRE, "agent");
            xb_add(&bar[XB_XGEN(b.x)], 1u);
            asm volatile("s_waitcnt vmcnt(0)" ::: "memory");
        } else {
            XB_SPIN(xb_ld(&bar[XB_XGEN(b.x)]) == gen, bar);
            __builtin_amdgcn_fence(__ATOMIC_ACQUIRE, "agent");
            asm volatile("s_waitcnt vmcnt(0)" ::: "memory");
        }
    }
    __syncthreads();
}

struct Args {
    const float* x; const float* w_in; const float* conv_a_w; const float* w_branch_a; const float* conv_r_w; const float* conv_r_b;
    const float* w_rg_a; const float* b_rg_a; const float* w_rg_x; const float* b_rg_x; const float* rg_lambda; const float* w_branch_r; const float* w_out;
    const float* ln1_g; const float* ln1_b; const float* w_router; const float* b_router; const float* w_exp_gate; const float* w_exp_up; const float* w_exp_down;
    const float* ln2_g; const float* ln2_b;
    float* out; unsigned char* ws; int ph_lo, ph_hi;
};

typedef const Args __attribute__((address_space(4)))* ArgsP;

__device__ __forceinline__ void transpose_item(const float* W, int N, int k0, int n0, bf16_t* WT, int ldk, int drow0, LAS float* scr, int lane) {
    float tv[32];
    { const float* wp = W + (size_t)(k0 + (lane >> 5)) * N + n0 + (lane & 31);
#pragma unroll
      for (int i = 0; i < 32; ++i) tv[i] = wp[(size_t)(2 * i) * N]; }
#pragma unroll
    for (int i = 0; i < 32; ++i) scr[(2 * i + (lane >> 5)) * 33 + (lane & 31)] = tv[i];
    LDS_WAIT(); asm volatile("" ::: "memory");
    const int c = lane & 7;
#pragma unroll
    for (int j = 0; j < 4; ++j) { const int n = (lane >> 3) + 8 * j; const LAS float* s = scr + (8 * c) * 33 + n;
        u32x4 o; o.x = cvt_pk_bf16(s[0 * 33], s[1 * 33]); o.y = cvt_pk_bf16(s[2 * 33], s[3 * 33]); o.z = cvt_pk_bf16(s[4 * 33], s[5 * 33]); o.w = cvt_pk_bf16(s[6 * 33], s[7 * 33]);
        *(u32x4*)(WT + (size_t)(drow0 + n) * ldk + k0 + 8 * c) = o; }
    LDS_WAIT(); asm volatile("" ::: "memory");
}
__device__ __forceinline__ void transpose_item8(const float* W, int N, int k0, int n0, unsigned char* WT, int ldk, int drow0, float sc, LAS float* scr, int lane) {
    float tv[32];
    { const float* wp = W + (size_t)(k0 + (lane >> 5)) * N + n0 + (lane & 31);
#pragma unroll
      for (int i = 0; i < 32; ++i) tv[i] = wp[(size_t)(2 * i) * N]; }
#pragma unroll
    for (int i = 0; i < 32; ++i) scr[(2 * i + (lane >> 5)) * 33 + (lane & 31)] = tv[i];
    LDS_WAIT(); asm volatile("" ::: "memory");
    const int c = lane & 7;
#pragma unroll
    for (int j = 0; j < 4; ++j) { const int n = (lane >> 3) + 8 * j; const LAS float* s = scr + (8 * c) * 33 + n;
        u32x2 o; o.x = pk4_fp8(sc * s[0 * 33], sc * s[1 * 33], sc * s[2 * 33], sc * s[3 * 33]); o.y = pk4_fp8(sc * s[4 * 33], sc * s[5 * 33], sc * s[6 * 33], sc * s[7 * 33]);
        *(u32x2*)(WT + (size_t)(drow0 + n) * ldk + k0 + 8 * c) = o; }
    LDS_WAIT(); asm volatile("" ::: "memory");
}
__device__ __forceinline__ void transpose_plain(const float* W, int K, int N, bf16_t* WT, int item, LAS float* scr, int lane) {
    const int nblk = N / 32, kb = item / nblk, nb = item % nblk;
    transpose_item(W, N, 64 * kb, 32 * nb, WT, K, 32 * nb, scr, lane);
}

__device__ __forceinline__ void prep_tm_weights(ArgsP a, int l, unsigned char* ws, LAS float* scr, int gw, int NGW, int lane) {
    constexpr int I_IN = (D / 64) * (DIN / 32), I_A = (D / 64) * (D / 32), I_R = (DR / 64) * (D / 32), I_O = I_A, I_G = 2 * NHEAD * 2 * 4;
    constexpr int NITEMS = I_IN + I_A + I_R + I_O + I_G;
    if (gw < 20) { const int c = gw * 64 + lane; float* PC = (float*)(ws + WS_SMALL + SM_PCONST);
        PC[c] = 8.0f * log1pf(__expf(-a->rg_lambda[(size_t)l * DR + c])); PC[DR + c] = a->b_rg_a[(size_t)l * DR + c]; PC[2 * DR + c] = a->b_rg_x[(size_t)l * DR + c]; }
    for (int it = gw; it < NITEMS; it += NGW) {
        int r = it;
        if (r < I_IN) { const int nblk = DIN / 32, kb = r / nblk, n0 = 32 * (r % nblk);
            const int drow0 = n0 < 1024 ? (n0 >> 7) * 256 + (n0 & 127) : (n0 < 2048 ? n0 + 1024 : (n0 < 3072 ? ((n0 - 2048) >> 7) * 256 + 128 + (n0 & 127) : n0));
            transpose_item8(a->w_in + (size_t)l * D * DIN, DIN, 64 * kb, n0, ws + WS_WIN, D, drow0, 32.f, scr, lane); continue; } r -= I_IN;
        if (r < I_A) { const int kb = r / (D / 32), nb = r % (D / 32); transpose_item8(a->w_branch_a + (size_t)l * D * D, D, 64 * kb, 32 * nb, ws + WS_WA, UC, 32 * nb, 64.f, scr, lane); continue; } r -= I_A;
        if (r < I_R) { const int kb = r / (D / 32), nb = r % (D / 32); transpose_item8(a->w_branch_r + (size_t)l * DR * D, D, 64 * kb, 32 * nb, ws + WS_WA + D, UC, 32 * nb, 16.f, scr, lane); continue; } r -= I_R;
        if (r < I_O) { const int kb = r / (D / 32), nb = r % (D / 32); transpose_item8(a->w_out + (size_t)l * D * D, D, 64 * kb, 32 * nb, ws + WS_WO, D, 32 * nb, 64.f, scr, lane); continue; } r -= I_O;
        {
            const int nb = r & 3, kb = (r >> 2) & 1, hw = r >> 3, which = hw & 1, hh = hw >> 1;
            const float* W = (which ? a->w_rg_x : a->w_rg_a) + ((size_t)l * NHEAD + hh) * 128 * 128;
            transpose_item(W, 128, 64 * kb, 32 * nb, (bf16_t*)(ws + WS_WG), 128, hh * 256 + which * 128 + 32 * nb, scr, lane);
        }
    }
}
__device__ __forceinline__ void prep_expert_weights(ArgsP a, int l, unsigned char* ws, LAS float* scr, int gw, int NGW, int lane) {
    constexpr int I_G = (D / 64) * (FF / 32), I_D = (FF / 64) * (D / 32), PER_E = 2 * I_G + I_D;
    bf16_t* WGU = (bf16_t*)(ws + WS_WEX); bf16_t* WDN = WGU + (size_t)NE * 1024 * 1024;
    for (int it = gw; it < NE * PER_E; it += NGW) {
        const int e = it / PER_E; int r = it % PER_E;
        if (r < 2 * I_G) { const int which = r / I_G; r %= I_G; const int nblk = FF / 32, kb = r / nblk, nb = r % nblk, n0 = 32 * nb;
            const float* W = (which ? a->w_exp_up : a->w_exp_gate) + ((size_t)l * NE + e) * D * FF;
            const int drow0 = (n0 >> 7) * 256 + which * 128 + (n0 & 127);
            transpose_item(W, FF, 64 * kb, n0, WGU + (size_t)e * 1024 * 1024, D, drow0, scr, lane);
        } else { r -= 2 * I_G; const float* W = a->w_exp_down + ((size_t)l * NE + e) * FF * D;
            transpose_plain(W, FF, D, WDN + (size_t)e * 1024 * 512, r, scr, lane); }
    }
}
__device__ __forceinline__ void cvt_x(const float* x, unsigned char* xb, int gtid, int nthr) {
    for (size_t i = gtid; i < (size_t)T * D / 8; i += (size_t)4 * nthr) {
        f32x4 a[4], b[4];
#pragma unroll
        for (int k = 0; k < 4; ++k) { a[k] = *(const f32x4*)(x + (i + (size_t)k * nthr) * 8); b[k] = *(const f32x4*)(x + (i + (size_t)k * nthr) * 8 + 4); }
#pragma unroll
        for (int k = 0; k < 4; ++k) { u32x2 w; w.x = pk4_fp8(a[k][0], a[k][1], a[k][2], a[k][3]); w.y = pk4_fp8(b[k][0], b[k][1], b[k][2], b[k][3]); *(u32x2*)(xb + (i + (size_t)k * nthr) * 8) = w; } }
}
__device__ __forceinline__ void unpack8(const u32x4 w, float (&f)[8]) { f[0] = bflo(w.x); f[1] = bfhi(w.x); f[2] = bflo(w.y); f[3] = bfhi(w.y); f[4] = bflo(w.z); f[5] = bfhi(w.z); f[6] = bflo(w.w); f[7] = bfhi(w.w); }
__device__ __forceinline__ u32x4 pack8(const float (&f)[8]) { u32x4 w; w.x = cvt_pk_bf16(f[0], f[1]); w.y = cvt_pk_bf16(f[2], f[3]); w.z = cvt_pk_bf16(f[4], f[5]); w.w = cvt_pk_bf16(f[6], f[7]); return w; }

__device__ __forceinline__ void phase_e1(ArgsP a, int l, int half, unsigned char* ws, int gtid, int nthr) {
    const bf16_t* Z = (const bf16_t*)(ws + WS_Z); unsigned char* UA = ws + WS_U + (size_t)half * TH * UC; bf16_t* XC = (bf16_t*)(ws + WS_XC);
    constexpr int RUN = 8;
    constexpr int NA = (TH / RUN) * (D / 8), NR = (TH / RUN) * (DR / 8);
    for (int it = gtid; it < NA + NR; it += nthr) {
        if (it < NA) {
            const int cg = it % (D / 8), run = it / (D / 8), t0 = run * RUN, c0 = cg * 8;
            const bool first = (t0 & (SEQ - 1)) == 0;
            u32x4 vv[RUN + 2], bw[RUN];
            vv[0] = first ? (u32x4){0u, 0u, 0u, 0u} : *(const u32x4*)(Z + (size_t)(t0 - 2) * ZC + c0);
            vv[1] = first ? (u32x4){0u, 0u, 0u, 0u} : *(const u32x4*)(Z + (size_t)(t0 - 1) * ZC + c0);
#pragma unroll
            for (int i = 0; i < RUN; ++i) { vv[i + 2] = *(const u32x4*)(Z + (size_t)(t0 + i) * ZC + c0); bw[i] = *(const u32x4*)(Z + (size_t)(t0 + i) * ZC + D + c0); }
            float w0[8], w1[8], w2[8];
            { const float* cw = a->conv_a_w + (size_t)l * 3 * D + c0;
#pragma unroll
              for (int j = 0; j < 8; ++j) { w0[j] = cw[j]; w1[j] = cw[D + j]; w2[j] = cw[2 * D + j]; } }
            float vm2[8], vm1[8]; unpack8(vv[0], vm2); unpack8(vv[1], vm1);
#pragma unroll
            for (int i = 0; i < RUN; ++i) { float v[8], bb[8], o[8]; unpack8(vv[i + 2], v); unpack8(bw[i], bb);
#pragma unroll
                for (int j = 0; j < 8; ++j) { o[j] = bb[j] * (w0[j] * vm2[j] + w1[j] * vm1[j] + w2[j] * v[j]); vm2[j] = vm1[j]; vm1[j] = v[j]; }
                u32x2 w8; w8.x = pk4_fp8(o[0], o[1], o[2], o[3]); w8.y = pk4_fp8(o[4], o[5], o[6], o[7]); *(u32x2*)(UA + (size_t)(t0 + i) * UC + c0) = w8; }
        } else {
            const int r = it - NA; const int cg = r % (DR / 8), run = r / (DR / 8), t0 = run * RUN, c0 = cg * 8;
            const bool first = (t0 & (SEQ - 1)) == 0;
            u32x4 xv[RUN + 3];
#pragma unroll
            for (int i = 0; i < 3; ++i) xv[i] = first ? (u32x4){0u, 0u, 0u, 0u} : *(const u32x4*)(Z + (size_t)(t0 - 3 + i) * ZC + 2 * D + c0);
#pragma unroll
            for (int i = 0; i < RUN; ++i) xv[i + 3] = *(const u32x4*)(Z + (size_t)(t0 + i) * ZC + 2 * D + c0);
            float w0[8], w1[8], w2[8], w3[8], bi[8];
            { const float* cw = a->conv_r_w + (size_t)l * 4 * DR + c0; const float* cb = a->conv_r_b + (size_t)l * DR + c0;
#pragma unroll
              for (int j = 0; j < 8; ++j) { w0[j] = cw[j]; w1[j] = cw[DR + j]; w2[j] = cw[2 * DR + j]; w3[j] = cw[3 * DR + j]; bi[j] = cb[j]; } }
            float x3[8], x2[8], x1[8]; unpack8(xv[0], x3); unpack8(xv[1], x2); unpack8(xv[2], x1);
#pragma unroll
            for (int i = 0; i < RUN; ++i) { float x0[8], o[8]; unpack8(xv[i + 3], x0);
#pragma unroll
                for (int j = 0; j < 8; ++j) { o[j] = w0[j] * x3[j] + w1[j] * x2[j] + w2[j] * x1[j] + w3[j] * x0[j] + bi[j]; x3[j] = x2[j]; x2[j] = x1[j]; x1[j] = x0[j]; }
                *(u32x4*)(XC + (size_t)(t0 + i) * DR + c0) = pack8(o); }
        }
    }
}

template <bool FINAL>
__device__ __forceinline__ void phase_scan(int half, unsigned char* ws, int gtid, int nthr) {
    const bf16_t* GT = (const bf16_t*)(ws + WS_GT); const bf16_t* Z = (const bf16_t*)(ws + WS_Z);
    float* AEND = (float*)(ws + WS_SMALL + SM_AEND); float* HEND = (float*)(ws + WS_SMALL + SM_HEND);
    unsigned char* UR = ws + WS_U + (size_t)half * TH * UC + D;
    constexpr int NP = DR / 2, NITEMS = (TH / SEQ) * NSCH * NP, BT = 16;
    for (int it = gtid; it < NITEMS; it += nthr) {
        const int cp = it % NP, j = (it / NP) % NSCH, bl = it / (NP * NSCH), c = 2 * cp, hh = c >> 7, cc = c & 127, b = half * (TH / SEQ) + bl;
        float h0 = 0.f, h1 = 0.f, L0 = 0.f, L1 = 0.f;
        if (FINAL) {
            const size_t sb = (size_t)b * NSCH * DR + c; int jj = 0;
            for (; jj + 8 <= j; jj += 8) { f32x2 ae[8], he[8];
#pragma unroll
                for (int k = 0; k < 8; ++k) { ae[k] = *(const f32x2*)(AEND + sb + (size_t)(jj + k) * DR); he[k] = *(const f32x2*)(HEND + sb + (size_t)(jj + k) * DR); }
#pragma unroll
                for (int k = 0; k < 8; ++k) { h0 = ae[k].x * h0 + he[k].x; h1 = ae[k].y * h1 + he[k].y; } }
            for (; jj < j; ++jj) { const f32x2 ae = *(const f32x2*)(AEND + sb + (size_t)jj * DR), he = *(const f32x2*)(HEND + sb + (size_t)jj * DR); h0 = ae.x * h0 + he.x; h1 = ae.y * h1 + he.y; }
        }
        const size_t row0 = (size_t)bl * SEQ + (size_t)j * SCH;
        const bf16_t* gl = GT + row0 * 2560 + hh * 256 + cc; const bf16_t* zy = Z + row0 * ZC + 2 * D + DR + c; unsigned char* ur = UR + row0 * UC + c;
#pragma unroll 1
        for (int t0 = 0; t0 < SCH; t0 += BT) {
            unsigned lw[BT], bw[BT], yw[BT];
#pragma unroll
            for (int k = 0; k < BT; ++k) { lw[k] = *(const unsigned*)(gl + (size_t)(t0 + k) * 2560); bw[k] = *(const unsigned*)(gl + (size_t)(t0 + k) * 2560 + 128);
                if (FINAL) yw[k] = *(const unsigned*)(zy + (size_t)(t0 + k) * ZC); }
#pragma unroll
            for (int k = 0; k < BT; ++k) { const float l0 = bflo(lw[k]), l1 = bfhi(lw[k]);
                h0 = __expf(l0) * h0 + bflo(bw[k]); h1 = __expf(l1) * h1 + bfhi(bw[k]);
                if (FINAL) *(unsigned short*)(ur + (size_t)(t0 + k) * UC) = (unsigned short)pk4_fp8(4.f * h0 * bflo(yw[k]), 4.f * h1 * bfhi(yw[k]), 0.f, 0.f);
                else { L0 += l0; L1 += l1; } }
        }
        if (!FINAL) { const size_t si = ((size_t)b * NSCH + j) * DR + c; *(f32x2*)(AEND + si) = (f32x2){__expf(L0), __expf(L1)}; *(f32x2*)(HEND + si) = (f32x2){h0, h1}; }
    }
}

__device__ __forceinline__ void phase_ln1_router(ArgsP a, int l, unsigned char* ws, LAS unsigned char* lds, int tid, int lane, int gw, int NGW, int vcu) {
    LAS f32x4* wl = (LAS f32x4*)lds;
    for (int idx = tid; idx < 4096; idx += 512) { const int ln = idx & 63, q = (idx >> 6) & 3, jk = idx >> 8, d = 4 * ln + 256 * (jk >> 2) + (jk & 3);
        wl[idx] = *(const f32x4*)(a->w_router + (size_t)d * NE + 4 * q); }
    LAS unsigned* lcnt = (LAS unsigned*)(lds + 65536);
    if (tid < NE) lcnt[tid] = 0u;
    __syncthreads();
    const float* Y = (const float*)(ws + WS_Y); float* X1 = (float*)(ws + WS_X1); bf16_t* XB = (bf16_t*)(ws + WS_XB);
    unsigned* TOKE = (unsigned*)(ws + WS_SMALL + SM_TOKE); unsigned* TOKP = (unsigned*)(ws + WS_SMALL + SM_TOKP); float* TOKW = (float*)(ws + WS_SMALL + SM_TOKW);
    f32x4 gv[4], bv[4];
#pragma unroll
    for (int j = 0; j < 4; ++j) { gv[j] = *(const f32x4*)(a->ln1_g + (size_t)l * D + 4 * lane + 256 * j); bv[j] = *(const f32x4*)(a->ln1_b + (size_t)l * D + 4 * lane + 256 * j); }
    float br[16];
#pragma unroll
    for (int e = 0; e < 16; ++e) br[e] = a->b_router[e];
    for (int t = gw; t < T; t += NGW) {
        f32x4 v[4]; float s = 0.f;
#pragma unroll
        for (int j = 0; j < 4; ++j) { v[j] = *(const f32x4*)(Y + (size_t)t * D + 4 * lane + 256 * j); s += (v[j][0] + v[j][1]) + (v[j][2] + v[j][3]); }
        const float mean = wave_sum(s) * (1.f / D); float s2 = 0.f;
#pragma unroll
        for (int j = 0; j < 4; ++j) { v[j] = v[j] - mean; s2 += (v[j][0] * v[j][0] + v[j][1] * v[j][1]) + (v[j][2] * v[j][2] + v[j][3] * v[j][3]); }
        const float rstd = 1.f / sqrtf(wave_sum(s2) * (1.f / D) + LN_EPS);
        float acc[16];
#pragma unroll
        for (int e = 0; e < 16; ++e) acc[e] = 0.f;
#pragma unroll
        for (int j = 0; j < 4; ++j) { v[j] = v[j] * rstd * gv[j] + bv[j];
            *(f32x4*)(X1 + (size_t)t * D + 4 * lane + 256 * j) = v[j];
            u32x2 w; w.x = cvt_pk_bf16(v[j][0], v[j][1]); w.y = cvt_pk_bf16(v[j][2], v[j][3]); *(u32x2*)(XB + (size_t)t * D + 4 * lane + 256 * j) = w;
#pragma unroll
            for (int k = 0; k < 4; ++k) { const float xv = v[j][k];
#pragma unroll
                for (int q = 0; q < 4; ++q) { const f32x4 w4 = wl[((j * 4 + k) * 4 + q) * 64 + lane]; acc[4 * q] += xv * w4[0]; acc[4 * q + 1] += xv * w4[1]; acc[4 * q + 2] += xv * w4[2]; acc[4 * q + 3] += xv * w4[3]; } } }
        float r8[8], r4[4], r2[2], r1;
        { const bool hi = (lane & 32) != 0;
#pragma unroll
          for (int i = 0; i < 8; ++i) { const float keep = hi ? acc[i + 8] : acc[i], send = hi ? acc[i] : acc[i + 8]; r8[i] = keep + __shfl_xor(send, 32); } }
        { const bool hi = (lane & 16) != 0;
#pragma unroll
          for (int i = 0; i < 4; ++i) { const float keep = hi ? r8[i + 4] : r8[i], send = hi ? r8[i] : r8[i + 4]; r4[i] = keep + __shfl_xor(send, 16); } }
        { const bool hi = (lane & 8) != 0;
#pragma unroll
          for (int i = 0; i < 2; ++i) { const float keep = hi ? r4[i + 2] : r4[i], send = hi ? r4[i] : r4[i + 2]; r2[i] = keep + __shfl_xor(send, 8); } }
        { const bool hi = (lane & 4) != 0; const float keep = hi ? r2[1] : r2[0], send = hi ? r2[0] : r2[1]; r1 = keep + __shfl_xor(send, 4); }
        r1 += __shfl_xor(r1, 2); r1 += __shfl_xor(r1, 1);
        float lg[16]; float mx = -3.0e38f;
#pragma unroll
        for (int e = 0; e < 16; ++e) { lg[e] = __shfl(r1, 4 * e) + br[e]; mx = fmaxf(mx, lg[e]); }
        float p[16];
#pragma unroll
        for (int e = 0; e < 16; ++e) p[e] = __expf(lg[e] - mx);
        int gsel = 0; float gbest = -1.f;
#pragma unroll
        for (int g = 0; g < 4; ++g) { const float p0 = p[4 * g], p1 = p[4 * g + 1], p2 = p[4 * g + 2], p3 = p[4 * g + 3];
            const float sum = (p0 + p1) + (p2 + p3), mn1 = fminf(fminf(p0, p1), fminf(p2, p3));
            const float hi01 = fmaxf(p0, p1), lo01 = fminf(p0, p1), hi23 = fmaxf(p2, p3), lo23 = fminf(p2, p3);
            const float top1 = fmaxf(hi01, hi23), top2 = fmaxf(fminf(hi01, hi23), fmaxf(lo01, lo23));
            (void)sum; (void)mn1;
            const float sc = top1 + top2; if (sc > gbest) { gbest = sc; gsel = g; } }
        float q0, q1, q2, q3;
        q0 = gsel == 0 ? p[0] : gsel == 1 ? p[4] : gsel == 2 ? p[8] : p[12];
        q1 = gsel == 0 ? p[1] : gsel == 1 ? p[5] : gsel == 2 ? p[9] : p[13];
        q2 = gsel == 0 ? p[2] : gsel == 1 ? p[6] : gsel == 2 ? p[10] : p[14];
        q3 = gsel == 0 ? p[3] : gsel == 1 ? p[7] : gsel == 2 ? p[11] : p[15];
        int i1 = 0; float v1 = q0;
        if (q1 > v1) { v1 = q1; i1 = 1; } if (q2 > v1) { v1 = q2; i1 = 2; } if (q3 > v1) { v1 = q3; i1 = 3; }
        int i2 = -1; float v2 = -1.f;
        if (i1 != 0 && q0 > v2) { v2 = q0; i2 = 0; } if (i1 != 1 && q1 > v2) { v2 = q1; i2 = 1; } if (i1 != 2 && q2 > v2) { v2 = q2; i2 = 2; } if (i1 != 3 && q3 > v2) { v2 = q3; i2 = 3; }
        const float inv = 1.0f / (v1 + v2);
        if (lane == 0) { const int e1 = 4 * gsel + i1, e2 = 4 * gsel + i2;
            const unsigned pos1 = __hip_atomic_fetch_add(lcnt + e1, 1u, __ATOMIC_RELAXED, __HIP_MEMORY_SCOPE_WORKGROUP);
            const unsigned pos2 = __hip_atomic_fetch_add(lcnt + e2, 1u, __ATOMIC_RELAXED, __HIP_MEMORY_SCOPE_WORKGROUP);
            TOKE[t] = (unsigned)e1 | ((unsigned)e2 << 8); TOKP[2 * t] = pos1; TOKP[2 * t + 1] = pos2; TOKW[2 * t] = v1 * inv; TOKW[2 * t + 1] = v2 * inv; }
    }
    __syncthreads();
    if (tid < NE) ((unsigned*)(ws + WS_SMALL + SM_WGCNT))[vcu * NE + tid] = lcnt[tid];
}

__device__ __forceinline__ void phase_moe_lists(unsigned char* ws, LAS unsigned char* lds, int tid, int lane, int gw, int NGW, int vcu, int G) {
    unsigned* ctl = (unsigned*)(ws + WS_CTL);
    LAS unsigned* off = (LAS unsigned*)lds;
    { const unsigned* WGCNT = (const unsigned*)(ws + WS_SMALL + SM_WGCNT);
      const int e = tid & 15, p = tid >> 4; unsigned tot = 0, pre = 0;
      for (int v = p; v < G; v += 32) { const unsigned c = WGCNT[v * NE + e]; tot += c; pre += (v < vcu) ? c : 0u; }
      off[128 + p * 16 + e] = tot; off[128 + 512 + p * 16 + e] = pre; }
    __syncthreads();
    if (tid < NE) { unsigned tot = 0, pre = 0; for (int p = 0; p < 32; ++p) { tot += off[128 + p * 16 + tid]; pre += off[128 + 512 + p * 16 + tid]; } off[32 + tid] = tot; off[48 + tid] = pre; }
    __syncthreads();
    if (tid == 0) { unsigned o = 0;
        for (int e = 0; e < NE; ++e) { const unsigned c = off[32 + e]; off[e] = o; off[64 + e] = o + off[48 + e]; o += (c + 255u) & ~255u; }
        off[16] = o; }
    __syncthreads();
    int* ROWINFO = (int*)(ws + WS_SMALL + SM_ROWINFO);
    if (blockIdx.x == 0) {
        if (tid == 0) ctl[CW_NTILES] = off[16] >> 8;
        if (tid < NE) { const unsigned t0 = off[tid] >> 8, t1 = off[tid + 1] >> 8; for (unsigned tt = t0; tt < t1; ++tt) ctl[CW_TILEE + tt] = (unsigned)tid; }
        for (int e = 0; e < NE; ++e) { const unsigned p0 = off[e] + off[32 + e], p1 = off[e + 1]; for (unsigned r = p0 + tid; r < p1; r += 512) ROWINFO[r] = -1; }
    }
    const bf16_t* XB = (const bf16_t*)(ws + WS_XB); bf16_t* XG = (bf16_t*)(ws + WS_XG);
    const unsigned* TOKE = (const unsigned*)(ws + WS_SMALL + SM_TOKE); const unsigned* TOKP = (const unsigned*)(ws + WS_SMALL + SM_TOKP);
    for (int t = gw; t < T; t += NGW) {
        const unsigned ee = TOKE[t]; const unsigned r1 = off[64 + (ee & 255u)] + TOKP[2 * t], r2 = off[64 + ((ee >> 8) & 255u)] + TOKP[2 * t + 1];
        const u32x4 v0 = *(const u32x4*)(XB + (size_t)t * D + 8 * lane), v1 = *(const u32x4*)(XB + (size_t)t * D + 512 + 8 * lane);
        *(u32x4*)(XG + (size_t)r1 * D + 8 * lane) = v0; *(u32x4*)(XG + (size_t)r1 * D + 512 + 8 * lane) = v1;
        *(u32x4*)(XG + (size_t)r2 * D + 8 * lane) = v0; *(u32x4*)(XG + (size_t)r2 * D + 512 + 8 * lane) = v1;
        if (lane == 0) { ROWINFO[r1] = 2 * t; ROWINFO[r2] = 2 * t + 1; }
    }
}

__device__ __forceinline__ void phase_ln2(ArgsP a, int l, unsigned char* ws, float* out, int lane, int gw, int NGW) {
    const float* X1 = (const float*)(ws + WS_X1); const bf16_t* O = (const bf16_t*)(ws + WS_O); unsigned char* X8 = ws + WS_XB;
    const float* TOKW = (const float*)(ws + WS_SMALL + SM_TOKW);
    f32x4 gv[4], bv[4];
#pragma unroll
    for (int j = 0; j < 4; ++j) { gv[j] = *(const f32x4*)(a->ln2_g + (size_t)l * D + 4 * lane + 256 * j); bv[j] = *(const f32x4*)(a->ln2_b + (size_t)l * D + 4 * lane + 256 * j); }
    for (int t = gw; t < T; t += NGW) {
        const float w1 = TOKW[2 * t], w2 = TOKW[2 * t + 1];
        f32x4 v[4]; float s = 0.f;
#pragma unroll
        for (int j = 0; j < 4; ++j) { const f32x4 x = *(const f32x4*)(X1 + (size_t)t * D + 4 * lane + 256 * j);
            const u32x2 o1 = *(const u32x2*)(O + (size_t)(2 * t) * D + 4 * lane + 256 * j), o2 = *(const u32x2*)(O + (size_t)(2 * t + 1) * D + 4 * lane + 256 * j);
            f32x4 mo; mo[0] = w1 * bflo(o1.x) + w2 * bflo(o2.x); mo[1] = w1 * bfhi(o1.x) + w2 * bfhi(o2.x); mo[2] = w1 * bflo(o1.y) + w2 * bflo(o2.y); mo[3] = w1 * bfhi(o1.y) + w2 * bfhi(o2.y);
            v[j] = x * DN_ALPHA + mo; s += (v[j][0] + v[j][1]) + (v[j][2] + v[j][3]); }
        const float mean = wave_sum(s) * (1.f / D); float s2 = 0.f;
#pragma unroll
        for (int j = 0; j < 4; ++j) { v[j] = v[j] - mean; s2 += (v[j][0] * v[j][0] + v[j][1] * v[j][1]) + (v[j][2] * v[j][2] + v[j][3] * v[j][3]); }
        const float rstd = 1.f / sqrtf(wave_sum(s2) * (1.f / D) + LN_EPS);
#pragma unroll
        for (int j = 0; j < 4; ++j) { v[j] = v[j] * rstd * gv[j] + bv[j];
            *(f32x4*)(out + (size_t)t * D + 4 * lane + 256 * j) = v[j];
            *(unsigned*)(X8 + (size_t)t * D + 4 * lane + 256 * j) = pk4_fp8(v[j][0], v[j][1], v[j][2], v[j][3]); }
    }
}

constexpr int STEPS_PER_LAYER = 5 * NCHUNK + 7;
constexpr int N_STEPS = 1 + DEPTH * STEPS_PER_LAYER;

__global__ void __launch_bounds__(512, 2) mk_fwd(Args args_by_value) {
    (void)args_by_value;
    extern __shared__ __attribute__((aligned(16))) unsigned char lds_raw[];
    LAS unsigned char* lds = (LAS unsigned char*)lds_raw;
    volatile LAS unsigned* MISC = (volatile LAS unsigned*)(lds + MISC_OFF);
    const int tid0 = threadIdx.x;
    const int G = gridDim.x; const int bx = blockIdx.x; const int vcu0 = (G % 8 == 0) ? (bx % 8) * (G / 8) + bx / 8 : bx;
    const int NGW = G * 8, nthr = G * 512;
    ArgsP ap0 = (ArgsP)__builtin_amdgcn_kernarg_segment_ptr();
    unsigned char* ws0 = ap0->ws;
    unsigned* ctl = (unsigned*)(ws0 + WS_CTL);
    for (int u = tid0; u < (LDS_BYTES - LDSCTL_OFF) / 4; u += 512) ((LAS unsigned*)(lds + LDSCTL_OFF))[u] = 0u;
    __syncthreads();
    XcdBarrier bar; bar.bar = ctl + CW_BAR; bar.x = 0; bar.st = nullptr;
    if (!MK_PER_STEP_LAUNCH) bar = xcd_barrier_post(ctl + CW_BAR, MISC + 8);
    const int lo = ap0->ph_lo, hi = ap0->ph_hi;
    int step = 0;
#ifndef MK_MASK
#define MK_MASK 0xFFFFFFFFu
#endif
#ifndef MK_REPEAT
#define MK_REPEAT 0u
#endif
#ifndef MK_BAR2
#define MK_BAR2 0
#endif
#define STEP_BEGIN(id) if (((MK_MASK >> (id)) & 1u) && lo <= step && step < hi) { for (int rep = 0; rep < 1 + (int)((MK_REPEAT >> (id)) & 1u); ++rep) { if (rep) __syncthreads(); unsigned char* ws = ws0; asm volatile("" : "+s"(ws)); ArgsP args = ap0; asm volatile("" : "+s"(args)); int tid = tid0; asm volatile("" : "+v"(tid)); int vcu = vcu0; asm volatile("" : "+s"(vcu)); \
    const int lane = tid & 63, wave = __builtin_amdgcn_readfirstlane(tid >> 6), gw = vcu * 8 + wave, gtid = vcu * 512 + tid; LAS float* scr = (LAS float*)(lds + wave * 16384); (void)lane; (void)gw; (void)gtid; (void)scr;
#define STEP_END   } if (step + 1 < hi) { if (MK_PER_STEP_LAUNCH) {} else { xcd_barrier(bar); if (MK_BAR2) xcd_barrier(bar); } } } ++step;

    STEP_BEGIN(0)
        prep_tm_weights(args, 0, ws, scr, gw, NGW, lane);
        cvt_x(args->x, ws + WS_XB, gtid, nthr);
    STEP_END

#pragma unroll 1
    for (int l = 0; l < DEPTH; ++l) {

#pragma unroll 1
        for (int half = 0; half < NCHUNK; ++half) {
            STEP_BEGIN(1)
                pg8::SchedPlain S{TH / 256, DIN / 256, G, bx, (const char*)(ws + WS_XB) + (size_t)half * TH * D, (const char*)(ws + WS_WIN), (size_t)256 * D, (size_t)256 * D, 0};
                pg8::EpiZ E{(bf16_t*)(ws + WS_Z), (bf16_t*)(ws + WS_GG), half * TH};
                pg8::gemm_phase<pg8::EpiZ, pg8::SchedPlain, true, -1, true>(lds, D, D, D, S, E, 0x7a7a7a7a);
            STEP_END
            STEP_BEGIN(2)
                phase_e1(args, l, half, ws, gtid, nthr);
            STEP_END
            STEP_BEGIN(3)
                pg8::SchedPlain S{TH / 256, NHEAD, G, bx, (const char*)(ws + WS_XC), (const char*)(ws + WS_WG), (size_t)256 * DR * 2, (size_t)256 * 128 * 2, (size_t)128 * 2};
                pg8::EpiRG E{(bf16_t*)(ws + WS_GT), (const bf16_t*)(ws + WS_XC), (const float*)(ws + WS_SMALL + SM_PCONST)};
                pg8::gemm_phase<pg8::EpiRG, pg8::SchedPlain, true>(lds, DR * 2, 128 * 2, 128 * 2, S, E);
            STEP_END
            STEP_BEGIN(4)
                phase_scan<false>(half, ws, gtid, nthr);
            STEP_END
            STEP_BEGIN(5)
                phase_scan<true>(half, ws, gtid, nthr);
            STEP_END
        }
        STEP_BEGIN(6)
            pg8::SchedPlain S{T / 256, D / 256, G, bx, (const char*)(ws + WS_U), (const char*)(ws + WS_WA), (size_t)256 * UC, (size_t)256 * UC, 0};
            pg8::EpiMix E{(const bf16_t*)(ws + WS_GG), (unsigned char*)(ws + WS_MERGED)};
            pg8::gemm_phase<pg8::EpiMix, pg8::SchedPlain, true, 8, true>(lds, UC, UC, UC, S, E, 0x79797979);
        STEP_END
        STEP_BEGIN(8)
            pg8::SchedPlain S{T / 256, D / 256, G, bx, (const char*)(ws + WS_MERGED), (const char*)(ws + WS_WO), (size_t)256 * D, (size_t)256 * D, 0};
            pg8::EpiY E{(l == 0) ? args->x : (const float*)args->out, (float*)(ws + WS_Y)};
            pg8::gemm_phase<pg8::EpiY, pg8::SchedPlain, true, -1, true>(lds, D, D, D, S, E, 0x77777777);
        STEP_END
        STEP_BEGIN(9)
            prep_expert_weights(args, l, ws, scr, gw, NGW, lane);
            __syncthreads();
            if (rep == 0) phase_ln1_router(args, l, ws, lds, tid, lane, gw, NGW, vcu);
        STEP_END
        STEP_BEGIN(10)
            phase_moe_lists(ws, lds, tid, lane, gw, NGW, vcu, G);
            __syncthreads();
            if (l + 1 < DEPTH) prep_tm_weights(args, l + 1, ws, scr, gw, NGW, lane);
        STEP_END
        STEP_BEGIN(11)
            const int ntiles = (int)__hip_atomic_load(ctl + CW_NTILES, __ATOMIC_RELAXED, __HIP_MEMORY_SCOPE_AGENT);
            pg8::SchedMoe S{ntiles, 4, G, bx, (const char*)(ws + WS_XG), (const char*)(ws + WS_WEX), (size_t)256 * D * 2, (size_t)256 * D * 2, (size_t)1024 * 1024 * 2, ctl + CW_TILEE};
            pg8::EpiH E{(bf16_t*)(ws + WS_H)};
            pg8::gemm_phase<pg8::EpiH, pg8::SchedMoe, true>(lds, D * 2, D * 2, D * 2, S, E);
        STEP_END
        STEP_BEGIN(12)
            const int ntiles = (int)__hip_atomic_load(ctl + CW_NTILES, __ATOMIC_RELAXED, __HIP_MEMORY_SCOPE_AGENT);
            pg8::SchedMoe S{ntiles, 4, G, bx, (const char*)(ws + WS_H), (const char*)(ws + WS_WEX) + (size_t)NE * 1024 * 1024 * 2, (size_t)256 * FF * 2, (size_t)256 * FF * 2, (size_t)1024 * 512 * 2, ctl + CW_TILEE};
            pg8::EpiO E{(bf16_t*)(ws + WS_O), (const int*)(ws + WS_SMALL + SM_ROWINFO)};
            pg8::gemm_phase<pg8::EpiO, pg8::SchedMoe, true>(lds, FF * 2, FF * 2, FF * 2, S, E);
        STEP_END
        STEP_BEGIN(13)
            phase_ln2(args, l, ws, args->out, lane, gw, NGW);
        STEP_END
    }
#undef STEP_BEGIN
#undef STEP_END
}

extern "C" void kernel_launch(void* const* d_in, const int* in_sizes, int n_in, void* d_out, int out_size, void* d_ws, size_t ws_size, hipStream_t stream) {
    static int grid = 0;
    if (grid == 0) {
        if (n_in != 22 || in_sizes[0] != T * D || out_size != T * D || ws_size < WS_NEED) {
            fprintf(stderr, "kernel_launch: unexpected shapes (n_in %d, in0 %d, out %d, ws %zu, need %zu); nothing launched\n", n_in, n_in > 0 ? in_sizes[0] : -1, out_size, ws_size, (size_t)WS_NEED); grid = -1; return; }
        int dev = 0, cus = 0, per_cu = 0;
        if (hipGetDevice(&dev) != hipSuccess || hipDeviceGetAttribute(&cus, hipDeviceAttributeMultiprocessorCount, dev) != hipSuccess) { grid = -1; return; }
        if (hipFuncSetAttribute((const void*)mk_fwd, hipFuncAttributeMaxDynamicSharedMemorySize, LDS_BYTES) != hipSuccess) { fprintf(stderr, "kernel_launch: hipFuncSetAttribute failed\n"); grid = -1; return; }
        if (hipOccupancyMaxActiveBlocksPerMultiprocessor(&per_cu, (const void*)mk_fwd, 512, LDS_BYTES) != hipSuccess || per_cu < 1) { fprintf(stderr, "kernel_launch: occupancy query says %d blocks per CU\n", per_cu); per_cu = 1; }
        (void)hipGetLastError();
        grid = cus;
    }
    if (grid < 0) return;
    (void)hipMemsetAsync((char*)d_ws + WS_CTL, 0, CTL_ZERO_BYTES, stream);
    Args a{};
    const float** p = (const float**)&a;
    for (int i = 0; i < 22; ++i) p[i] = (const float*)d_in[i];
    a.out = (float*)d_out; a.ws = (unsigned char*)d_ws;
#if MK_PER_STEP_LAUNCH
    for (int s = 0; s < N_STEPS; ++s) { a.ph_lo = s; a.ph_hi = s + 1; hipLaunchKernelGGL(mk_fwd, dim3(grid), dim3(512), LDS_BYTES, stream, a); }
#else
    a.ph_lo = 0; a.ph_hi = N_STEPS;
    hipLaunchKernelGGL(mk_fwd, dim3(grid), dim3(512), LDS_BYTES, stream, a);
#endif
}
```

```cpp
#include <hip/hip_runtime.h>
#include <cstdio>
#include <cstdint>

#ifndef MK_PER_STEP_LAUNCH
#define MK_PER_STEP_LAUNCH 0
#endif

#define LAS __attribute__((address_space(3)))
typedef unsigned short bf16_t;
typedef short bf16x8 __attribute__((ext_vector_type(8)));
typedef float f32x4 __attribute__((ext_vector_type(4)));
typedef float f32x2 __attribute__((ext_vector_type(2)));
typedef unsigned u32x4 __attribute__((ext_vector_type(4)));
typedef unsigned u32x2 __attribute__((ext_vector_type(2)));

constexpr int D = 1024, T = 16384, SEQ = 4096, NBATCH = 4, DR = 1280, NHEAD = 10, DIN = 7680, NE = 16, FF = 512, DEPTH = 2;
constexpr int NCHUNK = 1, TH = T / NCHUNK;
constexpr int ZC = 3328;
constexpr int GGC = 2048;
constexpr int SCH = 64, NSCH = SEQ / SCH;
constexpr int MOE_ROWS = 36864, MOE_TILES = MOE_ROWS / 256;
constexpr float LN_EPS = 1e-5f;
constexpr float DN_ALPHA = 1.4142135623730951f;

constexpr size_t MiB = 1u << 20;
constexpr size_t WS_CTL = 0, CTL_ZERO_BYTES = 128 * 1024;
constexpr size_t WS_WIN = 1 * MiB;
constexpr size_t WS_WA = 16 * MiB;
constexpr size_t WS_WO = 21 * MiB;
constexpr size_t WS_WG = 23 * MiB;
constexpr size_t WS_XB = 24 * MiB;
constexpr size_t WS_U = 56 * MiB;
constexpr int UC = 2304;
constexpr size_t WS_GG = 92 * MiB;
constexpr size_t WS_Z = 156 * MiB;
constexpr size_t WS_YR = 260 * MiB;
constexpr size_t WS_XC = 300 * MiB;
constexpr size_t WS_GT = 156 * MiB;
constexpr size_t WS_SMALL = 340 * MiB;
constexpr size_t WS_MERGED = 156 * MiB;
constexpr size_t WS_Y = 172 * MiB;
constexpr size_t WS_X1 = 92 * MiB;
constexpr size_t WS_WEX = 236 * MiB;
constexpr size_t WS_XG = 156 * MiB;
constexpr size_t WS_H = 284 * MiB;
constexpr size_t WS_O = 156 * MiB;
constexpr size_t WS_NEED = 344 * MiB + 512 * 1024;
constexpr size_t SM_AEND = 0;
constexpr size_t SM_HEND = SM_AEND + (size_t)NBATCH * NSCH * DR * 4;
constexpr size_t SM_TOKE = SM_HEND + (size_t)NBATCH * NSCH * DR * 4;
constexpr size_t SM_TOKP = SM_TOKE + (size_t)T * 4;
constexpr size_t SM_TOKW = SM_TOKP + (size_t)T * 8;
constexpr size_t SM_ROWINFO = SM_TOKW + (size_t)T * 8;
constexpr size_t SM_WGCNT = SM_ROWINFO + (size_t)MOE_ROWS * 4;
constexpr size_t SM_PCONST = SM_WGCNT + 256 * 16 * 4;
constexpr size_t SM_END = SM_PCONST + 3 * 1280 * 4;
static_assert(WS_SMALL + SM_END <= WS_NEED, "small region");
constexpr int CW_BAR = 4096;
constexpr int CW_CNT = 8192;
constexpr int CW_NTILES = 8256;
constexpr int CW_TILEE = 8320;

constexpr int RING_BYTES = 131072;
constexpr int LDSCTL_OFF = RING_BYTES, MISC_OFF = LDSCTL_OFF + 320;
constexpr int LDS_BYTES = 147456;

__device__ __forceinline__ unsigned cvt_pk_bf16(float lo, float hi) { unsigned r; asm volatile("v_cvt_pk_bf16_f32 %0, %1, %2" : "=v"(r) : "v"(lo), "v"(hi)); return r; }
__device__ __forceinline__ float bflo(unsigned w) { return __uint_as_float(w << 16); }
__device__ __forceinline__ float bfhi(unsigned w) { return __uint_as_float(w & 0xffff0000u); }
__device__ __forceinline__ float bf1(bf16_t b) { return __uint_as_float((unsigned)b << 16); }
__device__ __forceinline__ float fsigmoid(float x) { return __builtin_amdgcn_rcpf(1.0f + __builtin_amdgcn_exp2f(-1.4426950408889634f * x)); }
__device__ __forceinline__ float gelu_tanh(float y) { const float u = 1.5957691216057308f * (y + 0.044715f * y * y * y); return y * fsigmoid(u); }
__device__ __forceinline__ float lane_xor(float v, int mask, int lane) { return __builtin_bit_cast(float, __builtin_amdgcn_ds_bpermute((lane ^ mask) << 2, __builtin_bit_cast(int, v))); }
__device__ __forceinline__ float lane_get(float v, int src) { return __builtin_bit_cast(float, __builtin_amdgcn_ds_bpermute(src << 2, __builtin_bit_cast(int, v))); }
__device__ __forceinline__ float wave_sum(float v, int lane) {
#pragma unroll
    for (int o = 1; o < 64; o <<= 1) v += lane_xor(v, o, lane);
    return v;
}
typedef int v8i __attribute__((ext_vector_type(8)));
typedef int v4i __attribute__((ext_vector_type(4)));
__device__ __forceinline__ unsigned pk4_fp8(float a, float b, float c, float d) {
    a = __builtin_amdgcn_fmed3f(a, -448.f, 448.f); b = __builtin_amdgcn_fmed3f(b, -448.f, 448.f); c = __builtin_amdgcn_fmed3f(c, -448.f, 448.f); d = __builtin_amdgcn_fmed3f(d, -448.f, 448.f);
    int w = __builtin_amdgcn_cvt_pk_fp8_f32(a, b, 0, false); w = __builtin_amdgcn_cvt_pk_fp8_f32(c, d, w, true); return (unsigned)w; }
#ifndef MK_WT
#define MK_WT 0
#endif
__device__ __forceinline__ void st16(void* p, u32x4 v) {
#if MK_WT
    asm volatile("global_store_dwordx4 %0, %1, off sc1\n\ts_nop 1" :: "v"(p), "v"(v));
#else
    *(u32x4*)p = v;
#endif
}
__device__ __forceinline__ void st16f(void* p, f32x4 v) {
#if MK_WT
    asm volatile("global_store_dwordx4 %0, %1, off sc1\n\ts_nop 1" :: "v"(p), "v"(v));
#else
    *(f32x4*)p = v;
#endif
}
#define LDS_WAIT() asm volatile("s_waitcnt lgkmcnt(0)" ::: "memory")
#define VM_WAIT() asm volatile("s_waitcnt vmcnt(0)" ::: "memory")

namespace pg8 {
constexpr int BM = 256, BK = 64, HALF = 128, HTB = HALF * BK * 2, STAGE_BYTES = 8 * HTB, NXCD = 8, WGM = 8;
__host__ __device__ __forceinline__ int lds_byte(int r, int c) { const int st = (r >> 4) * 2 + (c >> 5), rr = r & 15, cc = c & 31, ob = rr * 64 + cc * 2; return st * 1024 + (ob ^ (((ob >> 9) & 1) << 5)); }
__host__ __device__ __forceinline__ void stage_rc(int b, int& R, int& C) { const int st = b / 1024, sb = b % 1024, swz = sb ^ (((sb >> 9) & 1) << 5); R = (st >> 1) * 16 + swz / 64; C = (st & 1) * 32 + (swz % 64) / 2; }
__host__ __device__ __forceinline__ int perm32(int rho) { const int n = rho >> 4, i = rho & 15; return 8 * (i >> 2) + 4 * n + (i & 3); }

struct Unit { const char* a; const char* b; int pm, pn; };

__device__ __forceinline__ bool static_order(int i, int G, int c, int nM, int nN, int& pm, int& pn) {
    const int nwg = nM * nN; const long L = (long)i * G + c; if (L >= nwg) return false;
    int wgid = (int)L; { const int q = nwg / NXCD, r = nwg % NXCD, xcd = wgid % NXCD, off = wgid / NXCD; wgid = (xcd < r ? xcd * (q + 1) : r * (q + 1) + (xcd - r) * q) + off; }
    const int nig = WGM * nN, gid = wgid / nig, fm = gid * WGM, gsz = (nM - fm) < WGM ? (nM - fm) : WGM;
    pm = fm + ((wgid % nig) % gsz); pn = (wgid % nig) / gsz; return true;
}
struct SchedPlain {
    int nM, nN, G, c; const char* A; const char* B; size_t a_tile, b_tile, a_pn;
    __device__ __forceinline__ bool next(int i, Unit& u) const {
        int pm, pn; if (!static_order(i, G, c, nM, nN, pm, pn)) return false;
        u.pm = pm; u.pn = pn; u.a = A + (size_t)pm * a_tile + (size_t)pn * a_pn; u.b = B + (size_t)pn * b_tile; return true;
    }
};
struct SchedMoe {
    int nM, nN, G, c; const char* A; const char* B; size_t a_tile, b_tile, b_exp; const unsigned* tile_e;
    __device__ __forceinline__ bool next(int i, Unit& u) const {
        int pm, pn; if (!static_order(i, G, c, nM, nN, pm, pn)) return false;
        const int e = __builtin_amdgcn_readfirstlane((int)__hip_atomic_load(tile_e + pm, __ATOMIC_RELAXED, __HIP_MEMORY_SCOPE_AGENT));
        u.pm = pm; u.pn = pn; u.a = A + (size_t)pm * a_tile; u.b = B + (size_t)e * b_exp + (size_t)pn * b_tile; return true;
    }
};

template <class Epi, class Sched, bool ALIGN_EPI, int HOOK_T = -1, bool FP8 = false>
__device__ __forceinline__ void gemm_phase(LAS unsigned char* lds, const int lda, const int ldb, const int K, const Sched& S, const Epi& E, const int tid_in, const int scale = 0x7f7f7f7f) {
    int tid = tid_in; asm volatile("" : "+v"(tid));
    const int wid = __builtin_amdgcn_readfirstlane(tid >> 6), lane = tid & 63, wr = wid >> 2, wc = wid & 3, fr = lane & 15, fq = lane >> 4;
    int Kop = K; asm volatile("" : "+s"(Kop));
    const int nt = Kop / 128;
    unsigned voffA[2], voffB[2];
#pragma unroll
    for (int i = 0; i < 2; ++i) { int R, C; stage_rc(tid * 16 + i * 8192, R, C); const int Rb = Epi::PERM ? ((R & ~31) + perm32(R & 31)) : R;
        voffA[i] = (unsigned)(R * lda + 2 * C); voffB[i] = (unsigned)(Rb * ldb + 2 * C); }
    const size_t kstep = (size_t)(BK * 2);
    const size_t hstepA = (size_t)HALF * lda, hstepB = (size_t)HALF * ldb;
    const unsigned ldsw = (unsigned)wid * 1024u;
    const int aoff = FP8 ? lds_byte(wr * 64 + fr, fq * 16) : lds_byte(wr * 64 + fr, fq * 8), boff = FP8 ? lds_byte(wc * 32 + fr, fq * 16) : lds_byte(wc * 32 + fr, fq * 8);
    const int f0 = FP8 ? ((fq >> 1) & 1) * 16 : 0, f1 = 16 - f0;
    const LAS unsigned char* pa0 = lds + aoff + f0; const LAS unsigned char* pa1 = lds + aoff + f1; const LAS unsigned char* pb0 = lds + 4 * HTB + boff + f0; const LAS unsigned char* pb1 = lds + 4 * HTB + boff + f1;
    (void)pa1; (void)pb1;
#define PG8_SA(b, h) (((b) * 2 + (h)) * HTB)
#define PG8_SB(b, h) ((4 + (b) * 2 + (h)) * HTB)
#define PG8_STAGE(bufoff, gbase, voff) do { _Pragma("unroll") for (int _i = 0; _i < 2; ++_i) \
        __builtin_amdgcn_global_load_lds((const unsigned*)((const char*)(gbase) + (voff)[_i]), (LAS unsigned*)(lds + (bufoff) + ldsw + _i * 8192), 16, 0, 0); } while (0)
#define PG8_LD8(dst, i_, p0_, p1_, off_) do { const v4i lo_ = *(const LAS v4i*)((p0_) + (off_)), hi_ = *(const LAS v4i*)((p1_) + (off_)); dst[i_] = __builtin_shufflevector(lo_, hi_, 0, 1, 2, 3, 4, 5, 6, 7); } while (0)
#define PG8_LDA(dst, b, h) do { if constexpr (FP8) { _Pragma("unroll") for (int m = 0; m < 4; ++m) PG8_LD8(dst##8, m, pa0, pa1, PG8_SA(b, h) + m * 2048); } \
        else { _Pragma("unroll") for (int m = 0; m < 4; ++m) _Pragma("unroll") for (int k = 0; k < 2; ++k) dst[m][k] = *(const LAS bf16x8*)(pa0 + PG8_SA(b, h) + m * 2048 + k * 1024); } } while (0)
#define PG8_LDB(dst, b, h) do { if constexpr (FP8) { _Pragma("unroll") for (int n = 0; n < 2; ++n) PG8_LD8(dst##8, n, pb0, pb1, PG8_SA(b, h) + n * 2048); } \
        else { _Pragma("unroll") for (int n = 0; n < 2; ++n) _Pragma("unroll") for (int k = 0; k < 2; ++k) dst[n][k] = *(const LAS bf16x8*)(pb0 + PG8_SA(b, h) + n * 2048 + k * 1024); } } while (0)
#define PG8_MMA(ai, bj, At, Bt) do { __builtin_amdgcn_s_setprio(1); _Pragma("unroll") for (int m = 0; m < 4; ++m) _Pragma("unroll") for (int n = 0; n < 2; ++n) { \
        if constexpr (FP8) asm volatile("v_mfma_scale_f32_16x16x128_f8f6f4 %0, %1, %2, %0, %3, %4 op_sel_hi:[0,0,0]" : "+v"(acc[ai][bj][m][n]) : "v"(Bt##8[n]), "v"(At##8[m]), "v"(scale_v), "v"(one_v)); \
        else { _Pragma("unroll") for (int k = 0; k < 2; ++k) acc[ai][bj][m][n] = __builtin_amdgcn_mfma_f32_16x16x32_bf16(Bt[n][k], At[m][k], acc[ai][bj][m][n], 0, 0, 0); } } \
        __builtin_amdgcn_s_setprio(0); } while (0)
#define PG8_WAIT_V(n) asm volatile("s_waitcnt vmcnt(" #n ")" ::: "memory")
#define PG8_WAIT_L(n) asm volatile("s_waitcnt lgkmcnt(" #n ")" ::: "memory")
#define PG8_BAR __builtin_amdgcn_s_barrier()
#define PG8_SCHED __builtin_amdgcn_sched_barrier(0)
    int scale_v = scale, one_v = 0x7f7f7f7f; asm volatile("" : "+v"(scale_v), "+v"(one_v));
    (void)scale_v; (void)one_v;
    Unit cur, nxt; int ui = 0;
    if (!S.next(0, cur)) return;
    f32x4 acc[2][2][4][2];
#pragma unroll
    for (int a = 0; a < 2; ++a)
#pragma unroll
        for (int b = 0; b < 2; ++b)
#pragma unroll
            for (int m = 0; m < 4; ++m)
#pragma unroll
                for (int n = 0; n < 2; ++n) acc[a][b][m][n] = (f32x4){0.f, 0.f, 0.f, 0.f};
    bf16x8 At[4][2], B0[2][2], B1[2][2];
    v8i At8[4], B08[2], B18[2];
    const char* cA = cur.a; const char* cB = cur.b;
    PG8_STAGE(PG8_SB(0, 0), cB, voffB); PG8_STAGE(PG8_SB(0, 1), cB + hstepB, voffB); PG8_STAGE(PG8_SA(0, 0), cA, voffA); PG8_STAGE(PG8_SA(0, 1), cA + hstepA, voffA);
    if (wr == 1) PG8_BAR;
    PG8_WAIT_V(2); PG8_BAR;
    PG8_STAGE(PG8_SB(1, 0), cB + kstep, voffB); PG8_STAGE(PG8_SA(1, 0), cA + kstep, voffA); PG8_STAGE(PG8_SB(1, 1), cB + hstepB + kstep, voffB);
    PG8_WAIT_V(6); PG8_BAR;
    for (;;) {
        const bool has_next = S.next(ui + 1, nxt);
        const char* nA = has_next ? nxt.a : cA; const char* nB = has_next ? nxt.b : cB;
        for (int t = 0; t < nt; t += 2) {
            const bool last = (t == nt - 2);
            if constexpr (HOOK_T >= 0) { if (t == HOOK_T) { if constexpr (FP8) asm volatile("s_nop 15\n\ts_nop 15" ::: "memory"); int fr2 = fr, fq2 = fq; asm volatile("" : "+v"(fr2), "+v"(fq2)); E.hook(acc, cur, wr, wc, fr2, fq2); } }
            const char* a1 = cA + (size_t)(t + 1) * kstep;
            const char* a2 = last ? nA : cA + (size_t)(t + 2) * kstep; const char* b2 = last ? nB : cB + (size_t)(t + 2) * kstep;
            const char* a3 = a2 + kstep; const char* b3 = b2 + kstep;
            PG8_LDB(B0, 0, 0); PG8_LDB(B1, 0, 1); PG8_SCHED; PG8_LDA(At, 0, 0); PG8_STAGE(PG8_SA(1, 1), a1 + hstepA, voffA);
            PG8_WAIT_V(8); PG8_WAIT_L(0); PG8_BAR; PG8_MMA(0, 0, At, B0); PG8_MMA(0, 1, At, B1); PG8_BAR; PG8_SCHED;
            PG8_LDA(At, 0, 1); PG8_STAGE(PG8_SB(0, 0), b2, voffB); PG8_STAGE(PG8_SB(0, 1), b2 + hstepB, voffB); PG8_STAGE(PG8_SA(0, 0), a2, voffA);
            PG8_WAIT_V(8); PG8_WAIT_L(0); PG8_BAR; PG8_MMA(1, 0, At, B0); PG8_MMA(1, 1, At, B1); PG8_BAR; PG8_SCHED;
            PG8_LDB(B0, 1, 0); PG8_LDB(B1, 1, 1); PG8_SCHED; PG8_LDA(At, 1, 0); PG8_STAGE(PG8_SA(0, 1), a2 + hstepA, voffA);
            PG8_WAIT_V(8); PG8_WAIT_L(0); PG8_BAR; PG8_MMA(0, 0, At, B0); PG8_MMA(0, 1, At, B1); PG8_BAR; PG8_SCHED;
            PG8_LDA(At, 1, 1); PG8_STAGE(PG8_SB(1, 0), b3, voffB); PG8_STAGE(PG8_SB(1, 1), b3 + hstepB, voffB); PG8_STAGE(PG8_SA(1, 0), a3, voffA);
            PG8_WAIT_V(8); PG8_WAIT_L(0); PG8_BAR; PG8_MMA(1, 0, At, B0); PG8_MMA(1, 1, At, B1); PG8_BAR; PG8_SCHED;
        }
        if constexpr (ALIGN_EPI) { if (wr == 0) PG8_BAR; }
        if constexpr (FP8) asm volatile("s_nop 15\n\ts_nop 15" ::: "memory");
        { int fr2 = fr, fq2 = fq; asm volatile("" : "+v"(fr2), "+v"(fq2));
          E(acc, cur, wr, wc, fr2, fq2); }
        if (!has_next) break;
#pragma unroll
        for (int a = 0; a < 2; ++a)
#pragma unroll
            for (int b = 0; b < 2; ++b)
#pragma unroll
                for (int m = 0; m < 4; ++m)
#pragma unroll
                    for (int n = 0; n < 2; ++n) acc[a][b][m][n] = (f32x4){0.f, 0.f, 0.f, 0.f};
        cur = nxt; cA = nA; cB = nB; ++ui;
        if constexpr (ALIGN_EPI) { if (wr == 1) PG8_BAR; }
    }
    PG8_WAIT_V(0);
    if constexpr (!ALIGN_EPI) { if (wr == 0) PG8_BAR; }
    PG8_BAR;
#undef PG8_SA
#undef PG8_SB
#undef PG8_STAGE
#undef PG8_LDA
#undef PG8_LDB
#undef PG8_MMA
#undef PG8_LD8
#undef PG8_WAIT_V
#undef PG8_WAIT_L
#undef PG8_BAR
#undef PG8_SCHED
}

typedef const f32x4 (&AccRef)[2][2][4][2];
typedef f32x4 (&AccMut)[2][2][4][2];
#define EPI_LOOP_ROWS for (int ai = 0; ai < 2; ++ai) _Pragma("unroll") for (int m = 0; m < 4; ++m)

struct EpiZ {
    static constexpr bool PERM = true;
    bf16_t* Z; bf16_t* GG; bf16_t* YR; int row_base;
    __device__ __forceinline__ void operator()(AccRef acc, const Unit& u, int wr, int wc, int fr, int fq) const {
        const int row0 = u.pm * BM + wr * 64 + fr;
        if (u.pn < 8) {
            bf16_t* base = Z + u.pn * HALF + wc * 32 + 8 * fq;
#pragma unroll
            EPI_LOOP_ROWS { const f32x4 h0 = acc[ai][0][m][0], h1 = acc[ai][0][m][1], c0 = acc[ai][1][m][0], c1 = acc[ai][1][m][1];
                u32x4 w; w.x = cvt_pk_bf16(h0[0] * c0[0], h0[1] * c0[1]); w.y = cvt_pk_bf16(h0[2] * c0[2], h0[3] * c0[3]); w.z = cvt_pk_bf16(h1[0] * c1[0], h1[1] * c1[1]); w.w = cvt_pk_bf16(h1[2] * c1[2], h1[3] * c1[3]);
                st16(base + (size_t)(row0 + ai * HALF + m * 16) * ZC, w); }
        } else {
            const int colt = u.pn * BM + wc * 32 + 8 * fq; const int act = u.pn < 17 ? 0 : (u.pn < 22 ? 1 : 2);
            bf16_t* base; size_t ldc;
            if (u.pn < 17) { base = Z + (colt - 1024); ldc = ZC; } else if (u.pn < 22) { base = YR + (colt - 4352); ldc = DR; } else { base = GG + (size_t)row_base * GGC + (colt - 5632); ldc = GGC; }
#pragma unroll
            EPI_LOOP_ROWS { bf16_t* rowp = base + (size_t)(row0 + ai * HALF + m * 16) * ldc;
#pragma unroll
                for (int bj = 0; bj < 2; ++bj) { f32x4 v0 = acc[ai][bj][m][0], v1 = acc[ai][bj][m][1];
                    if (act == 1) {
#pragma unroll
                        for (int j = 0; j < 4; ++j) { v0[j] = gelu_tanh(v0[j]); v1[j] = gelu_tanh(v1[j]); } }
                    else if (act == 2) {
#pragma unroll
                        for (int j = 0; j < 4; ++j) { v0[j] = fsigmoid(v0[j]); v1[j] = fsigmoid(v1[j]); } }
                    u32x4 w; w.x = cvt_pk_bf16(v0[0], v0[1]); w.y = cvt_pk_bf16(v0[2], v0[3]); w.z = cvt_pk_bf16(v1[0], v1[1]); w.w = cvt_pk_bf16(v1[2], v1[3]);
                    st16(rowp + bj * HALF, w); } }
        }
    }
};
struct EpiBf16 {
    static constexpr bool PERM = true;
    bf16_t* O; int ldc;
    __device__ __forceinline__ void operator()(AccRef acc, const Unit& u, int wr, int wc, int fr, int fq) const {
        const int row0 = u.pm * BM + wr * 64 + fr; const int colt = u.pn * BM + wc * 32 + 8 * fq;
#pragma unroll
        EPI_LOOP_ROWS { bf16_t* rowp = O + (size_t)(row0 + ai * HALF + m * 16) * ldc + colt;
#pragma unroll
            for (int bj = 0; bj < 2; ++bj) { const f32x4 v0 = acc[ai][bj][m][0], v1 = acc[ai][bj][m][1];
                u32x4 w; w.x = cvt_pk_bf16(v0[0], v0[1]); w.y = cvt_pk_bf16(v0[2], v0[3]); w.z = cvt_pk_bf16(v1[0], v1[1]); w.w = cvt_pk_bf16(v1[2], v1[3]);
                st16(rowp + bj * HALF, w); } }
    }
};
__device__ __forceinline__ float dpp_shr(float v, float ident, int s) {
    const int o = __builtin_bit_cast(int, ident), x = __builtin_bit_cast(int, v); int r;
    switch (s) { case 1: r = __builtin_amdgcn_update_dpp(o, x, 0x111, 0xf, 0xf, false); break; case 2: r = __builtin_amdgcn_update_dpp(o, x, 0x112, 0xf, 0xf, false); break;
                 case 4: r = __builtin_amdgcn_update_dpp(o, x, 0x114, 0xf, 0xf, false); break; default: r = __builtin_amdgcn_update_dpp(o, x, 0x118, 0xf, 0xf, false); break; }
    return __builtin_bit_cast(float, r);
}
struct EpiRG {
    static constexpr bool PERM = true;
    unsigned char* wsb; int half; const LAS unsigned* pcl;
    __device__ __forceinline__ void operator()(AccRef acc, const Unit& u, int wr, int wc, int fr, int fq) const {
        bf16_t* GT = (bf16_t*)(wsb + WS_GT); const bf16_t* XC = (const bf16_t*)(wsb + WS_XC);
        float* AEND = (float*)(wsb + WS_SMALL + SM_AEND); float* HEND = (float*)(wsb + WS_SMALL + SM_HEND);
        const int row0 = u.pm * BM + wr * 64 + fr; const int cc = wc * 32 + 8 * fq, ch = u.pn * HALF + cc;
#pragma unroll
        for (int ai = 0; ai < 2; ++ai) {
            int chl = ch; asm volatile("" : "+v"(chl));
            u32x4 xwv[4];
#pragma unroll
            for (int m = 0; m < 2; ++m) xwv[m] = *(const u32x4*)(XC + (size_t)(row0 + ai * HALF + m * 16) * DR + ch);
            float At[8], Ht[8];
#pragma unroll
            for (int k = 0; k < 8; ++k) { At[k] = 1.f; Ht[k] = 0.f; }
#pragma unroll
            for (int m = 0; m < 4; ++m) { const size_t r = (size_t)(row0 + ai * HALF + m * 16);
                const u32x4 xw = xwv[m];
                if (m < 2) { xwv[m + 2] = *(const u32x4*)(XC + (size_t)(row0 + ai * HALF + (m + 2) * 16) * DR + ch); asm volatile("" ::: "memory"); }
                float xc[8]; xc[0] = bflo(xw.x); xc[1] = bfhi(xw.x); xc[2] = bflo(xw.y); xc[3] = bfhi(xw.y); xc[4] = bflo(xw.z); xc[5] = bfhi(xw.z); xc[6] = bflo(xw.w); xc[7] = bfhi(xw.w);
#pragma unroll
                for (int n = 0; n < 2; ++n) {
                    float la[4], bb[4];
                    const u32x4 cb = *(const LAS u32x4*)(pcl + chl + 4 * n); const u32x2 xb2 = *(const LAS u32x2*)(pcl + DR + ((chl + 4 * n) >> 1));
#pragma unroll
                    for (int j = 0; j < 4; ++j) { const int k = 4 * n + j; const float rp = acc[ai][0][m][n][j], ip = acc[ai][1][m][n][j];
                        const float l = -bflo(cb[j]) * fsigmoid(rp + bfhi(cb[j])); const float x = 2.0f * l;
                        float em = -x * (1.0f + x * (0.5f + x * (0.16666667f + x * (0.041666668f + x * (0.0083333338f + x * 0.0013888889f)))));
                        la[j] = l; bb[j] = __builtin_amdgcn_sqrtf(em) * fsigmoid(ip + ((j & 1) ? bfhi(xb2[j >> 1]) : bflo(xb2[j >> 1]))) * xc[k]; }
                    u32x2 w0, w1; w0.x = cvt_pk_bf16(la[0], la[1]); w0.y = cvt_pk_bf16(la[2], la[3]); w1.x = cvt_pk_bf16(bb[0], bb[1]); w1.y = cvt_pk_bf16(bb[2], bb[3]);
                    *(u32x2*)(GT + r * 2560 + u.pn * BM + cc + 4 * n) = w0; *(u32x2*)(GT + r * 2560 + u.pn * BM + HALF + cc + 4 * n) = w1;
                    la[0] = bflo(w0.x); la[1] = bfhi(w0.x); la[2] = bflo(w0.y); la[3] = bfhi(w0.y); bb[0] = bflo(w1.x); bb[1] = bfhi(w1.x); bb[2] = bflo(w1.y); bb[3] = bfhi(w1.y);
#pragma unroll
                    for (int j = 0; j < 4; ++j) { const int k = 4 * n + j; float A = __builtin_amdgcn_exp2f(1.4426950408889634f * la[j]), H = bb[j];
#pragma unroll
                        for (int s = 1; s < 16; s <<= 1) { const float Al = dpp_shr(A, 1.f, s), Hl = dpp_shr(H, 0.f, s); H = A * Hl + H; A = A * Al; }
                        Ht[k] = A * Ht[k] + H; At[k] = At[k] * A; }
                    __builtin_amdgcn_sched_barrier(0);
                }
            }
            if (fr == 15) { const int rloc = u.pm * BM + ai * HALF + wr * 64;
                const int b = half * (TH / SEQ) + rloc / SEQ, j = (rloc % SEQ) / SCH; const size_t si = ((size_t)b * NSCH + j) * DR + ch;
                *(f32x4*)(AEND + si) = (f32x4){At[0], At[1], At[2], At[3]}; *(f32x4*)(AEND + si + 4) = (f32x4){At[4], At[5], At[6], At[7]};
                *(f32x4*)(HEND + si) = (f32x4){Ht[0], Ht[1], Ht[2], Ht[3]}; *(f32x4*)(HEND + si + 4) = (f32x4){Ht[4], Ht[5], Ht[6], Ht[7]}; }
            asm volatile("" ::: "memory");
        }
    }
};
struct EpiMix {
    static constexpr bool PERM = true;
    const bf16_t* GG; unsigned char* MG;
    __device__ __forceinline__ void hook(AccMut acc, const Unit& u, int wr, int wc, int fr, int fq) const {
        const int row0 = u.pm * BM + wr * 64 + fr;
        const int colt = u.pn * BM + wc * 32 + 8 * fq;
#pragma unroll
        EPI_LOOP_ROWS { const size_t r = (size_t)(row0 + ai * HALF + m * 16);
#pragma unroll
            for (int bj = 0; bj < 2; ++bj) { const int c = colt + bj * HALF; const u32x4 ga = *(const u32x4*)(GG + r * GGC + c), gr = *(const u32x4*)(GG + r * GGC + D + c);
                f32x4 q0, q1;
                q0[0] = bflo(ga.x) * __builtin_amdgcn_rcpf(bflo(gr.x)); q0[1] = bfhi(ga.x) * __builtin_amdgcn_rcpf(bfhi(gr.x)); q0[2] = bflo(ga.y) * __builtin_amdgcn_rcpf(bflo(gr.y)); q0[3] = bfhi(ga.y) * __builtin_amdgcn_rcpf(bfhi(gr.y));
                q1[0] = bflo(ga.z) * __builtin_amdgcn_rcpf(bflo(gr.z)); q1[1] = bfhi(ga.z) * __builtin_amdgcn_rcpf(bfhi(gr.z)); q1[2] = bflo(ga.w) * __builtin_amdgcn_rcpf(bflo(gr.w)); q1[3] = bfhi(ga.w) * __builtin_amdgcn_rcpf(bfhi(gr.w));
                acc[ai][bj][m][0] *= q0; acc[ai][bj][m][1] *= q1; }
            asm volatile("" ::: "memory"); }
    }
    __device__ __forceinline__ void operator()(AccRef acc, const Unit& u, int wr, int wc, int fr, int fq) const {
        const int row0 = u.pm * BM + wr * 64 + fr; const int colt = u.pn * BM + wc * 32 + 8 * fq;
#pragma unroll
        EPI_LOOP_ROWS { const size_t r = (size_t)(row0 + ai * HALF + m * 16);
#pragma unroll
            for (int bj = 0; bj < 2; ++bj) { const int c = colt + bj * HALF; const u32x4 g = *(const u32x4*)(GG + r * GGC + D + c);
                const f32x4 v0 = acc[ai][bj][m][0], v1 = acc[ai][bj][m][1];
                u32x2 w; w.x = pk4_fp8(4.f * bflo(g.x) * v0[0], 4.f * bfhi(g.x) * v0[1], 4.f * bflo(g.y) * v0[2], 4.f * bfhi(g.y) * v0[3]);
                w.y = pk4_fp8(4.f * bflo(g.z) * v1[0], 4.f * bfhi(g.z) * v1[1], 4.f * bflo(g.w) * v1[2], 4.f * bfhi(g.w) * v1[3]);
                *(u32x2*)(MG + r * D + c) = w; }
            asm volatile("" ::: "memory"); }
    }
};
struct EpiY {
    static constexpr bool PERM = false;
    const float* X0; float* Y;
    __device__ __forceinline__ void operator()(AccRef acc, const Unit& u, int wr, int wc, int fr, int fq) const {
        const int row0 = u.pm * BM + wr * 64 + fr, col0 = u.pn * BM + wc * 32 + 4 * fq;
#pragma unroll
        EPI_LOOP_ROWS { const size_t r = (size_t)(row0 + ai * HALF + m * 16);
#pragma unroll
            for (int bj = 0; bj < 2; ++bj)
#pragma unroll
                for (int n = 0; n < 2; ++n) { const int c = col0 + bj * HALF + n * 16; const f32x4 x = *(const f32x4*)(X0 + r * D + c);
                    st16f(Y + r * D + c, x * DN_ALPHA + acc[ai][bj][m][n]); }
            asm volatile("" ::: "memory"); }
    }
};
struct EpiH {
    static constexpr bool PERM = true;
    bf16_t* H;
    __device__ __forceinline__ void operator()(AccRef acc, const Unit& u, int wr, int wc, int fr, int fq) const {
        const int row0 = u.pm * BM + wr * 64 + fr; const int col = u.pn * HALF + wc * 32 + 8 * fq;
#pragma unroll
        EPI_LOOP_ROWS { const size_t r = (size_t)(row0 + ai * HALF + m * 16);
            const f32x4 g0 = acc[ai][0][m][0], g1 = acc[ai][0][m][1], u0 = acc[ai][1][m][0], u1 = acc[ai][1][m][1];
            u32x4 w;
            w.x = cvt_pk_bf16(g0[0] * fsigmoid(g0[0]) * u0[0], g0[1] * fsigmoid(g0[1]) * u0[1]);
            w.y = cvt_pk_bf16(g0[2] * fsigmoid(g0[2]) * u0[2], g0[3] * fsigmoid(g0[3]) * u0[3]);
            w.z = cvt_pk_bf16(g1[0] * fsigmoid(g1[0]) * u1[0], g1[1] * fsigmoid(g1[1]) * u1[1]);
            w.w = cvt_pk_bf16(g1[2] * fsigmoid(g1[2]) * u1[2], g1[3] * fsigmoid(g1[3]) * u1[3]);
            st16(H + r * FF + col, w); }
    }
};
struct EpiO {
    static constexpr bool PERM = true;
    bf16_t* O; const int* rowinfo;
    __device__ __forceinline__ void operator()(AccRef acc, const Unit& u, int wr, int wc, int fr, int fq) const {
        const int row0 = u.pm * BM + wr * 64 + fr; const int colt = u.pn * BM + wc * 32 + 8 * fq;
#pragma unroll
        EPI_LOOP_ROWS { const int dst = rowinfo[row0 + ai * HALF + m * 16];
            if (dst >= 0) { bf16_t* rowp = O + (size_t)dst * D + colt;
#pragma unroll
                for (int bj = 0; bj < 2; ++bj) { const f32x4 v0 = acc[ai][bj][m][0], v1 = acc[ai][bj][m][1];
                    u32x4 w; w.x = cvt_pk_bf16(v0[0], v0[1]); w.y = cvt_pk_bf16(v0[2], v0[3]); w.z = cvt_pk_bf16(v1[0], v1[1]); w.w = cvt_pk_bf16(v1[2], v1[3]);
                    st16(rowp + bj * HALF, w); } } }
    }
};
}

#define XB_TMO      128
#define XB_XCNT(j)  (256  + 64 * (j))
#define XB_XSUB(j)  (1280 + 64 * (j))
#define XB_XGEN(j)  (2304 + 64 * (j))
#define XB_TOP      3328
#define XB_TOPGEN   3392
#define XCD_BAR_WORDS 3456
#define XB_SPIN_CAP (1u << 18)
__device__ __forceinline__ unsigned xb_ld(unsigned* p)              { return __hip_atomic_load(p, __ATOMIC_RELAXED, __HIP_MEMORY_SCOPE_AGENT); }
__device__ __forceinline__ unsigned xb_add(unsigned* p, unsigned v) { return __hip_atomic_fetch_add(p, v, __ATOMIC_RELAXED, __HIP_MEMORY_SCOPE_AGENT); }
__device__ __forceinline__ unsigned xb_xcc_id() { return (unsigned)__builtin_amdgcn_s_getreg((3 << 11) | 20) & 0xFu; }
#define XB_SPIN(cond, bar) do { unsigned _sp = 0; while (cond) { __builtin_amdgcn_s_sleep(1); \
    if ((++_sp & 255u) == 0u) { if (xb_ld(&(bar)[XB_TMO])) break; if (_sp > XB_SPIN_CAP) { atomicAdd(&(bar)[XB_TMO], 1u); break; } } } } while (0)
struct XcdBarrier { unsigned* bar; unsigned x; volatile LAS unsigned* st; };
__device__ __forceinline__ XcdBarrier xcd_barrier_post(unsigned* bar, volatile LAS unsigned* st) {
    XcdBarrier b; b.bar = bar; b.x = xb_xcc_id(); b.st = st;
    if (threadIdx.x == 0) (void)xb_add(&bar[XB_XCNT(b.x)], 1u);
    return b;
}
__device__ __forceinline__ void xcd_barrier_complete(unsigned* bar, unsigned x, unsigned& nloc, unsigned& nx) {
    const unsigned G = gridDim.x * gridDim.y * gridDim.z;
    unsigned sum, cnt, mine, sp = 0u;
    for (;;) {
        sum = 0u; cnt = 0u; mine = 0u;
#pragma unroll
        for (unsigned j = 0; j < 16; ++j) { const unsigned c = xb_ld(&bar[XB_XCNT(j)]); sum += c; cnt += (c > 0u) ? 1u : 0u; mine = (j == x) ? c : mine; }
        if (sum == G) break;
        __builtin_amdgcn_s_sleep(1);
        if ((++sp & 255u) == 0u) { if (xb_ld(&bar[XB_TMO])) break; if (sp > XB_SPIN_CAP) { atomicAdd(&bar[XB_TMO], 1u); break; } }
    }
    nloc = mine > 0u ? mine : 1u; nx = cnt > 0u ? cnt : 1u;
}
__device__ __forceinline__ void xcd_barrier(const XcdBarrier& b) {
    asm volatile("s_waitcnt vmcnt(0)" ::: "memory");
    __syncthreads();
    if (threadIdx.x == 0) {
        unsigned* bar = b.bar;
        __builtin_amdgcn_s_waitcnt(0);
        unsigned nloc = b.st[0], nx = b.st[1];
        if (nloc == 0u) { xcd_barrier_complete(bar, b.x, nloc, nx); b.st[0] = nloc; b.st[1] = nx; }
        const unsigned old = xb_add(&bar[XB_XSUB(b.x)], 1u);
        const unsigned gen = old / nloc;
        if (old + 1u == (gen + 1u) * nloc) {
            __builtin_amdgcn_fence(__ATOMIC_RELEASE, "agent");
            asm volatile("s_waitcnt vmcnt(0)" ::: "memory");
            const unsigned og = xb_add(&bar[XB_TOP], 1u);
            const unsigned tg = og / nx;
            if (og + 1u == (tg + 1u) * nx) xb_add(&bar[XB_TOPGEN], 1u);
            else XB_SPIN(xb_ld(&bar[XB_TOPGEN]) == tg, bar);
            __builtin_amdgcn_fence(__ATOMIC_ACQUIRE, "agent");
            xb_add(&bar[XB_XGEN(b.x)], 1u);
            asm volatile("s_waitcnt vmcnt(0)" ::: "memory");
        } else {
            XB_SPIN(xb_ld(&bar[XB_XGEN(b.x)]) == gen, bar);
            __builtin_amdgcn_fence(__ATOMIC_ACQUIRE, "agent");
            asm volatile("s_waitcnt vmcnt(0)" ::: "memory");
        }
    }
    __syncthreads();
}

struct Args {
    const float* x; const float* w_in; const float* conv_a_w; const float* w_branch_a; const float* conv_r_w; const float* conv_r_b;
    const float* w_rg_a; const float* b_rg_a; const float* w_rg_x; const float* b_rg_x; const float* rg_lambda; const float* w_branch_r; const float* w_out;
    const float* ln1_g; const float* ln1_b; const float* w_router; const float* b_router; const float* w_exp_gate; const float* w_exp_up; const float* w_exp_down;
    const float* ln2_g; const float* ln2_b;
    float* out; unsigned char* ws; int ph_lo, ph_hi;
};

typedef const Args __attribute__((address_space(4)))* ArgsP;

__device__ __forceinline__ void transpose_item(const float* W, int N, int k0, int n0, bf16_t* WT, int ldk, int drow0, LAS float* scr, int lane) {
    float tv[32];
    { const float* wp = W + (size_t)(k0 + (lane >> 5)) * N + n0 + (lane & 31);
#pragma unroll
      for (int i = 0; i < 32; ++i) tv[i] = wp[(size_t)(2 * i) * N]; }
#pragma unroll
    for (int i = 0; i < 32; ++i) scr[(2 * i + (lane >> 5)) * 33 + (lane & 31)] = tv[i];
    LDS_WAIT(); asm volatile("" ::: "memory");
    const int c = lane & 7;
#pragma unroll
    for (int j = 0; j < 4; ++j) { const int n = (lane >> 3) + 8 * j; const LAS float* s = scr + (8 * c) * 33 + n;
        u32x4 o; o.x = cvt_pk_bf16(s[0 * 33], s[1 * 33]); o.y = cvt_pk_bf16(s[2 * 33], s[3 * 33]); o.z = cvt_pk_bf16(s[4 * 33], s[5 * 33]); o.w = cvt_pk_bf16(s[6 * 33], s[7 * 33]);
        st16(WT + (size_t)(drow0 + n) * ldk + k0 + 8 * c, o); }
    LDS_WAIT(); asm volatile("" ::: "memory");
}
__device__ __forceinline__ void transpose_item8(const float* W, int N, int k0, int n0, unsigned char* WT, int ldk, int drow0, float sc, LAS float* scr, int lane) {
    float tv[32];
    { const float* wp = W + (size_t)(k0 + (lane >> 5)) * N + n0 + (lane & 31);
#pragma unroll
      for (int i = 0; i < 32; ++i) tv[i] = wp[(size_t)(2 * i) * N]; }
#pragma unroll
    for (int i = 0; i < 32; ++i) scr[(2 * i + (lane >> 5)) * 33 + (lane & 31)] = tv[i];
    LDS_WAIT(); asm volatile("" ::: "memory");
    const int c = lane & 7;
#pragma unroll
    for (int j = 0; j < 4; ++j) { const int n = (lane >> 3) + 8 * j; const LAS float* s = scr + (8 * c) * 33 + n;
        u32x2 o; o.x = pk4_fp8(sc * s[0 * 33], sc * s[1 * 33], sc * s[2 * 33], sc * s[3 * 33]); o.y = pk4_fp8(sc * s[4 * 33], sc * s[5 * 33], sc * s[6 * 33], sc * s[7 * 33]);
        *(u32x2*)(WT + (size_t)(drow0 + n) * ldk + k0 + 8 * c) = o; }
    LDS_WAIT(); asm volatile("" ::: "memory");
}
__device__ __forceinline__ void transpose_plain(const float* W, int K, int N, bf16_t* WT, int item, LAS float* scr, int lane) {
    const int nblk = N / 32, kb = item / nblk, nb = item % nblk;
    transpose_item(W, N, 64 * kb, 32 * nb, WT, K, 32 * nb, scr, lane);
}

__device__ __forceinline__ void prep_tm_weights(ArgsP a, int l, unsigned char* ws, LAS float* scr, int gw, int NGW, int lane) {
    constexpr int I_IN = (D / 64) * (DIN / 32), I_A = (D / 64) * (D / 32), I_R = (DR / 64) * (D / 32), I_O = I_A, I_G = 2 * NHEAD * 2 * 4;
    constexpr int NITEMS = I_IN + I_A + I_R + I_O + I_G;
    if (gw < 20) { const int c = gw * 64 + lane; float* PC = (float*)(ws + WS_SMALL + SM_PCONST);
        PC[c] = 8.0f * log1pf(__expf(-a->rg_lambda[(size_t)l * DR + c])); PC[DR + c] = a->b_rg_a[(size_t)l * DR + c]; PC[2 * DR + c] = a->b_rg_x[(size_t)l * DR + c]; }
    for (int it = gw; it < NITEMS; it += NGW) {
        int r = it;
        if (r < I_IN) { const int nblk = DIN / 32, kb = r / nblk, n0 = 32 * (r % nblk);
            const int drow0 = n0 < 1024 ? (n0 >> 7) * 256 + (n0 & 127) : (n0 < 2048 ? n0 + 1024 : (n0 < 3072 ? ((n0 - 2048) >> 7) * 256 + 128 + (n0 & 127) : n0));
            transpose_item8(a->w_in + (size_t)l * D * DIN, DIN, 64 * kb, n0, ws + WS_WIN, D, drow0, 32.f, scr, lane); continue; } r -= I_IN;
        if (r < I_A) { const int kb = r / (D / 32), nb = r % (D / 32); transpose_item8(a->w_branch_a + (size_t)l * D * D, D, 64 * kb, 32 * nb, ws + WS_WA, UC, 32 * nb, 64.f, scr, lane); continue; } r -= I_A;
        if (r < I_R) { const int kb = r / (D / 32), nb = r % (D / 32); transpose_item8(a->w_branch_r + (size_t)l * DR * D, D, 64 * kb, 32 * nb, ws + WS_WA + D, UC, 32 * nb, 16.f, scr, lane); continue; } r -= I_R;
        if (r < I_O) { const int kb = r / (D / 32), nb = r % (D / 32); transpose_item8(a->w_out + (size_t)l * D * D, D, 64 * kb, 32 * nb, ws + WS_WO, D, 32 * nb, 64.f, scr, lane); continue; } r -= I_O;
        {
            const int nb = r & 3, kb = (r >> 2) & 1, hw = r >> 3, which = hw & 1, hh = hw >> 1;
            const float* W = (which ? a->w_rg_x : a->w_rg_a) + ((size_t)l * NHEAD + hh) * 128 * 128;
            transpose_item(W, 128, 64 * kb, 32 * nb, (bf16_t*)(ws + WS_WG), 128, hh * 256 + which * 128 + 32 * nb, scr, lane);
        }
    }
}
__device__ __forceinline__ void prep_expert_weights(ArgsP a, int l, unsigned char* ws, LAS float* scr, int gw, int NGW, int lane) {
    constexpr int I_G = (D / 64) * (FF / 32), I_D = (FF / 64) * (D / 32), PER_E = 2 * I_G + I_D;
    bf16_t* WGU = (bf16_t*)(ws + WS_WEX); bf16_t* WDN = WGU + (size_t)NE * 1024 * 1024;
    for (int it = gw; it < NE * PER_E; it += NGW) {
        const int e = it / PER_E; int r = it % PER_E;
        if (r < 2 * I_G) { const int which = r / I_G; r %= I_G; const int nblk = FF / 32, kb = r / nblk, nb = r % nblk, n0 = 32 * nb;
            const float* W = (which ? a->w_exp_up : a->w_exp_gate) + ((size_t)l * NE + e) * D * FF;
            const int drow0 = (n0 >> 7) * 256 + which * 128 + (n0 & 127);
            transpose_item(W, FF, 64 * kb, n0, WGU + (size_t)e * 1024 * 1024, D, drow0, scr, lane);
        } else { r -= 2 * I_G; const float* W = a->w_exp_down + ((size_t)l * NE + e) * FF * D;
            transpose_plain(W, FF, D, WDN + (size_t)e * 1024 * 512, r, scr, lane); }
    }
}
__device__ __forceinline__ void cvt_x(const float* x, unsigned char* xb, int gtid, int nthr) {
    for (size_t i = gtid; i < (size_t)T * D / 8; i += (size_t)4 * nthr) {
        f32x4 a[4], b[4];
#pragma unroll
        for (int k = 0; k < 4; ++k) { a[k] = *(const f32x4*)(x + (i + (size_t)k * nthr) * 8); b[k] = *(const f32x4*)(x + (i + (size_t)k * nthr) * 8 + 4); }
#pragma unroll
        for (int k = 0; k < 4; ++k) { u32x2 w; w.x = pk4_fp8(a[k][0], a[k][1], a[k][2], a[k][3]); w.y = pk4_fp8(b[k][0], b[k][1], b[k][2], b[k][3]); *(u32x2*)(xb + (i + (size_t)k * nthr) * 8) = w; } }
}
__device__ __forceinline__ void unpack8(const u32x4 w, float (&f)[8]) { f[0] = bflo(w.x); f[1] = bfhi(w.x); f[2] = bflo(w.y); f[3] = bfhi(w.y); f[4] = bflo(w.z); f[5] = bfhi(w.z); f[6] = bflo(w.w); f[7] = bfhi(w.w); }
__device__ __forceinline__ u32x4 pack8(const float (&f)[8]) { u32x4 w; w.x = cvt_pk_bf16(f[0], f[1]); w.y = cvt_pk_bf16(f[2], f[3]); w.z = cvt_pk_bf16(f[4], f[5]); w.w = cvt_pk_bf16(f[6], f[7]); return w; }

__device__ __forceinline__ void phase_e1(ArgsP a, int l, int half, unsigned char* ws, int gtid, int nthr) {
    const bf16_t* Z = (const bf16_t*)(ws + WS_Z); unsigned char* UA = ws + WS_U + (size_t)half * TH * UC; bf16_t* XC = (bf16_t*)(ws + WS_XC);
    constexpr int RUN = 8;
    constexpr int NA = (TH / RUN) * (D / 8), NR = (TH / RUN) * (DR / 8);
    for (int it = gtid; it < NA + NR; it += nthr) {
        if (it < NA) {
            const int cg = it % (D / 8), run = it / (D / 8), t0 = run * RUN, c0 = cg * 8;
            const bool first = (t0 & (SEQ - 1)) == 0;
            u32x4 vv[RUN + 2], bw[RUN];
            vv[0] = first ? (u32x4){0u, 0u, 0u, 0u} : *(const u32x4*)(Z + (size_t)(t0 - 2) * ZC + c0);
            vv[1] = first ? (u32x4){0u, 0u, 0u, 0u} : *(const u32x4*)(Z + (size_t)(t0 - 1) * ZC + c0);
#pragma unroll
            for (int i = 0; i < RUN; ++i) { vv[i + 2] = *(const u32x4*)(Z + (size_t)(t0 + i) * ZC + c0); bw[i] = *(const u32x4*)(Z + (size_t)(t0 + i) * ZC + D + c0); }
            float w0[8], w1[8], w2[8];
            { const float* cw = a->conv_a_w + (size_t)l * 3 * D + c0;
#pragma unroll
              for (int j = 0; j < 8; ++j) { w0[j] = cw[j]; w1[j] = cw[D + j]; w2[j] = cw[2 * D + j]; } }
            float vm2[8], vm1[8]; unpack8(vv[0], vm2); unpack8(vv[1], vm1);
#pragma unroll
            for (int i = 0; i < RUN; ++i) { float v[8], bb[8], o[8]; unpack8(vv[i + 2], v); unpack8(bw[i], bb);
#pragma unroll
                for (int j = 0; j < 8; ++j) { o[j] = bb[j] * (w0[j] * vm2[j] + w1[j] * vm1[j] + w2[j] * v[j]); vm2[j] = vm1[j]; vm1[j] = v[j]; }
                u32x2 w8; w8.x = pk4_fp8(o[0], o[1], o[2], o[3]); w8.y = pk4_fp8(o[4], o[5], o[6], o[7]); *(u32x2*)(UA + (size_t)(t0 + i) * UC + c0) = w8; }
        } else {
            const int r = it - NA; const int cg = r % (DR / 8), run = r / (DR / 8), t0 = run * RUN, c0 = cg * 8;
            const bool first = (t0 & (SEQ - 1)) == 0;
            u32x4 xv[RUN + 3];
#pragma unroll
            for (int i = 0; i < 3; ++i) xv[i] = first ? (u32x4){0u, 0u, 0u, 0u} : *(const u32x4*)(Z + (size_t)(t0 - 3 + i) * ZC + 2 * D + c0);
#pragma unroll
            for (int i = 0; i < RUN; ++i) xv[i + 3] = *(const u32x4*)(Z + (size_t)(t0 + i) * ZC + 2 * D + c0);
            float w0[8], w1[8], w2[8], w3[8], bi[8];
            { const float* cw = a->conv_r_w + (size_t)l * 4 * DR + c0; const float* cb = a->conv_r_b + (size_t)l * DR + c0;
#pragma unroll
              for (int j = 0; j < 8; ++j) { w0[j] = cw[j]; w1[j] = cw[DR + j]; w2[j] = cw[2 * DR + j]; w3[j] = cw[3 * DR + j]; bi[j] = cb[j]; } }
            float x3[8], x2[8], x1[8]; unpack8(xv[0], x3); unpack8(xv[1], x2); unpack8(xv[2], x1);
#pragma unroll
            for (int i = 0; i < RUN; ++i) { float x0[8], o[8]; unpack8(xv[i + 3], x0);
#pragma unroll
                for (int j = 0; j < 8; ++j) { o[j] = w0[j] * x3[j] + w1[j] * x2[j] + w2[j] * x1[j] + w3[j] * x0[j] + bi[j]; x3[j] = x2[j]; x2[j] = x1[j]; x1[j] = x0[j]; }
                st16(XC + (size_t)(t0 + i) * DR + c0, pack8(o)); }
        }
    }
}

__device__ __forceinline__ void phase_scan(unsigned char* ws, int gtid, int nthr) {
    const bf16_t* GT = (const bf16_t*)(ws + WS_GT); const bf16_t* YR = (const bf16_t*)(ws + WS_YR);
    const float* AEND = (const float*)(ws + WS_SMALL + SM_AEND); const float* HEND = (const float*)(ws + WS_SMALL + SM_HEND);
    unsigned char* UR = ws + WS_U + D;
    constexpr int NP = DR / 4, NITEMS = NBATCH * NSCH * NP, BT = 16;
    for (int it = gtid; it < NITEMS; it += nthr) {
        const int cp = it % NP, j = (it / NP) % NSCH, b = it / (NP * NSCH), c = 4 * cp, hh = c >> 7, cc = c & 127;
        f32x4 h = (f32x4){0.f, 0.f, 0.f, 0.f};
        { const size_t sb = (size_t)b * NSCH * DR + c; int jj = 0;
          for (; jj + 8 <= j; jj += 8) { f32x4 ae[8], he[8];
#pragma unroll
              for (int k = 0; k < 8; ++k) { ae[k] = *(const f32x4*)(AEND + sb + (size_t)(jj + k) * DR); he[k] = *(const f32x4*)(HEND + sb + (size_t)(jj + k) * DR); }
#pragma unroll
              for (int k = 0; k < 8; ++k) h = ae[k] * h + he[k]; }
          for (; jj < j; ++jj) { const f32x4 ae = *(const f32x4*)(AEND + sb + (size_t)jj * DR), he = *(const f32x4*)(HEND + sb + (size_t)jj * DR); h = ae * h + he; } }
        const size_t row0 = (size_t)b * SEQ + (size_t)j * SCH;
        const bf16_t* gl = GT + row0 * 2560 + hh * 256 + cc; const bf16_t* zy = YR + row0 * DR + c; unsigned char* ur = UR + row0 * UC + c;
#pragma unroll 1
        for (int t0 = 0; t0 < SCH; t0 += BT) {
            u32x2 lw[BT], bw[BT], yw[BT];
#pragma unroll
            for (int k = 0; k < BT; ++k) { lw[k] = *(const u32x2*)(gl + (size_t)(t0 + k) * 2560); bw[k] = *(const u32x2*)(gl + (size_t)(t0 + k) * 2560 + 128); yw[k] = *(const u32x2*)(zy + (size_t)(t0 + k) * DR); }
#pragma unroll
            for (int k = 0; k < BT; ++k) {
                h[0] = __builtin_amdgcn_exp2f(1.4426950408889634f * bflo(lw[k].x)) * h[0] + bflo(bw[k].x); h[1] = __builtin_amdgcn_exp2f(1.4426950408889634f * bfhi(lw[k].x)) * h[1] + bfhi(bw[k].x);
                h[2] = __builtin_amdgcn_exp2f(1.4426950408889634f * bflo(lw[k].y)) * h[2] + bflo(bw[k].y); h[3] = __builtin_amdgcn_exp2f(1.4426950408889634f * bfhi(lw[k].y)) * h[3] + bfhi(bw[k].y);
                *(unsigned*)(ur + (size_t)(t0 + k) * UC) = pk4_fp8(4.f * h[0] * bflo(yw[k].x), 4.f * h[1] * bfhi(yw[k].x), 4.f * h[2] * bflo(yw[k].y), 4.f * h[3] * bfhi(yw[k].y)); }
        }
    }
}

__device__ __forceinline__ void phase_ln1_router(ArgsP a, int l, unsigned char* ws, LAS unsigned char* lds, int tid, int lane, int gw, int NGW, int vcu) {
    LAS f32x4* wl = (LAS f32x4*)lds;
    for (int idx = tid; idx < 4096; idx += 512) { const int ln = idx & 63, q = (idx >> 6) & 3, jk = idx >> 8, d = 4 * ln + 256 * (jk >> 2) + (jk & 3);
        wl[idx] = *(const f32x4*)(a->w_router + (size_t)d * NE + 4 * q); }
    LAS unsigned* lcnt = (LAS unsigned*)(lds + 65536);
    if (tid < NE) lcnt[tid] = 0u;
    __syncthreads();
    const float* Y = (const float*)(ws + WS_Y); float* X1 = (float*)(ws + WS_X1); bf16_t* XB = (bf16_t*)(ws + WS_XB);
    unsigned* TOKE = (unsigned*)(ws + WS_SMALL + SM_TOKE); unsigned* TOKP = (unsigned*)(ws + WS_SMALL + SM_TOKP); float* TOKW = (float*)(ws + WS_SMALL + SM_TOKW);
    f32x4 gv[4], bv[4];
#pragma unroll
    for (int j = 0; j < 4; ++j) { gv[j] = *(const f32x4*)(a->ln1_g + (size_t)l * D + 4 * lane + 256 * j); bv[j] = *(const f32x4*)(a->ln1_b + (size_t)l * D + 4 * lane + 256 * j); }
    float br[16];
#pragma unroll
    for (int e = 0; e < 16; ++e) br[e] = a->b_router[e];
    for (int t = gw; t < T; t += NGW) {
        f32x4 v[4]; float s = 0.f;
#pragma unroll
        for (int j = 0; j < 4; ++j) { v[j] = *(const f32x4*)(Y + (size_t)t * D + 4 * lane + 256 * j); s += (v[j][0] + v[j][1]) + (v[j][2] + v[j][3]); }
        const float mean = wave_sum(s, lane) * (1.f / D); float s2 = 0.f;
#pragma unroll
        for (int j = 0; j < 4; ++j) { v[j] = v[j] - mean; s2 += (v[j][0] * v[j][0] + v[j][1] * v[j][1]) + (v[j][2] * v[j][2] + v[j][3] * v[j][3]); }
        const float rstd = 1.f / sqrtf(wave_sum(s2, lane) * (1.f / D) + LN_EPS);
        float acc[16];
#pragma unroll
        for (int e = 0; e < 16; ++e) acc[e] = 0.f;
#pragma unroll
        for (int j = 0; j < 4; ++j) { v[j] = v[j] * rstd * gv[j] + bv[j];
            st16f(X1 + (size_t)t * D + 4 * lane + 256 * j, v[j]);
            u32x2 w; w.x = cvt_pk_bf16(v[j][0], v[j][1]); w.y = cvt_pk_bf16(v[j][2], v[j][3]); *(u32x2*)(XB + (size_t)t * D + 4 * lane + 256 * j) = w;
#pragma unroll
            for (int k = 0; k < 4; ++k) { const float xv = v[j][k];
#pragma unroll
                for (int q = 0; q < 4; ++q) { const f32x4 w4 = wl[((j * 4 + k) * 4 + q) * 64 + lane]; acc[4 * q] += xv * w4[0]; acc[4 * q + 1] += xv * w4[1]; acc[4 * q + 2] += xv * w4[2]; acc[4 * q + 3] += xv * w4[3]; } } }
        float r8[8], r4[4], r2[2], r1;
        { const bool hi = (lane & 32) != 0;
#pragma unroll
          for (int i = 0; i < 8; ++i) { const float keep = hi ? acc[i + 8] : acc[i], send = hi ? acc[i] : acc[i + 8]; r8[i] = keep + lane_xor(send, 32, lane); } }
        { const bool hi = (lane & 16) != 0;
#pragma unroll
          for (int i = 0; i < 4; ++i) { const float keep = hi ? r8[i + 4] : r8[i], send = hi ? r8[i] : r8[i + 4]; r4[i] = keep + lane_xor(send, 16, lane); } }
        { const bool hi = (lane & 8) != 0;
#pragma unroll
          for (int i = 0; i < 2; ++i) { const float keep = hi ? r4[i + 2] : r4[i], send = hi ? r4[i] : r4[i + 2]; r2[i] = keep + lane_xor(send, 8, lane); } }
        { const bool hi = (lane & 4) != 0; const float keep = hi ? r2[1] : r2[0], send = hi ? r2[0] : r2[1]; r1 = keep + lane_xor(send, 4, lane); }
        r1 += lane_xor(r1, 2, lane); r1 += lane_xor(r1, 1, lane);
        float lg[16]; float mx = -3.0e38f;
#pragma unroll
        for (int e = 0; e < 16; ++e) { lg[e] = lane_get(r1, 4 * e) + br[e]; mx = fmaxf(mx, lg[e]); }
        float p[16];
#pragma unroll
        for (int e = 0; e < 16; ++e) p[e] = __expf(lg[e] - mx);
        int gsel = 0; float gbest = -1.f;
#pragma unroll
        for (int g = 0; g < 4; ++g) { const float p0 = p[4 * g], p1 = p[4 * g + 1], p2 = p[4 * g + 2], p3 = p[4 * g + 3];
            const float sum = (p0 + p1) + (p2 + p3), mn1 = fminf(fminf(p0, p1), fminf(p2, p3));
            const float hi01 = fmaxf(p0, p1), lo01 = fminf(p0, p1), hi23 = fmaxf(p2, p3), lo23 = fminf(p2, p3);
            const float top1 = fmaxf(hi01, hi23), top2 = fmaxf(fminf(hi01, hi23), fmaxf(lo01, lo23));
            (void)sum; (void)mn1;
            const float sc = top1 + top2; if (sc > gbest) { gbest = sc; gsel = g; } }
        float q0, q1, q2, q3;
        q0 = gsel == 0 ? p[0] : gsel == 1 ? p[4] : gsel == 2 ? p[8] : p[12];
        q1 = gsel == 0 ? p[1] : gsel == 1 ? p[5] : gsel == 2 ? p[9] : p[13];
        q2 = gsel == 0 ? p[2] : gsel == 1 ? p[6] : gsel == 2 ? p[10] : p[14];
        q3 = gsel == 0 ? p[3] : gsel == 1 ? p[7] : gsel == 2 ? p[11] : p[15];
        int i1 = 0; float v1 = q0;
        if (q1 > v1) { v1 = q1; i1 = 1; } if (q2 > v1) { v1 = q2; i1 = 2; } if (q3 > v1) { v1 = q3; i1 = 3; }
        int i2 = -1; float v2 = -1.f;
        if (i1 != 0 && q0 > v2) { v2 = q0; i2 = 0; } if (i1 != 1 && q1 > v2) { v2 = q1; i2 = 1; } if (i1 != 2 && q2 > v2) { v2 = q2; i2 = 2; } if (i1 != 3 && q3 > v2) { v2 = q3; i2 = 3; }
        const float inv = 1.0f / (v1 + v2);
        if (lane == 0) { const int e1 = 4 * gsel + i1, e2 = 4 * gsel + i2;
            const unsigned pos1 = __hip_atomic_fetch_add(lcnt + e1, 1u, __ATOMIC_RELAXED, __HIP_MEMORY_SCOPE_WORKGROUP);
            const unsigned pos2 = __hip_atomic_fetch_add(lcnt + e2, 1u, __ATOMIC_RELAXED, __HIP_MEMORY_SCOPE_WORKGROUP);
            TOKE[t] = (unsigned)e1 | ((unsigned)e2 << 8); TOKP[2 * t] = pos1; TOKP[2 * t + 1] = pos2; TOKW[2 * t] = v1 * inv; TOKW[2 * t + 1] = v2 * inv; }
    }
    __syncthreads();
    if (tid < NE) ((unsigned*)(ws + WS_SMALL + SM_WGCNT))[vcu * NE + tid] = lcnt[tid];
}

__device__ __forceinline__ void phase_moe_lists(unsigned char* ws, LAS unsigned char* lds, int tid, int lane, int gw, int NGW, int vcu, int G) {
    unsigned* ctl = (unsigned*)(ws + WS_CTL);
    LAS unsigned* off = (LAS unsigned*)lds;
    { const unsigned* WGCNT = (const unsigned*)(ws + WS_SMALL + SM_WGCNT);
      const int e = tid & 15, p = tid >> 4; unsigned tot = 0, pre = 0;
      for (int v = p; v < G; v += 32) { const unsigned c = WGCNT[v * NE + e]; tot += c; pre += (v < vcu) ? c : 0u; }
      off[128 + p * 16 + e] = tot; off[128 + 512 + p * 16 + e] = pre; }
    __syncthreads();
    if (tid < NE) { unsigned tot = 0, pre = 0; for (int p = 0; p < 32; ++p) { tot += off[128 + p * 16 + tid]; pre += off[128 + 512 + p * 16 + tid]; } off[32 + tid] = tot; off[48 + tid] = pre; }
    __syncthreads();
    if (tid == 0) { unsigned o = 0;
        for (int e = 0; e < NE; ++e) { const unsigned c = off[32 + e]; off[e] = o; off[64 + e] = o + off[48 + e]; o += (c + 255u) & ~255u; }
        off[16] = o; }
    __syncthreads();
    int* ROWINFO = (int*)(ws + WS_SMALL + SM_ROWINFO);
    if (blockIdx.x == 0) {
        if (tid == 0) ctl[CW_NTILES] = off[16] >> 8;
        if (tid < NE) { const unsigned t0 = off[tid] >> 8, t1 = off[tid + 1] >> 8; for (unsigned tt = t0; tt < t1; ++tt) ctl[CW_TILEE + tt] = (unsigned)tid; }
        for (int e = 0; e < NE; ++e) { const unsigned p0 = off[e] + off[32 + e], p1 = off[e + 1]; for (unsigned r = p0 + tid; r < p1; r += 512) ROWINFO[r] = -1; }
    }
    const bf16_t* XB = (const bf16_t*)(ws + WS_XB); bf16_t* XG = (bf16_t*)(ws + WS_XG);
    const unsigned* TOKE = (const unsigned*)(ws + WS_SMALL + SM_TOKE); const unsigned* TOKP = (const unsigned*)(ws + WS_SMALL + SM_TOKP);
    for (int t = gw; t < T; t += NGW) {
        const unsigned ee = TOKE[t]; const unsigned r1 = off[64 + (ee & 255u)] + TOKP[2 * t], r2 = off[64 + ((ee >> 8) & 255u)] + TOKP[2 * t + 1];
        const u32x4 v0 = *(const u32x4*)(XB + (size_t)t * D + 8 * lane), v1 = *(const u32x4*)(XB + (size_t)t * D + 512 + 8 * lane);
        st16(XG + (size_t)r1 * D + 8 * lane, v0); st16(XG + (size_t)r1 * D + 512 + 8 * lane, v1);
        st16(XG + (size_t)r2 * D + 8 * lane, v0); st16(XG + (size_t)r2 * D + 512 + 8 * lane, v1);
        if (lane == 0) { ROWINFO[r1] = 2 * t; ROWINFO[r2] = 2 * t + 1; }
    }
}

__device__ __forceinline__ void phase_ln2(ArgsP a, int l, unsigned char* ws, float* out, int lane, int gw, int NGW) {
    const float* X1 = (const float*)(ws + WS_X1); const bf16_t* O = (const bf16_t*)(ws + WS_O); unsigned char* X8 = ws + WS_XB;
    const float* TOKW = (const float*)(ws + WS_SMALL + SM_TOKW);
    f32x4 gv[4], bv[4];
#pragma unroll
    for (int j = 0; j < 4; ++j) { gv[j] = *(const f32x4*)(a->ln2_g + (size_t)l * D + 4 * lane + 256 * j); bv[j] = *(const f32x4*)(a->ln2_b + (size_t)l * D + 4 * lane + 256 * j); }
    for (int t = gw; t < T; t += NGW) {
        const float w1 = TOKW[2 * t], w2 = TOKW[2 * t + 1];
        f32x4 v[4]; float s = 0.f;
#pragma unroll
        for (int j = 0; j < 4; ++j) { const f32x4 x = *(const f32x4*)(X1 + (size_t)t * D + 4 * lane + 256 * j);
            const u32x2 o1 = *(const u32x2*)(O + (size_t)(2 * t) * D + 4 * lane + 256 * j), o2 = *(const u32x2*)(O + (size_t)(2 * t + 1) * D + 4 * lane + 256 * j);
            f32x4 mo; mo[0] = w1 * bflo(o1.x) + w2 * bflo(o2.x); mo[1] = w1 * bfhi(o1.x) + w2 * bfhi(o2.x); mo[2] = w1 * bflo(o1.y) + w2 * bflo(o2.y); mo[3] = w1 * bfhi(o1.y) + w2 * bfhi(o2.y);
            v[j] = x * DN_ALPHA + mo; s += (v[j][0] + v[j][1]) + (v[j][2] + v[j][3]); }
        const float mean = wave_sum(s, lane) * (1.f / D); float s2 = 0.f;
#pragma unroll
        for (int j = 0; j < 4; ++j) { v[j] = v[j] - mean; s2 += (v[j][0] * v[j][0] + v[j][1] * v[j][1]) + (v[j][2] * v[j][2] + v[j][3] * v[j][3]); }
        const float rstd = 1.f / sqrtf(wave_sum(s2, lane) * (1.f / D) + LN_EPS);
#pragma unroll
        for (int j = 0; j < 4; ++j) { v[j] = v[j] * rstd * gv[j] + bv[j];
            st16f(out + (size_t)t * D + 4 * lane + 256 * j, v[j]);
            *(unsigned*)(X8 + (size_t)t * D + 4 * lane + 256 * j) = pk4_fp8(v[j][0], v[j][1], v[j][2], v[j][3]); }
    }
}

constexpr int STEPS_PER_LAYER = 4 * NCHUNK + 7;
constexpr int N_STEPS = 1 + DEPTH * STEPS_PER_LAYER;

__global__ void __launch_bounds__(512, 2) mk_fwd(Args args_by_value) {
    (void)args_by_value;
    extern __shared__ __attribute__((aligned(16))) unsigned char lds_raw[];
    LAS unsigned char* lds = (LAS unsigned char*)lds_raw;
    volatile LAS unsigned* MISC = (volatile LAS unsigned*)(lds + MISC_OFF);
    const int tid0 = threadIdx.x;
    const int wave0 = __builtin_amdgcn_readfirstlane(tid0 >> 6);
    const int G = gridDim.x; const int bx = blockIdx.x; const int vcu0 = (G % 8 == 0) ? (bx % 8) * (G / 8) + bx / 8 : bx;
    const int NGW = G * 8, nthr = G * 512;
    ArgsP ap0 = (ArgsP)__builtin_amdgcn_kernarg_segment_ptr();
    unsigned char* ws0 = ap0->ws;
    unsigned* ctl = (unsigned*)(ws0 + WS_CTL);
    for (int u = tid0; u < (LDS_BYTES - LDSCTL_OFF) / 4; u += 512) ((LAS unsigned*)(lds + LDSCTL_OFF))[u] = 0u;
    __syncthreads();
    XcdBarrier bar; bar.bar = ctl + CW_BAR; bar.x = 0; bar.st = nullptr;
    if (!MK_PER_STEP_LAUNCH) bar = xcd_barrier_post(ctl + CW_BAR, MISC + 8);
    const int lo = ap0->ph_lo, hi = ap0->ph_hi;
    int step = 0;
#ifndef MK_MASK
#define MK_MASK 0xFFFFFFFFu
#endif
#ifndef MK_REPEAT
#define MK_REPEAT 0u
#endif
#ifndef MK_BAR2
#define MK_BAR2 0
#endif
#define STEP_BEGIN(id) if (((MK_MASK >> (id)) & 1u) && lo <= step && step < hi) { for (int rep = 0; rep < 1 + (int)((MK_REPEAT >> (id)) & 1u); ++rep) { if (rep) __syncthreads(); unsigned char* ws = ws0; asm volatile("" : "+s"(ws)); ArgsP args = ap0; asm volatile("" : "+s"(args)); int lz_ = 0; asm volatile("" : "+v"(lz_)); int wv_ = wave0; asm volatile("" : "+s"(wv_)); int vcu = vcu0; asm volatile("" : "+s"(vcu)); \
    const int lane = (int)__builtin_amdgcn_mbcnt_hi(~0u, __builtin_amdgcn_mbcnt_lo(~0u, (unsigned)lz_)), wave = wv_, tid = wave * 64 + lane, gw = vcu * 8 + wave, gtid = vcu * 512 + tid; LAS float* scr = (LAS float*)(lds + wave * 16384); (void)lane; (void)gw; (void)gtid; (void)scr;
#define STEP_END   } if (step + 1 < hi) { if (MK_PER_STEP_LAUNCH) {} else { xcd_barrier(bar); if (MK_BAR2) xcd_barrier(bar); } } } ++step;

    STEP_BEGIN(0)
        prep_tm_weights(args, 0, ws, scr, gw, NGW, lane);
        cvt_x(args->x, ws + WS_XB, gtid, nthr);
    STEP_END

#pragma unroll 1
    for (int l = 0; l < DEPTH; ++l) {

#pragma unroll 1
        for (int half = 0; half < NCHUNK; ++half) {
            STEP_BEGIN(1)
                pg8::SchedPlain S{TH / 256, DIN / 256, G, bx, (const char*)(ws + WS_XB) + (size_t)half * TH * D, (const char*)(ws + WS_WIN), (size_t)256 * D, (size_t)256 * D, 0};
                pg8::EpiZ E{(bf16_t*)(ws + WS_Z), (bf16_t*)(ws + WS_GG), (bf16_t*)(ws + WS_YR), half * TH};
                pg8::gemm_phase<pg8::EpiZ, pg8::SchedPlain, true, -1, true>(lds, D, D, D, S, E, tid, 0x7a7a7a7a);
            STEP_END
            STEP_BEGIN(2)
                phase_e1(args, l, half, ws, gtid, nthr);
            STEP_END
            STEP_BEGIN(3)
                pg8::SchedPlain S{TH / 256, NHEAD, G, bx, (const char*)(ws + WS_XC), (const char*)(ws + WS_WG), (size_t)256 * DR * 2, (size_t)256 * 128 * 2, (size_t)128 * 2};
                LAS unsigned* pcl = (LAS unsigned*)(lds + LDSCTL_OFF + 1024);
                { const float* PC = (const float*)(ws + WS_SMALL + SM_PCONST);
                  for (int c = tid; c < DR; c += 512) pcl[c] = cvt_pk_bf16(PC[c], PC[DR + c]);
                  for (int c = tid; c < DR / 2; c += 512) pcl[DR + c] = cvt_pk_bf16(PC[2 * DR + 2 * c], PC[2 * DR + 2 * c + 1]); }
                __syncthreads();
                pg8::EpiRG E{ws, half, pcl};
                pg8::gemm_phase<pg8::EpiRG, pg8::SchedPlain, true>(lds, DR * 2, 128 * 2, 128 * 2, S, E, tid);
            STEP_END
            STEP_BEGIN(5)
                phase_scan(ws, gtid, nthr);
            STEP_END
        }
        STEP_BEGIN(6)
            pg8::SchedPlain S{T / 256, D / 256, G, bx, (const char*)(ws + WS_U), (const char*)(ws + WS_WA), (size_t)256 * UC, (size_t)256 * UC, 0};
            pg8::EpiMix E{(const bf16_t*)(ws + WS_GG), (unsigned char*)(ws + WS_MERGED)};
            pg8::gemm_phase<pg8::EpiMix, pg8::SchedPlain, true, 8, true>(lds, UC, UC, UC, S, E, tid, 0x79797979);
        STEP_END
        STEP_BEGIN(8)
            pg8::SchedPlain S{T / 256, D / 256, G, bx, (const char*)(ws + WS_MERGED), (const char*)(ws + WS_WO), (size_t)256 * D, (size_t)256 * D, 0};
            pg8::EpiY E{(l == 0) ? args->x : (const float*)args->out, (float*)(ws + WS_Y)};
            pg8::gemm_phase<pg8::EpiY, pg8::SchedPlain, true, -1, true>(lds, D, D, D, S, E, tid, 0x77777777);
        STEP_END
        STEP_BEGIN(9)
            prep_expert_weights(args, l, ws, scr, gw, NGW, lane);
            __syncthreads();
            if (rep == 0) phase_ln1_router(args, l, ws, lds, tid, lane, gw, NGW, vcu);
        STEP_END
        STEP_BEGIN(10)
            phase_moe_lists(ws, lds, tid, lane, gw, NGW, vcu, G);
            __syncthreads();
            if (l + 1 < DEPTH) prep_tm_weights(args, l + 1, ws, scr, gw, NGW, lane);
        STEP_END
        STEP_BEGIN(11)
            const int ntiles = (int)__hip_atomic_load(ctl + CW_NTILES, __ATOMIC_RELAXED, __HIP_MEMORY_SCOPE_AGENT);
            pg8::SchedMoe S{ntiles, 4, G, bx, (const char*)(ws + WS_XG), (const char*)(ws + WS_WEX), (size_t)256 * D * 2, (size_t)256 * D * 2, (size_t)1024 * 1024 * 2, ctl + CW_TILEE};
            pg8::EpiH E{(bf16_t*)(ws + WS_H)};
            pg8::gemm_phase<pg8::EpiH, pg8::SchedMoe, true>(lds, D * 2, D * 2, D * 2, S, E, tid);
        STEP_END
        STEP_BEGIN(12)
            const int ntiles = (int)__hip_atomic_load(ctl + CW_NTILES, __ATOMIC_RELAXED, __HIP_MEMORY_SCOPE_AGENT);
            pg8::SchedMoe S{ntiles, 4, G, bx, (const char*)(ws + WS_H), (const char*)(ws + WS_WEX) + (size_t)NE * 1024 * 1024 * 2, (size_t)256 * FF * 2, (size_t)256 * FF * 2, (size_t)1024 * 512 * 2, ctl + CW_TILEE};
            pg8::EpiO E{(bf16_t*)(ws + WS_O), (const int*)(ws + WS_SMALL + SM_ROWINFO)};
            pg8::gemm_phase<pg8::EpiO, pg8::SchedMoe, true>(lds, FF * 2, FF * 2, FF * 2, S, E, tid);
        STEP_END
        STEP_BEGIN(13)
            phase_ln2(args, l, ws, args->out, lane, gw, NGW);
        STEP_END
    }
#undef STEP_BEGIN
#undef STEP_END
}

extern "C" void kernel_launch(void* const* d_in, const int* in_sizes, int n_in, void* d_out, int out_size, void* d_ws, size_t ws_size, hipStream_t stream) {
    static int grid = 0;
    if (grid == 0) {
        if (n_in != 22 || in_sizes[0] != T * D || out_size != T * D || ws_size < WS_NEED) {
            fprintf(stderr, "kernel_launch: unexpected shapes (n_in %d, in0 %d, out %d, ws %zu, need %zu); nothing launched\n", n_in, n_in > 0 ? in_sizes[0] : -1, out_size, ws_size, (size_t)WS_NEED); grid = -1; return; }
        int dev = 0, cus = 0, per_cu = 0;
        if (hipGetDevice(&dev) != hipSuccess || hipDeviceGetAttribute(&cus, hipDeviceAttributeMultiprocessorCount, dev) != hipSuccess) { grid = -1; return; }
        if (hipFuncSetAttribute((const void*)mk_fwd, hipFuncAttributeMaxDynamicSharedMemorySize, LDS_BYTES) != hipSuccess) { fprintf(stderr, "kernel_launch: hipFuncSetAttribute failed\n"); grid = -1; return; }
        if (hipOccupancyMaxActiveBlocksPerMultiprocessor(&per_cu, (const void*)mk_fwd, 512, LDS_BYTES) != hipSuccess || per_cu < 1) { fprintf(stderr, "kernel_launch: occupancy query says %d blocks per CU\n", per_cu); per_cu = 1; }
        (void)hipGetLastError();
        grid = cus;
    }
    if (grid < 0) return;
    (void)hipMemsetAsync((char*)d_ws + WS_CTL, 0, CTL_ZERO_BYTES, stream);
    Args a{};
    const float** p = (const float**)&a;
    for (int i = 0; i < 22; ++i) p[i] = (const float*)d_in[i];
    a.out = (float*)d_out; a.ws = (unsigned char*)d_ws;
#if MK_PER_STEP_LAUNCH
    for (int s = 0; s < N_STEPS; ++s) { a.ph_lo = s; a.ph_hi = s + 1; hipLaunchKernelGGL(mk_fwd, dim3(grid), dim3(512), LDS_BYTES, stream, a); }
#else
    a.ph_lo = 0; a.ph_hi = N_STEPS;
    hipLaunchKernelGGL(mk_fwd, dim3(grid), dim3(512), LDS_BYTES, stream, a);
#endif
}
```

```cpp
#include <hip/hip_runtime.h>
#include <cstdio>
#include <cstdint>

#ifndef MK_TP
#define MK_TP (-1)
#endif
#ifndef MK_TQ
#define MK_TQ (-1)
#endif
#ifndef MOE_FP8_MASK
#define MOE_FP8_MASK 2u
#endif
#ifndef MK_PER_STEP_LAUNCH
#define MK_PER_STEP_LAUNCH 0
#endif

#define LAS __attribute__((address_space(3)))
typedef unsigned short bf16_t;
typedef short bf16x8 __attribute__((ext_vector_type(8)));
typedef float f32x4 __attribute__((ext_vector_type(4)));
typedef float f32x2 __attribute__((ext_vector_type(2)));
typedef unsigned u32x4 __attribute__((ext_vector_type(4)));
typedef unsigned u32x2 __attribute__((ext_vector_type(2)));

constexpr int D = 1024, T = 16384, SEQ = 4096, NBATCH = 4, DR = 1280, NHEAD = 10, DIN = 7680, NE = 16, FF = 512, DEPTH = 2;
constexpr int NCHUNK = 1, TH = T / NCHUNK;
constexpr int ZC = 3328;
constexpr int GGC = 2048;
constexpr int SCH = 64, NSCH = SEQ / SCH;
constexpr int MOE_ROWS = 36864, MOE_TILES = MOE_ROWS / 256;
constexpr float LN_EPS = 1e-5f;
constexpr float DN_ALPHA = 1.4142135623730951f;

constexpr size_t MiB = 1u << 20;
constexpr size_t WS_CTL = 0, CTL_ZERO_BYTES = 128 * 1024;
constexpr size_t WS_WIN = 1 * MiB;
constexpr size_t WS_WA = 16 * MiB;
constexpr size_t WS_WO = 21 * MiB;
constexpr size_t WS_WG = 23 * MiB;
constexpr size_t WS_XB = 24 * MiB;
constexpr size_t WS_U = 56 * MiB;
constexpr int UC = 2304;
constexpr size_t WS_GG = 92 * MiB;
constexpr size_t WS_Z = 156 * MiB;
constexpr size_t WS_YR = 260 * MiB;
constexpr size_t WS_XC = 300 * MiB;
constexpr size_t WS_GT = 156 * MiB;
constexpr size_t WS_SMALL = 340 * MiB;
constexpr size_t WS_MERGED = 156 * MiB;
constexpr size_t WS_Y = 172 * MiB;
constexpr size_t WS_X1 = 92 * MiB;
constexpr size_t WS_WEX = 236 * MiB;
constexpr size_t WS_XG = 156 * MiB;
constexpr size_t WS_H = 284 * MiB;
constexpr size_t WS_O = 156 * MiB;
constexpr size_t WS_NEED = 344 * MiB + 512 * 1024;
constexpr size_t SM_AEND = 0;
constexpr size_t SM_HEND = SM_AEND + (size_t)NBATCH * NSCH * DR * 4;
constexpr size_t SM_TOKE = SM_HEND + (size_t)NBATCH * NSCH * DR * 4;
constexpr size_t SM_TOKP = SM_TOKE + (size_t)T * 4;
constexpr size_t SM_TOKW = SM_TOKP + (size_t)T * 8;
constexpr size_t SM_ROWINFO = SM_TOKW + (size_t)T * 8;
constexpr size_t SM_WGCNT = SM_ROWINFO + (size_t)MOE_ROWS * 4;
constexpr size_t SM_PCONST = SM_WGCNT + 256 * 16 * 4;
constexpr size_t SM_END = SM_PCONST + 3 * 1280 * 4;
static_assert(WS_SMALL + SM_END <= WS_NEED, "small region");
constexpr int CW_BAR = 4096;
constexpr int CW_CNT = 8192;
constexpr int CW_NTILES = 8256;
constexpr int CW_TILEE = 8320;

constexpr int RING_BYTES = 131072;
constexpr int LDSCTL_OFF = RING_BYTES, MISC_OFF = LDSCTL_OFF + 320;
constexpr int LDS_BYTES = 147456;

__device__ __forceinline__ unsigned cvt_pk_bf16(float lo, float hi) { unsigned r; asm volatile("v_cvt_pk_bf16_f32 %0, %1, %2" : "=v"(r) : "v"(lo), "v"(hi)); return r; }
__device__ __forceinline__ float bflo(unsigned w) { return __uint_as_float(w << 16); }
__device__ __forceinline__ float bfhi(unsigned w) { return __uint_as_float(w & 0xffff0000u); }
__device__ __forceinline__ float bf1(bf16_t b) { return __uint_as_float((unsigned)b << 16); }
__device__ __forceinline__ float fsigmoid(float x) { return __builtin_amdgcn_rcpf(1.0f + __builtin_amdgcn_exp2f(-1.4426950408889634f * x)); }
__device__ __forceinline__ float gelu_tanh(float y) { const float u = 1.5957691216057308f * (y + 0.044715f * y * y * y); return y * fsigmoid(u); }
__device__ __forceinline__ float lane_xor(float v, int mask, int lane) { return __builtin_bit_cast(float, __builtin_amdgcn_ds_bpermute((lane ^ mask) << 2, __builtin_bit_cast(int, v))); }
__device__ __forceinline__ float lane_get(float v, int src) { return __builtin_bit_cast(float, __builtin_amdgcn_ds_bpermute(src << 2, __builtin_bit_cast(int, v))); }
__device__ __forceinline__ float wave_sum(float v, int lane) {
#pragma unroll
    for (int o = 1; o < 64; o <<= 1) v += lane_xor(v, o, lane);
    return v;
}
typedef int v8i __attribute__((ext_vector_type(8)));
typedef int v4i __attribute__((ext_vector_type(4)));
__device__ __forceinline__ unsigned pk4_fp8(float a, float b, float c, float d) {
    a = __builtin_amdgcn_fmed3f(a, -448.f, 448.f); b = __builtin_amdgcn_fmed3f(b, -448.f, 448.f); c = __builtin_amdgcn_fmed3f(c, -448.f, 448.f); d = __builtin_amdgcn_fmed3f(d, -448.f, 448.f);
    int w = __builtin_amdgcn_cvt_pk_fp8_f32(a, b, 0, false); w = __builtin_amdgcn_cvt_pk_fp8_f32(c, d, w, true); return (unsigned)w; }
#ifndef MK_WT
#define MK_WT 0
#endif
__device__ __forceinline__ void st16(void* p, u32x4 v) {
#if MK_WT
    asm volatile("global_store_dwordx4 %0, %1, off sc1\n\ts_nop 1" :: "v"(p), "v"(v));
#else
    *(u32x4*)p = v;
#endif
}
__device__ __forceinline__ void st16f(void* p, f32x4 v) {
#if MK_WT
    asm volatile("global_store_dwordx4 %0, %1, off sc1\n\ts_nop 1" :: "v"(p), "v"(v));
#else
    *(f32x4*)p = v;
#endif
}
#define LDS_WAIT() asm volatile("s_waitcnt lgkmcnt(0)" ::: "memory")
#define VM_WAIT() asm volatile("s_waitcnt vmcnt(0)" ::: "memory")

namespace pg8 {
constexpr int BM = 256, BK = 64, HALF = 128, HTB = HALF * BK * 2, STAGE_BYTES = 8 * HTB, NXCD = 8, WGM = 8;
__host__ __device__ __forceinline__ int lds_byte(int r, int c) { const int st = (r >> 4) * 2 + (c >> 5), rr = r & 15, cc = c & 31, ob = rr * 64 + cc * 2; return st * 1024 + (ob ^ (((ob >> 9) & 1) << 5)); }
__host__ __device__ __forceinline__ void stage_rc(int b, int& R, int& C) { const int st = b / 1024, sb = b % 1024, swz = sb ^ (((sb >> 9) & 1) << 5); R = (st >> 1) * 16 + swz / 64; C = (st & 1) * 32 + (swz % 64) / 2; }
__host__ __device__ __forceinline__ int perm32(int rho) { const int n = rho >> 4, i = rho & 15; return 8 * (i >> 2) + 4 * n + (i & 3); }

struct Unit { const char* a; const char* b; int pm, pn; };

__device__ __forceinline__ bool static_order(int i, int G, int c, int nM, int nN, int& pm, int& pn) {
    const int nwg = nM * nN; const long L = (long)i * G + c; if (L >= nwg) return false;
    int wgid = (int)L; { const int q = nwg / NXCD, r = nwg % NXCD, xcd = wgid % NXCD, off = wgid / NXCD; wgid = (xcd < r ? xcd * (q + 1) : r * (q + 1) + (xcd - r) * q) + off; }
    const int nig = WGM * nN, gid = wgid / nig, fm = gid * WGM, gsz = (nM - fm) < WGM ? (nM - fm) : WGM;
    pm = fm + ((wgid % nig) % gsz); pn = (wgid % nig) / gsz; return true;
}
struct SchedPlain {
    int nM, nN, G, c; const char* A; const char* B; size_t a_tile, b_tile, a_pn;
    __device__ __forceinline__ bool next(int i, Unit& u) const {
        int pm, pn; if (!static_order(i, G, c, nM, nN, pm, pn)) return false;
        u.pm = pm; u.pn = pn; u.a = A + (size_t)pm * a_tile + (size_t)pn * a_pn; u.b = B + (size_t)pn * b_tile; return true;
    }
};
struct SchedMoe {
    int nM, nN, G, c; const char* A; const char* B; size_t a_tile, b_tile, b_exp; const unsigned* tile_e;
    __device__ __forceinline__ bool next(int i, Unit& u) const {
        int pm, pn; if (!static_order(i, G, c, nM, nN, pm, pn)) return false;
        const int e = __builtin_amdgcn_readfirstlane((int)__hip_atomic_load(tile_e + pm, __ATOMIC_RELAXED, __HIP_MEMORY_SCOPE_AGENT));
        u.pm = pm; u.pn = pn; u.a = A + (size_t)pm * a_tile; u.b = B + (size_t)e * b_exp + (size_t)pn * b_tile; return true;
    }
};

template <class Epi, class Sched, bool ALIGN_EPI, int HOOK_T = -1, bool FP8 = false>
__device__ __forceinline__ void gemm_phase(LAS unsigned char* lds, const int lda, const int ldb, const int K, const Sched& S, const Epi& E, const int tid_in, const int scale = 0x7f7f7f7f) {
    int tid = tid_in; asm volatile("" : "+v"(tid));
    const int wid = __builtin_amdgcn_readfirstlane(tid >> 6), lane = tid & 63, wr = wid >> 2, wc = wid & 3, fr = lane & 15, fq = lane >> 4;
    int Kop = K; asm volatile("" : "+s"(Kop));
    const int nt = Kop / 128;
    unsigned voffA[2], voffB[2];
#pragma unroll
    for (int i = 0; i < 2; ++i) { int R, C; stage_rc(tid * 16 + i * 8192, R, C); const int Rb = Epi::PERM ? ((R & ~31) + perm32(R & 31)) : R;
        voffA[i] = (unsigned)(R * lda + 2 * C); voffB[i] = (unsigned)(Rb * ldb + 2 * C); }
    const size_t kstep = (size_t)(BK * 2);
    const size_t hstepA = (size_t)HALF * lda, hstepB = (size_t)HALF * ldb;
    const unsigned ldsw = (unsigned)wid * 1024u;
    const int aoff = FP8 ? lds_byte(wr * 64 + fr, fq * 16) : lds_byte(wr * 64 + fr, fq * 8), boff = FP8 ? lds_byte(wc * 32 + fr, fq * 16) : lds_byte(wc * 32 + fr, fq * 8);
    const int f0 = FP8 ? ((fq >> 1) & 1) * 16 : 0, f1 = 16 - f0;
    const LAS unsigned char* pa0 = lds + aoff + f0; const LAS unsigned char* pa1 = lds + aoff + f1; const LAS unsigned char* pb0 = lds + 4 * HTB + boff + f0; const LAS unsigned char* pb1 = lds + 4 * HTB + boff + f1;
    (void)pa1; (void)pb1;
#define PG8_SA(b, h) (((b) * 2 + (h)) * HTB)
#define PG8_SB(b, h) ((4 + (b) * 2 + (h)) * HTB)
#define PG8_STAGE(bufoff, gbase, voff) do { _Pragma("unroll") for (int _i = 0; _i < 2; ++_i) \
        __builtin_amdgcn_global_load_lds((const unsigned*)((const char*)(gbase) + (voff)[_i]), (LAS unsigned*)(lds + (bufoff) + ldsw + _i * 8192), 16, 0, 0); } while (0)
#define PG8_LD8(dst, i_, p0_, p1_, off_) do { const v4i lo_ = *(const LAS v4i*)((p0_) + (off_)), hi_ = *(const LAS v4i*)((p1_) + (off_)); dst[i_] = __builtin_shufflevector(lo_, hi_, 0, 1, 2, 3, 4, 5, 6, 7); } while (0)
#define PG8_LDA(dst, b, h) do { if constexpr (FP8) { _Pragma("unroll") for (int m = 0; m < 4; ++m) PG8_LD8(dst##8, m, pa0, pa1, PG8_SA(b, h) + m * 2048); } \
        else { _Pragma("unroll") for (int m = 0; m < 4; ++m) _Pragma("unroll") for (int k = 0; k < 2; ++k) dst[m][k] = *(const LAS bf16x8*)(pa0 + PG8_SA(b, h) + m * 2048 + k * 1024); } } while (0)
#define PG8_LDB(dst, b, h) do { if constexpr (FP8) { _Pragma("unroll") for (int n = 0; n < 2; ++n) PG8_LD8(dst##8, n, pb0, pb1, PG8_SA(b, h) + n * 2048); } \
        else { _Pragma("unroll") for (int n = 0; n < 2; ++n) _Pragma("unroll") for (int k = 0; k < 2; ++k) dst[n][k] = *(const LAS bf16x8*)(pb0 + PG8_SA(b, h) + n * 2048 + k * 1024); } } while (0)
#define PG8_MMA(ai, bj, At, Bt) do { __builtin_amdgcn_s_setprio(1); _Pragma("unroll") for (int m = 0; m < 4; ++m) _Pragma("unroll") for (int n = 0; n < 2; ++n) { \
        if constexpr (FP8) asm volatile("v_mfma_scale_f32_16x16x128_f8f6f4 %0, %1, %2, %0, %3, %4 op_sel_hi:[0,0,0]" : "+v"(acc[ai][bj][m][n]) : "v"(Bt##8[n]), "v"(At##8[m]), "v"(scale_v), "v"(one_v)); \
        else { _Pragma("unroll") for (int k = 0; k < 2; ++k) acc[ai][bj][m][n] = __builtin_amdgcn_mfma_f32_16x16x32_bf16(Bt[n][k], At[m][k], acc[ai][bj][m][n], 0, 0, 0); } } \
        __builtin_amdgcn_s_setprio(0); } while (0)
#define PG8_WAIT_V(n) asm volatile("s_waitcnt vmcnt(" #n ")" ::: "memory")
#define PG8_WAIT_L(n) asm volatile("s_waitcnt lgkmcnt(" #n ")" ::: "memory")
#define PG8_BAR __builtin_amdgcn_s_barrier()
#define PG8_SCHED __builtin_amdgcn_sched_barrier(0)
    int scale_v = scale, one_v = 0x7f7f7f7f; asm volatile("" : "+v"(scale_v), "+v"(one_v));
    (void)scale_v; (void)one_v;
    Unit cur, nxt; int ui = 0;
    if (!S.next(0, cur)) return;
    f32x4 acc[2][2][4][2];
#pragma unroll
    for (int a = 0; a < 2; ++a)
#pragma unroll
        for (int b = 0; b < 2; ++b)
#pragma unroll
            for (int m = 0; m < 4; ++m)
#pragma unroll
                for (int n = 0; n < 2; ++n) acc[a][b][m][n] = (f32x4){0.f, 0.f, 0.f, 0.f};
    bf16x8 At[4][2], B0[2][2], B1[2][2];
    v8i At8[4], B08[2], B18[2];
    const char* cA = cur.a; const char* cB = cur.b;
    PG8_STAGE(PG8_SB(0, 0), cB, voffB); PG8_STAGE(PG8_SB(0, 1), cB + hstepB, voffB); PG8_STAGE(PG8_SA(0, 0), cA, voffA); PG8_STAGE(PG8_SA(0, 1), cA + hstepA, voffA);
    if (wr == 1) PG8_BAR;
    PG8_WAIT_V(2); PG8_BAR;
    PG8_STAGE(PG8_SB(1, 0), cB + kstep, voffB); PG8_STAGE(PG8_SA(1, 0), cA + kstep, voffA); PG8_STAGE(PG8_SB(1, 1), cB + hstepB + kstep, voffB);
    PG8_WAIT_V(6); PG8_BAR;
    for (;;) {
        const bool has_next = S.next(ui + 1, nxt);
        const char* nA = has_next ? nxt.a : cA; const char* nB = has_next ? nxt.b : cB;
        for (int t = 0; t < nt; t += 2) {
            const bool last = (t == nt - 2);
            if constexpr (HOOK_T >= 0) { if (t == HOOK_T) { if constexpr (FP8) asm volatile("s_nop 15\n\ts_nop 15" ::: "memory"); int fr2 = fr, fq2 = fq; asm volatile("" : "+v"(fr2), "+v"(fq2)); E.hook(acc, cur, wr, wc, fr2, fq2); } }
            const char* a1 = cA + (size_t)(t + 1) * kstep;
            const char* a2 = last ? nA : cA + (size_t)(t + 2) * kstep; const char* b2 = last ? nB : cB + (size_t)(t + 2) * kstep;
            const char* a3 = a2 + kstep; const char* b3 = b2 + kstep;
            PG8_LDB(B0, 0, 0); PG8_LDB(B1, 0, 1); PG8_SCHED; PG8_LDA(At, 0, 0); PG8_STAGE(PG8_SA(1, 1), a1 + hstepA, voffA);
            PG8_WAIT_V(8); PG8_WAIT_L(0); PG8_BAR; PG8_MMA(0, 0, At, B0); PG8_MMA(0, 1, At, B1); PG8_BAR; PG8_SCHED;
            PG8_LDA(At, 0, 1); PG8_STAGE(PG8_SB(0, 0), b2, voffB); PG8_STAGE(PG8_SB(0, 1), b2 + hstepB, voffB); PG8_STAGE(PG8_SA(0, 0), a2, voffA);
            PG8_WAIT_V(8); PG8_WAIT_L(0); PG8_BAR; PG8_MMA(1, 0, At, B0); PG8_MMA(1, 1, At, B1); PG8_BAR; PG8_SCHED;
            PG8_LDB(B0, 1, 0); PG8_LDB(B1, 1, 1); PG8_SCHED; PG8_LDA(At, 1, 0); PG8_STAGE(PG8_SA(0, 1), a2 + hstepA, voffA);
            PG8_WAIT_V(8); PG8_WAIT_L(0); PG8_BAR; PG8_MMA(0, 0, At, B0); PG8_MMA(0, 1, At, B1); PG8_BAR; PG8_SCHED;
            PG8_LDA(At, 1, 1); PG8_STAGE(PG8_SB(1, 0), b3, voffB); PG8_STAGE(PG8_SB(1, 1), b3 + hstepB, voffB); PG8_STAGE(PG8_SA(1, 0), a3, voffA);
            PG8_WAIT_V(8); PG8_WAIT_L(0); PG8_BAR; PG8_MMA(1, 0, At, B0); PG8_MMA(1, 1, At, B1); PG8_BAR; PG8_SCHED;
        }
        if constexpr (ALIGN_EPI) { if (wr == 0) PG8_BAR; }
        if constexpr (FP8) asm volatile("s_nop 15\n\ts_nop 15" ::: "memory");
        { int fr2 = fr, fq2 = fq; asm volatile("" : "+v"(fr2), "+v"(fq2));
          E(acc, cur, wr, wc, fr2, fq2); }
        if (!has_next) break;
#pragma unroll
        for (int a = 0; a < 2; ++a)
#pragma unroll
            for (int b = 0; b < 2; ++b)
#pragma unroll
                for (int m = 0; m < 4; ++m)
#pragma unroll
                    for (int n = 0; n < 2; ++n) acc[a][b][m][n] = (f32x4){0.f, 0.f, 0.f, 0.f};
        cur = nxt; cA = nA; cB = nB; ++ui;
        if constexpr (ALIGN_EPI) { if (wr == 1) PG8_BAR; }
    }
    PG8_WAIT_V(0);
    if constexpr (!ALIGN_EPI) { if (wr == 0) PG8_BAR; }
    PG8_BAR;
#undef PG8_SA
#undef PG8_SB
#undef PG8_STAGE
#undef PG8_LDA
#undef PG8_LDB
#undef PG8_MMA
#undef PG8_LD8
#undef PG8_WAIT_V
#undef PG8_WAIT_L
#undef PG8_BAR
#undef PG8_SCHED
}

typedef const f32x4 (&AccRef)[2][2][4][2];
typedef f32x4 (&AccMut)[2][2][4][2];
#define EPI_LOOP_ROWS for (int ai = 0; ai < 2; ++ai) _Pragma("unroll") for (int m = 0; m < 4; ++m)

struct EpiZ {
    static constexpr bool PERM = true;
    bf16_t* Z; bf16_t* GG; bf16_t* YR; int row_base;
    __device__ __forceinline__ void operator()(AccRef acc, const Unit& u, int wr, int wc, int fr, int fq) const {
        const int row0 = u.pm * BM + wr * 64 + fr;
        if (u.pn < 8) {
            bf16_t* base = Z + u.pn * HALF + wc * 32 + 8 * fq;
#pragma unroll
            EPI_LOOP_ROWS { const f32x4 h0 = acc[ai][0][m][0], h1 = acc[ai][0][m][1], c0 = acc[ai][1][m][0], c1 = acc[ai][1][m][1];
                u32x4 w; w.x = cvt_pk_bf16(h0[0] * c0[0], h0[1] * c0[1]); w.y = cvt_pk_bf16(h0[2] * c0[2], h0[3] * c0[3]); w.z = cvt_pk_bf16(h1[0] * c1[0], h1[1] * c1[1]); w.w = cvt_pk_bf16(h1[2] * c1[2], h1[3] * c1[3]);
                st16(base + (size_t)(row0 + ai * HALF + m * 16) * ZC, w); }
        } else {
            const int colt = u.pn * BM + wc * 32 + 8 * fq; const int act = u.pn < 17 ? 0 : (u.pn < 22 ? 1 : 2);
            bf16_t* base; size_t ldc;
            if (u.pn < 17) { base = Z + (colt - 1024); ldc = ZC; } else if (u.pn < 22) { base = YR + (colt - 4352); ldc = DR; } else { base = GG + (size_t)row_base * GGC + (colt - 5632); ldc = GGC; }
#pragma unroll
            EPI_LOOP_ROWS { bf16_t* rowp = base + (size_t)(row0 + ai * HALF + m * 16) * ldc;
#pragma unroll
                for (int bj = 0; bj < 2; ++bj) { f32x4 v0 = acc[ai][bj][m][0], v1 = acc[ai][bj][m][1];
                    if (act == 1) {
#pragma unroll
                        for (int j = 0; j < 4; ++j) { v0[j] = gelu_tanh(v0[j]); v1[j] = gelu_tanh(v1[j]); } }
                    else if (act == 2) {
#pragma unroll
                        for (int j = 0; j < 4; ++j) { v0[j] = fsigmoid(v0[j]); v1[j] = fsigmoid(v1[j]); } }
                    u32x4 w; w.x = cvt_pk_bf16(v0[0], v0[1]); w.y = cvt_pk_bf16(v0[2], v0[3]); w.z = cvt_pk_bf16(v1[0], v1[1]); w.w = cvt_pk_bf16(v1[2], v1[3]);
                    st16(rowp + bj * HALF, w); } }
        }
    }
};
struct EpiBf16 {
    static constexpr bool PERM = true;
    bf16_t* O; int ldc;
    __device__ __forceinline__ void operator()(AccRef acc, const Unit& u, int wr, int wc, int fr, int fq) const {
        const int row0 = u.pm * BM + wr * 64 + fr; const int colt = u.pn * BM + wc * 32 + 8 * fq;
#pragma unroll
        EPI_LOOP_ROWS { bf16_t* rowp = O + (size_t)(row0 + ai * HALF + m * 16) * ldc + colt;
#pragma unroll
            for (int bj = 0; bj < 2; ++bj) { const f32x4 v0 = acc[ai][bj][m][0], v1 = acc[ai][bj][m][1];
                u32x4 w; w.x = cvt_pk_bf16(v0[0], v0[1]); w.y = cvt_pk_bf16(v0[2], v0[3]); w.z = cvt_pk_bf16(v1[0], v1[1]); w.w = cvt_pk_bf16(v1[2], v1[3]);
                st16(rowp + bj * HALF, w); } }
    }
};
__device__ __forceinline__ float dpp_shr(float v, float ident, int s) {
    const int o = __builtin_bit_cast(int, ident), x = __builtin_bit_cast(int, v); int r;
    switch (s) { case 1: r = __builtin_amdgcn_update_dpp(o, x, 0x111, 0xf, 0xf, false); break; case 2: r = __builtin_amdgcn_update_dpp(o, x, 0x112, 0xf, 0xf, false); break;
                 case 4: r = __builtin_amdgcn_update_dpp(o, x, 0x114, 0xf, 0xf, false); break; default: r = __builtin_amdgcn_update_dpp(o, x, 0x118, 0xf, 0xf, false); break; }
    return __builtin_bit_cast(float, r);
}
struct EpiRG {
    static constexpr bool PERM = true;
    unsigned char* wsb; int half; const LAS unsigned* pcl;
    __device__ __forceinline__ void operator()(AccRef acc, const Unit& u, int wr, int wc, int fr, int fq) const {
        bf16_t* GT = (bf16_t*)(wsb + WS_GT); const bf16_t* XC = (const bf16_t*)(wsb + WS_XC);
        float* AEND = (float*)(wsb + WS_SMALL + SM_AEND); float* HEND = (float*)(wsb + WS_SMALL + SM_HEND);
        const int row0 = u.pm * BM + wr * 64 + fr; const int cc = wc * 32 + 8 * fq, ch = u.pn * HALF + cc;
#pragma unroll
        for (int ai = 0; ai < 2; ++ai) {
            int chl = ch; asm volatile("" : "+v"(chl));
            u32x4 xwv[4];
#pragma unroll
            for (int m = 0; m < 2; ++m) xwv[m] = *(const u32x4*)(XC + (size_t)(row0 + ai * HALF + m * 16) * DR + ch);
            float At[8], Ht[8];
#pragma unroll
            for (int k = 0; k < 8; ++k) { At[k] = 1.f; Ht[k] = 0.f; }
#pragma unroll
            for (int m = 0; m < 4; ++m) { const size_t r = (size_t)(row0 + ai * HALF + m * 16);
                const u32x4 xw = xwv[m];
                if (m < 2) { xwv[m + 2] = *(const u32x4*)(XC + (size_t)(row0 + ai * HALF + (m + 2) * 16) * DR + ch); asm volatile("" ::: "memory"); }
                float xc[8]; xc[0] = bflo(xw.x); xc[1] = bfhi(xw.x); xc[2] = bflo(xw.y); xc[3] = bfhi(xw.y); xc[4] = bflo(xw.z); xc[5] = bfhi(xw.z); xc[6] = bflo(xw.w); xc[7] = bfhi(xw.w);
#pragma unroll
                for (int n = 0; n < 2; ++n) {
                    float la[4], bb[4];
                    const u32x4 cb = *(const LAS u32x4*)(pcl + chl + 4 * n); const u32x2 xb2 = *(const LAS u32x2*)(pcl + DR + ((chl + 4 * n) >> 1));
#pragma unroll
                    for (int j = 0; j < 4; ++j) { const int k = 4 * n + j; const float rp = acc[ai][0][m][n][j], ip = acc[ai][1][m][n][j];
                        const float l = -bflo(cb[j]) * fsigmoid(rp + bfhi(cb[j])); const float x = 2.0f * l;
                        float em = -x * (1.0f + x * (0.5f + x * (0.16666667f + x * (0.041666668f + x * (0.0083333338f + x * 0.0013888889f)))));
                        la[j] = l; bb[j] = __builtin_amdgcn_sqrtf(em) * fsigmoid(ip + ((j & 1) ? bfhi(xb2[j >> 1]) : bflo(xb2[j >> 1]))) * xc[k]; }
                    u32x2 w0, w1; w0.x = cvt_pk_bf16(la[0], la[1]); w0.y = cvt_pk_bf16(la[2], la[3]); w1.x = cvt_pk_bf16(bb[0], bb[1]); w1.y = cvt_pk_bf16(bb[2], bb[3]);
                    *(u32x2*)(GT + r * 2560 + u.pn * BM + cc + 4 * n) = w0; *(u32x2*)(GT + r * 2560 + u.pn * BM + HALF + cc + 4 * n) = w1;
                    la[0] = bflo(w0.x); la[1] = bfhi(w0.x); la[2] = bflo(w0.y); la[3] = bfhi(w0.y); bb[0] = bflo(w1.x); bb[1] = bfhi(w1.x); bb[2] = bflo(w1.y); bb[3] = bfhi(w1.y);
#pragma unroll
                    for (int j = 0; j < 4; ++j) { const int k = 4 * n + j; float A = __builtin_amdgcn_exp2f(1.4426950408889634f * la[j]), H = bb[j];
#pragma unroll
                        for (int s = 1; s < 16; s <<= 1) { const float Al = dpp_shr(A, 1.f, s), Hl = dpp_shr(H, 0.f, s); H = A * Hl + H; A = A * Al; }
                        Ht[k] = A * Ht[k] + H; At[k] = At[k] * A; }
                    __builtin_amdgcn_sched_barrier(0);
                }
            }
            if (fr == 15) { const int rloc = u.pm * BM + ai * HALF + wr * 64;
                const int b = half * (TH / SEQ) + rloc / SEQ, j = (rloc % SEQ) / SCH; const size_t si = ((size_t)b * NSCH + j) * DR + ch;
                *(f32x4*)(AEND + si) = (f32x4){At[0], At[1], At[2], At[3]}; *(f32x4*)(AEND + si + 4) = (f32x4){At[4], At[5], At[6], At[7]};
                *(f32x4*)(HEND + si) = (f32x4){Ht[0], Ht[1], Ht[2], Ht[3]}; *(f32x4*)(HEND + si + 4) = (f32x4){Ht[4], Ht[5], Ht[6], Ht[7]}; }
            asm volatile("" ::: "memory");
        }
    }
};
struct EpiMix {
    static constexpr bool PERM = true;
    const bf16_t* GG; unsigned char* MG;
    __device__ __forceinline__ void hook(AccMut acc, const Unit& u, int wr, int wc, int fr, int fq) const {
        const int row0 = u.pm * BM + wr * 64 + fr;
        const int colt = u.pn * BM + wc * 32 + 8 * fq;
#pragma unroll
        EPI_LOOP_ROWS { const size_t r = (size_t)(row0 + ai * HALF + m * 16);
#pragma unroll
            for (int bj = 0; bj < 2; ++bj) { const int c = colt + bj * HALF; const u32x4 ga = *(const u32x4*)(GG + r * GGC + c), gr = *(const u32x4*)(GG + r * GGC + D + c);
                f32x4 q0, q1;
                q0[0] = bflo(ga.x) * __builtin_amdgcn_rcpf(bflo(gr.x)); q0[1] = bfhi(ga.x) * __builtin_amdgcn_rcpf(bfhi(gr.x)); q0[2] = bflo(ga.y) * __builtin_amdgcn_rcpf(bflo(gr.y)); q0[3] = bfhi(ga.y) * __builtin_amdgcn_rcpf(bfhi(gr.y));
                q1[0] = bflo(ga.z) * __builtin_amdgcn_rcpf(bflo(gr.z)); q1[1] = bfhi(ga.z) * __builtin_amdgcn_rcpf(bfhi(gr.z)); q1[2] = bflo(ga.w) * __builtin_amdgcn_rcpf(bflo(gr.w)); q1[3] = bfhi(ga.w) * __builtin_amdgcn_rcpf(bfhi(gr.w));
                acc[ai][bj][m][0] *= q0; acc[ai][bj][m][1] *= q1; }
            asm volatile("" ::: "memory"); }
    }
    __device__ __forceinline__ void operator()(AccRef acc, const Unit& u, int wr, int wc, int fr, int fq) const {
        const int row0 = u.pm * BM + wr * 64 + fr; const int colt = u.pn * BM + wc * 32 + 8 * fq;
#pragma unroll
        EPI_LOOP_ROWS { const size_t r = (size_t)(row0 + ai * HALF + m * 16);
#pragma unroll
            for (int bj = 0; bj < 2; ++bj) { const int c = colt + bj * HALF; const u32x4 g = *(const u32x4*)(GG + r * GGC + D + c);
                const f32x4 v0 = acc[ai][bj][m][0], v1 = acc[ai][bj][m][1];
                u32x2 w; w.x = pk4_fp8(4.f * bflo(g.x) * v0[0], 4.f * bfhi(g.x) * v0[1], 4.f * bflo(g.y) * v0[2], 4.f * bfhi(g.y) * v0[3]);
                w.y = pk4_fp8(4.f * bflo(g.z) * v1[0], 4.f * bfhi(g.z) * v1[1], 4.f * bflo(g.w) * v1[2], 4.f * bfhi(g.w) * v1[3]);
                *(u32x2*)(MG + r * D + c) = w; }
            asm volatile("" ::: "memory"); }
    }
};
struct EpiY {
    static constexpr bool PERM = false;
    const float* X0; float* Y;
    __device__ __forceinline__ void operator()(AccRef acc, const Unit& u, int wr, int wc, int fr, int fq) const {
        const int row0 = u.pm * BM + wr * 64 + fr, col0 = u.pn * BM + wc * 32 + 4 * fq;
#pragma unroll
        EPI_LOOP_ROWS { const size_t r = (size_t)(row0 + ai * HALF + m * 16);
#pragma unroll
            for (int bj = 0; bj < 2; ++bj)
#pragma unroll
                for (int n = 0; n < 2; ++n) { const int c = col0 + bj * HALF + n * 16; const f32x4 x = *(const f32x4*)(X0 + r * D + c);
                    st16f(Y + r * D + c, x * DN_ALPHA + acc[ai][bj][m][n]); }
            asm volatile("" ::: "memory"); }
    }
};
template <bool F8> struct EpiH {
    static constexpr bool PERM = true;
    bf16_t* H;
    __device__ __forceinline__ void operator()(AccRef acc, const Unit& u, int wr, int wc, int fr, int fq) const {
        const int row0 = u.pm * BM + wr * 64 + fr; const int col = u.pn * HALF + wc * 32 + 8 * fq;
#pragma unroll
        EPI_LOOP_ROWS { const size_t r = (size_t)(row0 + ai * HALF + m * 16);
            const f32x4 g0 = acc[ai][0][m][0], g1 = acc[ai][0][m][1], u0 = acc[ai][1][m][0], u1 = acc[ai][1][m][1];
            if constexpr (F8) { u32x2 w;
            w.x = pk4_fp8(4.f * g0[0] * fsigmoid(g0[0]) * u0[0], 4.f * g0[1] * fsigmoid(g0[1]) * u0[1], 4.f * g0[2] * fsigmoid(g0[2]) * u0[2], 4.f * g0[3] * fsigmoid(g0[3]) * u0[3]);
            w.y = pk4_fp8(4.f * g1[0] * fsigmoid(g1[0]) * u1[0], 4.f * g1[1] * fsigmoid(g1[1]) * u1[1], 4.f * g1[2] * fsigmoid(g1[2]) * u1[2], 4.f * g1[3] * fsigmoid(g1[3]) * u1[3]);
            *(u32x2*)((unsigned char*)H + r * FF + col) = w; } else {
            u32x4 w;
            w.x = cvt_pk_bf16(g0[0] * fsigmoid(g0[0]) * u0[0], g0[1] * fsigmoid(g0[1]) * u0[1]);
            w.y = cvt_pk_bf16(g0[2] * fsigmoid(g0[2]) * u0[2], g0[3] * fsigmoid(g0[3]) * u0[3]);
            w.z = cvt_pk_bf16(g1[0] * fsigmoid(g1[0]) * u1[0], g1[1] * fsigmoid(g1[1]) * u1[1]);
            w.w = cvt_pk_bf16(g1[2] * fsigmoid(g1[2]) * u1[2], g1[3] * fsigmoid(g1[3]) * u1[3]);
            st16(H + r * FF + col, w); } }
    }
};
struct EpiO {
    static constexpr bool PERM = true;
    bf16_t* O; const int* rowinfo;
    __device__ __forceinline__ void operator()(AccRef acc, const Unit& u, int wr, int wc, int fr, int fq) const {
        const int row0 = u.pm * BM + wr * 64 + fr; const int colt = u.pn * BM + wc * 32 + 8 * fq;
#pragma unroll
        EPI_LOOP_ROWS { const int dst = rowinfo[row0 + ai * HALF + m * 16];
            if (dst >= 0) { bf16_t* rowp = O + (size_t)dst * D + colt;
#pragma unroll
                for (int bj = 0; bj < 2; ++bj) { const f32x4 v0 = acc[ai][bj][m][0], v1 = acc[ai][bj][m][1];
                    u32x4 w; w.x = cvt_pk_bf16(v0[0], v0[1]); w.y = cvt_pk_bf16(v0[2], v0[3]); w.z = cvt_pk_bf16(v1[0], v1[1]); w.w = cvt_pk_bf16(v1[2], v1[3]);
                    st16(rowp + bj * HALF, w); } } }
    }
};
}

#define XB_TMO      128
#define XB_XCNT(j)  (256  + 64 * (j))
#define XB_XSUB(j)  (1280 + 64 * (j))
#define XB_XGEN(j)  (2304 + 64 * (j))
#define XB_TOP      3328
#define XB_TOPGEN   3392
#define XCD_BAR_WORDS 3456
#define XB_SPIN_CAP (1u << 18)
__device__ __forceinline__ unsigned xb_ld(unsigned* p)              { return __hip_atomic_load(p, __ATOMIC_RELAXED, __HIP_MEMORY_SCOPE_AGENT); }
__device__ __forceinline__ unsigned xb_add(unsigned* p, unsigned v) { return __hip_atomic_fetch_add(p, v, __ATOMIC_RELAXED, __HIP_MEMORY_SCOPE_AGENT); }
__device__ __forceinline__ unsigned xb_xcc_id() { return (unsigned)__builtin_amdgcn_s_getreg((3 << 11) | 20) & 0xFu; }
#define XB_SPIN(cond, bar) do { unsigned _sp = 0; while (cond) { __builtin_amdgcn_s_sleep(1); \
    if ((++_sp & 255u) == 0u) { if (xb_ld(&(bar)[XB_TMO])) break; if (_sp > XB_SPIN_CAP) { atomicAdd(&(bar)[XB_TMO], 1u); break; } } } } while (0)
struct XcdBarrier { unsigned* bar; unsigned x; volatile LAS unsigned* st; };
__device__ __forceinline__ XcdBarrier xcd_barrier_post(unsigned* bar, volatile LAS unsigned* st) {
    XcdBarrier b; b.bar = bar; b.x = xb_xcc_id(); b.st = st;
    if (threadIdx.x == 0) (void)xb_add(&bar[XB_XCNT(b.x)], 1u);
    return b;
}
__device__ __forceinline__ void xcd_barrier_complete(unsigned* bar, unsigned x, unsigned& nloc, unsigned& nx) {
    const unsigned G = gridDim.x * gridDim.y * gridDim.z;
    unsigned sum, cnt, mine, sp = 0u;
    for (;;) {
        sum = 0u; cnt = 0u; mine = 0u;
#pragma unroll
        for (unsigned j = 0; j < 16; ++j) { const unsigned c = xb_ld(&bar[XB_XCNT(j)]); sum += c; cnt += (c > 0u) ? 1u : 0u; mine = (j == x) ? c : mine; }
        if (sum == G) break;
        __builtin_amdgcn_s_sleep(1);
        if ((++sp & 255u) == 0u) { if (xb_ld(&bar[XB_TMO])) break; if (sp > XB_SPIN_CAP) { atomicAdd(&bar[XB_TMO], 1u); break; } }
    }
    nloc = mine > 0u ? mine : 1u; nx = cnt > 0u ? cnt : 1u;
}
__device__ __forceinline__ void xcd_barrier(const XcdBarrier& b) {
    asm volatile("s_waitcnt vmcnt(0)" ::: "memory");
    __syncthreads();
    if (threadIdx.x == 0) {
        unsigned* bar = b.bar;
        __builtin_amdgcn_s_waitcnt(0);
        unsigned nloc = b.st[0], nx = b.st[1];
        if (nloc == 0u) { xcd_barrier_complete(bar, b.x, nloc, nx); b.st[0] = nloc; b.st[1] = nx; }
        const unsigned old = xb_add(&bar[XB_XSUB(b.x)], 1u);
        const unsigned gen = old / nloc;
        if (old + 1u == (gen + 1u) * nloc) {
            __builtin_amdgcn_fence(__ATOMIC_RELEASE, "agent");
            asm volatile("s_waitcnt vmcnt(0)" ::: "memory");
            const unsigned og = xb_add(&bar[XB_TOP], 1u);
            const unsigned tg = og / nx;
            if (og + 1u == (tg + 1u) * nx) xb_add(&bar[XB_TOPGEN], 1u);
            else XB_SPIN(xb_ld(&bar[XB_TOPGEN]) == tg, bar);
            __builtin_amdgcn_fence(__ATOMIC_ACQUIRE, "agent");
            xb_add(&bar[XB_XGEN(b.x)], 1u);
            asm volatile("s_waitcnt vmcnt(0)" ::: "memory");
        } else {
            XB_SPIN(xb_ld(&bar[XB_XGEN(b.x)]) == gen, bar);
            __builtin_amdgcn_fence(__ATOMIC_ACQUIRE, "agent");
            asm volatile("s_waitcnt vmcnt(0)" ::: "memory");
        }
    }
    __syncthreads();
}

struct Args {
    const float* x; const float* w_in; const float* conv_a_w; const float* w_branch_a; const float* conv_r_w; const float* conv_r_b;
    const float* w_rg_a; const float* b_rg_a; const float* w_rg_x; const float* b_rg_x; const float* rg_lambda; const float* w_branch_r; const float* w_out;
    const float* ln1_g; const float* ln1_b; const float* w_router; const float* b_router; const float* w_exp_gate; const float* w_exp_up; const float* w_exp_down;
    const float* ln2_g; const float* ln2_b;
    float* out; unsigned char* ws; int ph_lo, ph_hi;
};

typedef const Args __attribute__((address_space(4)))* ArgsP;

__device__ __forceinline__ void transpose_item(const float* W, int N, int k0, int n0, bf16_t* WT, int ldk, int drow0, LAS float* scr, int lane) {
    float tv[32];
    { const float* wp = W + (size_t)(k0 + (lane >> 5)) * N + n0 + (lane & 31);
#pragma unroll
      for (int i = 0; i < 32; ++i) tv[i] = wp[(size_t)(2 * i) * N]; }
#pragma unroll
    for (int i = 0; i < 32; ++i) scr[(2 * i + (lane >> 5)) * 33 + (lane & 31)] = tv[i];
    LDS_WAIT(); asm volatile("" ::: "memory");
    const int c = lane & 7;
#pragma unroll
    for (int j = 0; j < 4; ++j) { const int n = (lane >> 3) + 8 * j; const LAS float* s = scr + (8 * c) * 33 + n;
        u32x4 o; o.x = cvt_pk_bf16(s[0 * 33], s[1 * 33]); o.y = cvt_pk_bf16(s[2 * 33], s[3 * 33]); o.z = cvt_pk_bf16(s[4 * 33], s[5 * 33]); o.w = cvt_pk_bf16(s[6 * 33], s[7 * 33]);
        st16(WT + (size_t)(drow0 + n) * ldk + k0 + 8 * c, o); }
    LDS_WAIT(); asm volatile("" ::: "memory");
}
__device__ __forceinline__ void transpose_item8(const float* W, int N, int k0, int n0, unsigned char* WT, int ldk, int drow0, float sc, LAS float* scr, int lane) {
    float tv[32];
    { const float* wp = W + (size_t)(k0 + (lane >> 5)) * N + n0 + (lane & 31);
#pragma unroll
      for (int i = 0; i < 32; ++i) tv[i] = wp[(size_t)(2 * i) * N]; }
#pragma unroll
    for (int i = 0; i < 32; ++i) scr[(2 * i + (lane >> 5)) * 33 + (lane & 31)] = tv[i];
    LDS_WAIT(); asm volatile("" ::: "memory");
    const int c = lane & 7;
#pragma unroll
    for (int j = 0; j < 4; ++j) { const int n = (lane >> 3) + 8 * j; const LAS float* s = scr + (8 * c) * 33 + n;
        u32x2 o; o.x = pk4_fp8(sc * s[0 * 33], sc * s[1 * 33], sc * s[2 * 33], sc * s[3 * 33]); o.y = pk4_fp8(sc * s[4 * 33], sc * s[5 * 33], sc * s[6 * 33], sc * s[7 * 33]);
        *(u32x2*)(WT + (size_t)(drow0 + n) * ldk + k0 + 8 * c) = o; }
    LDS_WAIT(); asm volatile("" ::: "memory");
}
__device__ __forceinline__ void transpose_plain(const float* W, int K, int N, bf16_t* WT, int item, LAS float* scr, int lane) {
    const int nblk = N / 32, kb = item / nblk, nb = item % nblk;
    transpose_item(W, N, 64 * kb, 32 * nb, WT, K, 32 * nb, scr, lane);
}

__device__ __forceinline__ void prep_tm_weights(ArgsP a, int l, unsigned char* ws, LAS float* scr, int gw, int NGW, int lane) {
    constexpr int I_IN = (D / 64) * (DIN / 32), I_A = (D / 64) * (D / 32), I_R = (DR / 64) * (D / 32), I_O = I_A, I_G = 2 * NHEAD * 2 * 4;
    constexpr int NITEMS = I_IN + I_A + I_R + I_O + I_G;
    if (gw < 20) { const int c = gw * 64 + lane; float* PC = (float*)(ws + WS_SMALL + SM_PCONST);
        PC[c] = 8.0f * log1pf(__expf(-a->rg_lambda[(size_t)l * DR + c])); PC[DR + c] = a->b_rg_a[(size_t)l * DR + c]; PC[2 * DR + c] = a->b_rg_x[(size_t)l * DR + c]; }
    for (int it = gw; it < NITEMS; it += NGW) {
        int r = it;
        if (r < I_IN) { const int nblk = DIN / 32, kb = r / nblk, n0 = 32 * (r % nblk);
            const int drow0 = n0 < 1024 ? (n0 >> 7) * 256 + (n0 & 127) : (n0 < 2048 ? n0 + 1024 : (n0 < 3072 ? ((n0 - 2048) >> 7) * 256 + 128 + (n0 & 127) : n0));
            transpose_item8(a->w_in + (size_t)l * D * DIN, DIN, 64 * kb, n0, ws + WS_WIN, D, drow0, 32.f, scr, lane); continue; } r -= I_IN;
        if (r < I_A) { const int kb = r / (D / 32), nb = r % (D / 32); transpose_item8(a->w_branch_a + (size_t)l * D * D, D, 64 * kb, 32 * nb, ws + WS_WA, UC, 32 * nb, 64.f, scr, lane); continue; } r -= I_A;
        if (r < I_R) { const int kb = r / (D / 32), nb = r % (D / 32); transpose_item8(a->w_branch_r + (size_t)l * DR * D, D, 64 * kb, 32 * nb, ws + WS_WA + D, UC, 32 * nb, 16.f, scr, lane); continue; } r -= I_R;
        if (r < I_O) { const int kb = r / (D / 32), nb = r % (D / 32); transpose_item8(a->w_out + (size_t)l * D * D, D, 64 * kb, 32 * nb, ws + WS_WO, D, 32 * nb, 64.f, scr, lane); continue; } r -= I_O;
        {
            const int nb = r & 3, kb = (r >> 2) & 1, hw = r >> 3, which = hw & 1, hh = hw >> 1;
            const float* W = (which ? a->w_rg_x : a->w_rg_a) + ((size_t)l * NHEAD + hh) * 128 * 128;
            transpose_item(W, 128, 64 * kb, 32 * nb, (bf16_t*)(ws + WS_WG), 128, hh * 256 + which * 128 + 32 * nb, scr, lane);
        }
    }
}
template <bool F8>
__device__ __forceinline__ void prep_expert_weights(ArgsP a, int l, unsigned char* ws, LAS float* scr, int gw, int NGW, int lane) {
    constexpr int I_G = (D / 64) * (FF / 32), I_D = (FF / 64) * (D / 32), PER_E = 2 * I_G + I_D, ES = F8 ? 1 : 2;
    unsigned char* WGU = ws + WS_WEX; unsigned char* WDN = WGU + (size_t)NE * 1024 * 1024 * ES;
    for (int it = gw; it < NE * PER_E; it += NGW) {
        const int e = it / PER_E; int r = it % PER_E;
        if (r < 2 * I_G) { const int which = r / I_G; r %= I_G; const int nblk = FF / 32, kb = r / nblk, nb = r % nblk, n0 = 32 * nb;
            const float* W = (which ? a->w_exp_up : a->w_exp_gate) + ((size_t)l * NE + e) * D * FF;
            const int drow0 = (n0 >> 7) * 256 + which * 128 + (n0 & 127);
            if constexpr (F8) transpose_item8(W, FF, 64 * kb, n0, WGU + (size_t)e * 1024 * 1024, D, drow0, 32.f, scr, lane);
            else transpose_item(W, FF, 64 * kb, n0, (bf16_t*)WGU + (size_t)e * 1024 * 1024, D, drow0, scr, lane);
        } else { r -= 2 * I_G; const float* W = a->w_exp_down + ((size_t)l * NE + e) * FF * D; const int kb = r / (D / 32), nb = r % (D / 32);
            if constexpr (F8) transpose_item8(W, D, 64 * kb, 32 * nb, WDN + (size_t)e * 1024 * 512, FF, 32 * nb, 32.f, scr, lane);
            else transpose_item(W, D, 64 * kb, 32 * nb, (bf16_t*)WDN + (size_t)e * 1024 * 512, FF, 32 * nb, scr, lane); }
    }
}
__device__ __forceinline__ void cvt_x(const float* x, unsigned char* xb, int gtid, int nthr) {
    for (size_t i = gtid; i < (size_t)T * D / 8; i += (size_t)4 * nthr) {
        f32x4 a[4], b[4];
#pragma unroll
        for (int k = 0; k < 4; ++k) { a[k] = *(const f32x4*)(x + (i + (size_t)k * nthr) * 8); b[k] = *(const f32x4*)(x + (i + (size_t)k * nthr) * 8 + 4); }
#pragma unroll
        for (int k = 0; k < 4; ++k) { u32x2 w; w.x = pk4_fp8(a[k][0], a[k][1], a[k][2], a[k][3]); w.y = pk4_fp8(b[k][0], b[k][1], b[k][2], b[k][3]); *(u32x2*)(xb + (i + (size_t)k * nthr) * 8) = w; } }
}
__device__ __forceinline__ void unpack8(const u32x4 w, float (&f)[8]) { f[0] = bflo(w.x); f[1] = bfhi(w.x); f[2] = bflo(w.y); f[3] = bfhi(w.y); f[4] = bflo(w.z); f[5] = bfhi(w.z); f[6] = bflo(w.w); f[7] = bfhi(w.w); }
__device__ __forceinline__ u32x4 pack8(const float (&f)[8]) { u32x4 w; w.x = cvt_pk_bf16(f[0], f[1]); w.y = cvt_pk_bf16(f[2], f[3]); w.z = cvt_pk_bf16(f[4], f[5]); w.w = cvt_pk_bf16(f[6], f[7]); return w; }

__device__ __forceinline__ void phase_e1(ArgsP a, int l, int half, unsigned char* ws, int gtid, int nthr) {
    const bf16_t* Z = (const bf16_t*)(ws + WS_Z); unsigned char* UA = ws + WS_U + (size_t)half * TH * UC; bf16_t* XC = (bf16_t*)(ws + WS_XC);
    constexpr int RUN = 8;
    constexpr int NA = (TH / RUN) * (D / 8), NR = (TH / RUN) * (DR / 8);
    for (int it = gtid; it < NA + NR; it += nthr) {
        if (it < NA) {
            const int cg = it % (D / 8), run = it / (D / 8), t0 = run * RUN, c0 = cg * 8;
            const bool first = (t0 & (SEQ - 1)) == 0;
            u32x4 vv[RUN + 2], bw[RUN];
            vv[0] = first ? (u32x4){0u, 0u, 0u, 0u} : *(const u32x4*)(Z + (size_t)(t0 - 2) * ZC + c0);
            vv[1] = first ? (u32x4){0u, 0u, 0u, 0u} : *(const u32x4*)(Z + (size_t)(t0 - 1) * ZC + c0);
#pragma unroll
            for (int i = 0; i < RUN; ++i) { vv[i + 2] = *(const u32x4*)(Z + (size_t)(t0 + i) * ZC + c0); bw[i] = *(const u32x4*)(Z + (size_t)(t0 + i) * ZC + D + c0); }
            float w0[8], w1[8], w2[8];
            { const float* cw = a->conv_a_w + (size_t)l * 3 * D + c0;
#pragma unroll
              for (int j = 0; j < 8; ++j) { w0[j] = cw[j]; w1[j] = cw[D + j]; w2[j] = cw[2 * D + j]; } }
            float vm2[8], vm1[8]; unpack8(vv[0], vm2); unpack8(vv[1], vm1);
#pragma unroll
            for (int i = 0; i < RUN; ++i) { float v[8], bb[8], o[8]; unpack8(vv[i + 2], v); unpack8(bw[i], bb);
#pragma unroll
                for (int j = 0; j < 8; ++j) { o[j] = bb[j] * (w0[j] * vm2[j] + w1[j] * vm1[j] + w2[j] * v[j]); vm2[j] = vm1[j]; vm1[j] = v[j]; }
                u32x2 w8; w8.x = pk4_fp8(o[0], o[1], o[2], o[3]); w8.y = pk4_fp8(o[4], o[5], o[6], o[7]); *(u32x2*)(UA + (size_t)(t0 + i) * UC + c0) = w8; }
        } else {
            const int r = it - NA; const int cg = r % (DR / 8), run = r / (DR / 8), t0 = run * RUN, c0 = cg * 8;
            const bool first = (t0 & (SEQ - 1)) == 0;
            u32x4 xv[RUN + 3];
#pragma unroll
            for (int i = 0; i < 3; ++i) xv[i] = first ? (u32x4){0u, 0u, 0u, 0u} : *(const u32x4*)(Z + (size_t)(t0 - 3 + i) * ZC + 2 * D + c0);
#pragma unroll
            for (int i = 0; i < RUN; ++i) xv[i + 3] = *(const u32x4*)(Z + (size_t)(t0 + i) * ZC + 2 * D + c0);
            float w0[8], w1[8], w2[8], w3[8], bi[8];
            { const float* cw = a->conv_r_w + (size_t)l * 4 * DR + c0; const float* cb = a->conv_r_b + (size_t)l * DR + c0;
#pragma unroll
              for (int j = 0; j < 8; ++j) { w0[j] = cw[j]; w1[j] = cw[DR + j]; w2[j] = cw[2 * DR + j]; w3[j] = cw[3 * DR + j]; bi[j] = cb[j]; } }
            float x3[8], x2[8], x1[8]; unpack8(xv[0], x3); unpack8(xv[1], x2); unpack8(xv[2], x1);
#pragma unroll
            for (int i = 0; i < RUN; ++i) { float x0[8], o[8]; unpack8(xv[i + 3], x0);
#pragma unroll
                for (int j = 0; j < 8; ++j) { o[j] = w0[j] * x3[j] + w1[j] * x2[j] + w2[j] * x1[j] + w3[j] * x0[j] + bi[j]; x3[j] = x2[j]; x2[j] = x1[j]; x1[j] = x0[j]; }
                st16(XC + (size_t)(t0 + i) * DR + c0, pack8(o)); }
        }
    }
}

__device__ __forceinline__ void phase_scan(unsigned char* ws, int gtid, int nthr) {
    const bf16_t* GT = (const bf16_t*)(ws + WS_GT); const bf16_t* YR = (const bf16_t*)(ws + WS_YR);
    const float* AEND = (const float*)(ws + WS_SMALL + SM_AEND); const float* HEND = (const float*)(ws + WS_SMALL + SM_HEND);
    unsigned char* UR = ws + WS_U + D;
    constexpr int NP = DR / 4, NITEMS = NBATCH * NSCH * NP, BT = 16;
    for (int it = gtid; it < NITEMS; it += nthr) {
        const int cp = it % NP, j = (it / NP) % NSCH, b = it / (NP * NSCH), c = 4 * cp, hh = c >> 7, cc = c & 127;
        f32x4 h = (f32x4){0.f, 0.f, 0.f, 0.f};
        { const size_t sb = (size_t)b * NSCH * DR + c; int jj = 0;
          for (; jj + 8 <= j; jj += 8) { f32x4 ae[8], he[8];
#pragma unroll
              for (int k = 0; k < 8; ++k) { ae[k] = *(const f32x4*)(AEND + sb + (size_t)(jj + k) * DR); he[k] = *(const f32x4*)(HEND + sb + (size_t)(jj + k) * DR); }
#pragma unroll
              for (int k = 0; k < 8; ++k) h = ae[k] * h + he[k]; }
          for (; jj < j; ++jj) { const f32x4 ae = *(const f32x4*)(AEND + sb + (size_t)jj * DR), he = *(const f32x4*)(HEND + sb + (size_t)jj * DR); h = ae * h + he; } }
        const size_t row0 = (size_t)b * SEQ + (size_t)j * SCH;
        const bf16_t* gl = GT + row0 * 2560 + hh * 256 + cc; const bf16_t* zy = YR + row0 * DR + c; unsigned char* ur = UR + row0 * UC + c;
#pragma unroll 1
        for (int t0 = 0; t0 < SCH; t0 += BT) {
            u32x2 lw[BT], bw[BT], yw[BT];
#pragma unroll
            for (int k = 0; k < BT; ++k) { lw[k] = *(const u32x2*)(gl + (size_t)(t0 + k) * 2560); bw[k] = *(const u32x2*)(gl + (size_t)(t0 + k) * 2560 + 128); yw[k] = *(const u32x2*)(zy + (size_t)(t0 + k) * DR); }
#pragma unroll
            for (int k = 0; k < BT; ++k) {
                h[0] = __builtin_amdgcn_exp2f(1.4426950408889634f * bflo(lw[k].x)) * h[0] + bflo(bw[k].x); h[1] = __builtin_amdgcn_exp2f(1.4426950408889634f * bfhi(lw[k].x)) * h[1] + bfhi(bw[k].x);
                h[2] = __builtin_amdgcn_exp2f(1.4426950408889634f * bflo(lw[k].y)) * h[2] + bflo(bw[k].y); h[3] = __builtin_amdgcn_exp2f(1.4426950408889634f * bfhi(lw[k].y)) * h[3] + bfhi(bw[k].y);
                *(unsigned*)(ur + (size_t)(t0 + k) * UC) = pk4_fp8(4.f * h[0] * bflo(yw[k].x), 4.f * h[1] * bfhi(yw[k].x), 4.f * h[2] * bflo(yw[k].y), 4.f * h[3] * bfhi(yw[k].y)); }
        }
    }
}

template <bool moe8>
__device__ __forceinline__ void phase_ln1_router(ArgsP a, int l, unsigned char* ws, LAS unsigned char* lds, int tid, int lane, int gw, int NGW, int vcu) {
    LAS f32x4* wl = (LAS f32x4*)lds;
    for (int idx = tid; idx < 4096; idx += 512) { const int ln = idx & 63, q = (idx >> 6) & 3, jk = idx >> 8, d = 4 * ln + 256 * (jk >> 2) + (jk & 3);
        wl[idx] = *(const f32x4*)(a->w_router + (size_t)d * NE + 4 * q); }
    LAS unsigned* lcnt = (LAS unsigned*)(lds + 65536);
    if (tid < NE) lcnt[tid] = 0u;
    __syncthreads();
    const float* Y = (const float*)(ws + WS_Y); float* X1 = (float*)(ws + WS_X1); bf16_t* XB = (bf16_t*)(ws + WS_XB);
    unsigned* TOKE = (unsigned*)(ws + WS_SMALL + SM_TOKE); unsigned* TOKP = (unsigned*)(ws + WS_SMALL + SM_TOKP); float* TOKW = (float*)(ws + WS_SMALL + SM_TOKW);
    f32x4 gv[4], bv[4];
#pragma unroll
    for (int j = 0; j < 4; ++j) { gv[j] = *(const f32x4*)(a->ln1_g + (size_t)l * D + 4 * lane + 256 * j); bv[j] = *(const f32x4*)(a->ln1_b + (size_t)l * D + 4 * lane + 256 * j); }
    float br[16];
#pragma unroll
    for (int e = 0; e < 16; ++e) br[e] = a->b_router[e];
    for (int t = gw; t < T; t += NGW) {
        f32x4 v[4]; float s = 0.f;
#pragma unroll
        for (int j = 0; j < 4; ++j) { v[j] = *(const f32x4*)(Y + (size_t)t * D + 4 * lane + 256 * j); s += (v[j][0] + v[j][1]) + (v[j][2] + v[j][3]); }
        const float mean = wave_sum(s, lane) * (1.f / D); float s2 = 0.f;
#pragma unroll
        for (int j = 0; j < 4; ++j) { v[j] = v[j] - mean; s2 += (v[j][0] * v[j][0] + v[j][1] * v[j][1]) + (v[j][2] * v[j][2] + v[j][3] * v[j][3]); }
        const float rstd = 1.f / sqrtf(wave_sum(s2, lane) * (1.f / D) + LN_EPS);
        float acc[16];
#pragma unroll
        for (int e = 0; e < 16; ++e) acc[e] = 0.f;
#pragma unroll
        for (int j = 0; j < 4; ++j) { v[j] = v[j] * rstd * gv[j] + bv[j];
            st16f(X1 + (size_t)t * D + 4 * lane + 256 * j, v[j]);
            if constexpr (moe8) *(unsigned*)((unsigned char*)XB + (size_t)t * D + 4 * lane + 256 * j) = pk4_fp8(v[j][0], v[j][1], v[j][2], v[j][3]);
            else { u32x2 w; w.x = cvt_pk_bf16(v[j][0], v[j][1]); w.y = cvt_pk_bf16(v[j][2], v[j][3]); *(u32x2*)(XB + (size_t)t * D + 4 * lane + 256 * j) = w; }
#pragma unroll
            for (int k = 0; k < 4; ++k) { const float xv = v[j][k];
#pragma unroll
                for (int q = 0; q < 4; ++q) { const f32x4 w4 = wl[((j * 4 + k) * 4 + q) * 64 + lane]; acc[4 * q] += xv * w4[0]; acc[4 * q + 1] += xv * w4[1]; acc[4 * q + 2] += xv * w4[2]; acc[4 * q + 3] += xv * w4[3]; } } }
        float r8[8], r4[4], r2[2], r1;
        { const bool hi = (lane & 32) != 0;
#pragma unroll
          for (int i = 0; i < 8; ++i) { const float keep = hi ? acc[i + 8] : acc[i], send = hi ? acc[i] : acc[i + 8]; r8[i] = keep + lane_xor(send, 32, lane); } }
        { const bool hi = (lane & 16) != 0;
#pragma unroll
          for (int i = 0; i < 4; ++i) { const float keep = hi ? r8[i + 4] : r8[i], send = hi ? r8[i] : r8[i + 4]; r4[i] = keep + lane_xor(send, 16, lane); } }
        { const bool hi = (lane & 8) != 0;
#pragma unroll
          for (int i = 0; i < 2; ++i) { const float keep = hi ? r4[i + 2] : r4[i], send = hi ? r4[i] : r4[i + 2]; r2[i] = keep + lane_xor(send, 8, lane); } }
        { const bool hi = (lane & 4) != 0; const float keep = hi ? r2[1] : r2[0], send = hi ? r2[0] : r2[1]; r1 = keep + lane_xor(send, 4, lane); }
        r1 += lane_xor(r1, 2, lane); r1 += lane_xor(r1, 1, lane);
        float lg[16]; float mx = -3.0e38f;
#pragma unroll
        for (int e = 0; e < 16; ++e) { lg[e] = lane_get(r1, 4 * e) + br[e]; mx = fmaxf(mx, lg[e]); }
        float p[16];
#pragma unroll
        for (int e = 0; e < 16; ++e) p[e] = __expf(lg[e] - mx);
        int gsel = 0; float gbest = -1.f;
#pragma unroll
        for (int g = 0; g < 4; ++g) { const float p0 = p[4 * g], p1 = p[4 * g + 1], p2 = p[4 * g + 2], p3 = p[4 * g + 3];
            const float sum = (p0 + p1) + (p2 + p3), mn1 = fminf(fminf(p0, p1), fminf(p2, p3));
            const float hi01 = fmaxf(p0, p1), lo01 = fminf(p0, p1), hi23 = fmaxf(p2, p3), lo23 = fminf(p2, p3);
            const float top1 = fmaxf(hi01, hi23), top2 = fmaxf(fminf(hi01, hi23), fmaxf(lo01, lo23));
            (void)sum; (void)mn1;
            const float sc = top1 + top2; if (sc > gbest) { gbest = sc; gsel = g; } }
        float q0, q1, q2, q3;
        q0 = gsel == 0 ? p[0] : gsel == 1 ? p[4] : gsel == 2 ? p[8] : p[12];
        q1 = gsel == 0 ? p[1] : gsel == 1 ? p[5] : gsel == 2 ? p[9] : p[13];
        q2 = gsel == 0 ? p[2] : gsel == 1 ? p[6] : gsel == 2 ? p[10] : p[14];
        q3 = gsel == 0 ? p[3] : gsel == 1 ? p[7] : gsel == 2 ? p[11] : p[15];
        int i1 = 0; float v1 = q0;
        if (q1 > v1) { v1 = q1; i1 = 1; } if (q2 > v1) { v1 = q2; i1 = 2; } if (q3 > v1) { v1 = q3; i1 = 3; }
        int i2 = -1; float v2 = -1.f;
        if (i1 != 0 && q0 > v2) { v2 = q0; i2 = 0; } if (i1 != 1 && q1 > v2) { v2 = q1; i2 = 1; } if (i1 != 2 && q2 > v2) { v2 = q2; i2 = 2; } if (i1 != 3 && q3 > v2) { v2 = q3; i2 = 3; }
        const float inv = 1.0f / (v1 + v2);
        if (lane == 0) { const int e1 = 4 * gsel + i1, e2 = 4 * gsel + i2;
            const unsigned pos1 = __hip_atomic_fetch_add(lcnt + e1, 1u, __ATOMIC_RELAXED, __HIP_MEMORY_SCOPE_WORKGROUP);
            const unsigned pos2 = __hip_atomic_fetch_add(lcnt + e2, 1u, __ATOMIC_RELAXED, __HIP_MEMORY_SCOPE_WORKGROUP);
            TOKE[t] = (unsigned)e1 | ((unsigned)e2 << 8); TOKP[2 * t] = pos1; TOKP[2 * t + 1] = pos2; TOKW[2 * t] = v1 * inv; TOKW[2 * t + 1] = v2 * inv; }
    }
    __syncthreads();
    if (tid < NE) ((unsigned*)(ws + WS_SMALL + SM_WGCNT))[vcu * NE + tid] = lcnt[tid];
}

__device__ __forceinline__ void phase_moe_lists(unsigned char* ws, LAS unsigned char* lds, int tid, int lane, int gw, int NGW, int vcu, int G, bool moe8) {
    unsigned* ctl = (unsigned*)(ws + WS_CTL);
    LAS unsigned* off = (LAS unsigned*)lds;
    { const unsigned* WGCNT = (const unsigned*)(ws + WS_SMALL + SM_WGCNT);
      const int e = tid & 15, p = tid >> 4; unsigned tot = 0, pre = 0;
      for (int v = p; v < G; v += 32) { const unsigned c = WGCNT[v * NE + e]; tot += c; pre += (v < vcu) ? c : 0u; }
      off[128 + p * 16 + e] = tot; off[128 + 512 + p * 16 + e] = pre; }
    __syncthreads();
    if (tid < NE) { unsigned tot = 0, pre = 0; for (int p = 0; p < 32; ++p) { tot += off[128 + p * 16 + tid]; pre += off[128 + 512 + p * 16 + tid]; } off[32 + tid] = tot; off[48 + tid] = pre; }
    __syncthreads();
    if (tid == 0) { unsigned o = 0;
        for (int e = 0; e < NE; ++e) { const unsigned c = off[32 + e]; off[e] = o; off[64 + e] = o + off[48 + e]; o += (c + 255u) & ~255u; }
        off[16] = o; }
    __syncthreads();
    int* ROWINFO = (int*)(ws + WS_SMALL + SM_ROWINFO);
    if (blockIdx.x == 0) {
        if (tid == 0) ctl[CW_NTILES] = off[16] >> 8;
        if (tid < NE) { const unsigned t0 = off[tid] >> 8, t1 = off[tid + 1] >> 8; for (unsigned tt = t0; tt < t1; ++tt) ctl[CW_TILEE + tt] = (unsigned)tid; }
        for (int e = 0; e < NE; ++e) { const unsigned p0 = off[e] + off[32 + e], p1 = off[e + 1]; for (unsigned r = p0 + tid; r < p1; r += 512) ROWINFO[r] = -1; }
    }
    const bf16_t* XB = (const bf16_t*)(ws + WS_XB); bf16_t* XG = (bf16_t*)(ws + WS_XG);
    const unsigned* TOKE = (const unsigned*)(ws + WS_SMALL + SM_TOKE); const unsigned* TOKP = (const unsigned*)(ws + WS_SMALL + SM_TOKP);
    for (int t = gw; t < T; t += NGW) {
        const unsigned ee = TOKE[t]; const unsigned r1 = off[64 + (ee & 255u)] + TOKP[2 * t], r2 = off[64 + ((ee >> 8) & 255u)] + TOKP[2 * t + 1];
        if (moe8) { const u32x4 v0 = *(const u32x4*)((const unsigned char*)XB + (size_t)t * D + 16 * lane);
            st16((unsigned char*)XG + (size_t)r1 * D + 16 * lane, v0); st16((unsigned char*)XG + (size_t)r2 * D + 16 * lane, v0);
        } else { const u32x4 v0 = *(const u32x4*)(XB + (size_t)t * D + 8 * lane), v1 = *(const u32x4*)(XB + (size_t)t * D + 512 + 8 * lane);
            st16(XG + (size_t)r1 * D + 8 * lane, v0); st16(XG + (size_t)r1 * D + 512 + 8 * lane, v1);
            st16(XG + (size_t)r2 * D + 8 * lane, v0); st16(XG + (size_t)r2 * D + 512 + 8 * lane, v1); }
        if (lane == 0) { ROWINFO[r1] = 2 * t; ROWINFO[r2] = 2 * t + 1; }
    }
}

__device__ __forceinline__ void phase_ln2(ArgsP a, int l, unsigned char* ws, float* out, int lane, int gw, int NGW) {
    const float* X1 = (const float*)(ws + WS_X1); const bf16_t* O = (const bf16_t*)(ws + WS_O); unsigned char* X8 = ws + WS_XB;
    const float* TOKW = (const float*)(ws + WS_SMALL + SM_TOKW);
    f32x4 gv[4], bv[4];
#pragma unroll
    for (int j = 0; j < 4; ++j) { gv[j] = *(const f32x4*)(a->ln2_g + (size_t)l * D + 4 * lane + 256 * j); bv[j] = *(const f32x4*)(a->ln2_b + (size_t)l * D + 4 * lane + 256 * j); }
    for (int t = gw; t < T; t += NGW) {
        const float w1 = TOKW[2 * t], w2 = TOKW[2 * t + 1];
        f32x4 v[4]; float s = 0.f;
#pragma unroll
        for (int j = 0; j < 4; ++j) { const f32x4 x = *(const f32x4*)(X1 + (size_t)t * D + 4 * lane + 256 * j);
            const u32x2 o1 = *(const u32x2*)(O + (size_t)(2 * t) * D + 4 * lane + 256 * j), o2 = *(const u32x2*)(O + (size_t)(2 * t + 1) * D + 4 * lane + 256 * j);
            f32x4 mo; mo[0] = w1 * bflo(o1.x) + w2 * bflo(o2.x); mo[1] = w1 * bfhi(o1.x) + w2 * bfhi(o2.x); mo[2] = w1 * bflo(o1.y) + w2 * bflo(o2.y); mo[3] = w1 * bfhi(o1.y) + w2 * bfhi(o2.y);
            v[j] = x * DN_ALPHA + mo; s += (v[j][0] + v[j][1]) + (v[j][2] + v[j][3]); }
        const float mean = wave_sum(s, lane) * (1.f / D); float s2 = 0.f;
#pragma unroll
        for (int j = 0; j < 4; ++j) { v[j] = v[j] - mean; s2 += (v[j][0] * v[j][0] + v[j][1] * v[j][1]) + (v[j][2] * v[j][2] + v[j][3] * v[j][3]); }
        const float rstd = 1.f / sqrtf(wave_sum(s2, lane) * (1.f / D) + LN_EPS);
#pragma unroll
        for (int j = 0; j < 4; ++j) { v[j] = v[j] * rstd * gv[j] + bv[j];
            st16f(out + (size_t)t * D + 4 * lane + 256 * j, v[j]);
            *(unsigned*)(X8 + (size_t)t * D + 4 * lane + 256 * j) = pk4_fp8(v[j][0], v[j][1], v[j][2], v[j][3]); }
    }
}

constexpr int STEPS_PER_LAYER = 4 * NCHUNK + 7;
constexpr int N_STEPS = 1 + DEPTH * STEPS_PER_LAYER;

__global__ void __launch_bounds__(512, 2) mk_fwd(Args args_by_value) {
    (void)args_by_value;
    extern __shared__ __attribute__((aligned(16))) unsigned char lds_raw[];
    LAS unsigned char* lds = (LAS unsigned char*)lds_raw;
    volatile LAS unsigned* MISC = (volatile LAS unsigned*)(lds + MISC_OFF);
    const int tid0 = threadIdx.x;
    const int wave0 = __builtin_amdgcn_readfirstlane(tid0 >> 6);
    const int G = gridDim.x; const int bx = blockIdx.x; const int vcu0 = (G % 8 == 0) ? (bx % 8) * (G / 8) + bx / 8 : bx;
    const int NGW = G * 8, nthr = G * 512;
    ArgsP ap0 = (ArgsP)__builtin_amdgcn_kernarg_segment_ptr();
    unsigned char* ws0 = ap0->ws;
    unsigned* ctl = (unsigned*)(ws0 + WS_CTL);
    for (int u = tid0; u < (LDS_BYTES - LDSCTL_OFF) / 4; u += 512) ((LAS unsigned*)(lds + LDSCTL_OFF))[u] = 0u;
    __syncthreads();
    XcdBarrier bar; bar.bar = ctl + CW_BAR; bar.x = 0; bar.st = nullptr;
    if (!MK_PER_STEP_LAUNCH) bar = xcd_barrier_post(ctl + CW_BAR, MISC + 8);
    const int lo = ap0->ph_lo, hi = ap0->ph_hi;
    int step = 0;
    if ((MK_TP >= 0 || MK_TQ >= 0) && bx == 0 && tid0 == 0) { volatile LAS unsigned long long* tw_ = (volatile LAS unsigned long long*)(lds + LDSCTL_OFF + 512); tw_[0] = __builtin_amdgcn_s_memrealtime(); tw_[1] = 0; tw_[2] = 0; }
#ifndef MK_MASK
#define MK_MASK 0xFFFFFFFFu
#endif
#ifndef MK_REPEAT
#define MK_REPEAT 0u
#endif
#ifndef MK_BAR2
#define MK_BAR2 0
#endif
#define STEP_BEGIN(id) if (((MK_MASK >> (id)) & 1u) && lo <= step && step < hi) { const int step_id_ = (id); (void)step_id_; for (int rep = 0; rep < 1 + (int)((MK_REPEAT >> (id)) & 1u); ++rep) { if (rep) __syncthreads(); unsigned char* ws = ws0; asm volatile("" : "+s"(ws)); ArgsP args = ap0; asm volatile("" : "+s"(args)); int lz_ = 0; asm volatile("" : "+v"(lz_)); int wv_ = wave0; asm volatile("" : "+s"(wv_)); int vcu = vcu0; asm volatile("" : "+s"(vcu)); \
    const int lane = (int)__builtin_amdgcn_mbcnt_hi(~0u, __builtin_amdgcn_mbcnt_lo(~0u, (unsigned)lz_)), wave = wv_, tid = wave * 64 + lane, gw = vcu * 8 + wave, gtid = vcu * 512 + tid; LAS float* scr = (LAS float*)(lds + wave * 16384); (void)lane; (void)gw; (void)gtid; (void)scr;
#define STEP_END   } if (step + 1 < hi) { if (MK_PER_STEP_LAUNCH) {} else { xcd_barrier(bar); if (MK_BAR2) xcd_barrier(bar); } } \
    if ((MK_TP >= 0 || MK_TQ >= 0) && bx == 0 && tid0 == 0) { const unsigned long long now_ = __builtin_amdgcn_s_memrealtime(); volatile LAS unsigned long long* tw_ = (volatile LAS unsigned long long*)(lds + LDSCTL_OFF + 512); \
        const unsigned long long dt_ = now_ - tw_[0]; tw_[0] = now_; if (step_id_ == MK_TP) tw_[1] += dt_; if (step_id_ == MK_TQ) tw_[2] += dt_; } } ++step;

    STEP_BEGIN(0)
        prep_tm_weights(args, 0, ws, scr, gw, NGW, lane);
        cvt_x(args->x, ws + WS_XB, gtid, nthr);
    STEP_END

#pragma unroll 1
    for (int l = 0; l < DEPTH; ++l) {

#pragma unroll 1
        for (int half = 0; half < NCHUNK; ++half) {
            STEP_BEGIN(1)
                pg8::SchedPlain S{TH / 256, DIN / 256, G, bx, (const char*)(ws + WS_XB) + (size_t)half * TH * D, (const char*)(ws + WS_WIN), (size_t)256 * D, (size_t)256 * D, 0};
                pg8::EpiZ E{(bf16_t*)(ws + WS_Z), (bf16_t*)(ws + WS_GG), (bf16_t*)(ws + WS_YR), half * TH};
                pg8::gemm_phase<pg8::EpiZ, pg8::SchedPlain, true, -1, true>(lds, D, D, D, S, E, tid, 0x7a7a7a7a);
            STEP_END
            STEP_BEGIN(2)
                phase_e1(args, l, half, ws, gtid, nthr);
            STEP_END
            STEP_BEGIN(3)
                pg8::SchedPlain S{TH / 256, NHEAD, G, bx, (const char*)(ws + WS_XC), (const char*)(ws + WS_WG), (size_t)256 * DR * 2, (size_t)256 * 128 * 2, (size_t)128 * 2};
                LAS unsigned* pcl = (LAS unsigned*)(lds + LDSCTL_OFF + 1024);
                { const float* PC = (const float*)(ws + WS_SMALL + SM_PCONST);
                  for (int c = tid; c < DR; c += 512) pcl[c] = cvt_pk_bf16(PC[c], PC[DR + c]);
                  for (int c = tid; c < DR / 2; c += 512) pcl[DR + c] = cvt_pk_bf16(PC[2 * DR + 2 * c], PC[2 * DR + 2 * c + 1]); }
                __syncthreads();
                pg8::EpiRG E{ws, half, pcl};
                pg8::gemm_phase<pg8::EpiRG, pg8::SchedPlain, true>(lds, DR * 2, 128 * 2, 128 * 2, S, E, tid);
            STEP_END
            STEP_BEGIN(5)
                phase_scan(ws, gtid, nthr);
            STEP_END
        }
        STEP_BEGIN(6)
            pg8::SchedPlain S{T / 256, D / 256, G, bx, (const char*)(ws + WS_U), (const char*)(ws + WS_WA), (size_t)256 * UC, (size_t)256 * UC, 0};
            pg8::EpiMix E{(const bf16_t*)(ws + WS_GG), (unsigned char*)(ws + WS_MERGED)};
            pg8::gemm_phase<pg8::EpiMix, pg8::SchedPlain, true, 8, true>(lds, UC, UC, UC, S, E, tid, 0x79797979);
        STEP_END
        STEP_BEGIN(8)
            pg8::SchedPlain S{T / 256, D / 256, G, bx, (const char*)(ws + WS_MERGED), (const char*)(ws + WS_WO), (size_t)256 * D, (size_t)256 * D, 0};
            pg8::EpiY E{(l == 0) ? args->x : (const float*)args->out, (float*)(ws + WS_Y)};
            pg8::gemm_phase<pg8::EpiY, pg8::SchedPlain, true, -1, true>(lds, D, D, D, S, E, tid, 0x77777777);
        STEP_END
        STEP_BEGIN(9)
            if ((MOE_FP8_MASK >> l) & 1u) prep_expert_weights<true>(args, l, ws, scr, gw, NGW, lane); else prep_expert_weights<false>(args, l, ws, scr, gw, NGW, lane);
            __syncthreads();
            if (rep == 0) { if ((MOE_FP8_MASK >> l) & 1u) phase_ln1_router<true>(args, l, ws, lds, tid, lane, gw, NGW, vcu); else phase_ln1_router<false>(args, l, ws, lds, tid, lane, gw, NGW, vcu); }
        STEP_END
        STEP_BEGIN(10)
            phase_moe_lists(ws, lds, tid, lane, gw, NGW, vcu, G, (MOE_FP8_MASK >> l) & 1u);
            __syncthreads();
            if (l + 1 < DEPTH) prep_tm_weights(args, l + 1, ws, scr, gw, NGW, lane);
        STEP_END
        if ((MOE_FP8_MASK >> l) & 1u) {
        STEP_BEGIN(11)
            const int ntiles = (int)__hip_atomic_load(ctl + CW_NTILES, __ATOMIC_RELAXED, __HIP_MEMORY_SCOPE_AGENT);
            pg8::SchedMoe S{ntiles, 4, G, bx, (const char*)(ws + WS_XG), (const char*)(ws + WS_WEX), (size_t)256 * D, (size_t)256 * D, (size_t)1024 * 1024, ctl + CW_TILEE};
            pg8::EpiH<true> E{(bf16_t*)(ws + WS_H)};
            pg8::gemm_phase<pg8::EpiH<true>, pg8::SchedMoe, true, -1, true>(lds, D, D, D, S, E, tid, 0x7a7a7a7a);
        STEP_END
        } else {
        STEP_BEGIN(11)
            const int ntiles = (int)__hip_atomic_load(ctl + CW_NTILES, __ATOMIC_RELAXED, __HIP_MEMORY_SCOPE_AGENT);
            pg8::SchedMoe S{ntiles, 4, G, bx, (const char*)(ws + WS_XG), (const char*)(ws + WS_WEX), (size_t)256 * D * 2, (size_t)256 * D * 2, (size_t)1024 * 1024 * 2, ctl + CW_TILEE};
            pg8::EpiH<false> E{(bf16_t*)(ws + WS_H)};
            pg8::gemm_phase<pg8::EpiH<false>, pg8::SchedMoe, true>(lds, D * 2, D * 2, D * 2, S, E, tid);
        STEP_END
        }
        if ((MOE_FP8_MASK >> l) & 1u) {
        STEP_BEGIN(12)
            const int ntiles = (int)__hip_atomic_load(ctl + CW_NTILES, __ATOMIC_RELAXED, __HIP_MEMORY_SCOPE_AGENT);
            pg8::SchedMoe S{ntiles, 4, G, bx, (const char*)(ws + WS_H), (const char*)(ws + WS_WEX) + (size_t)NE * 1024 * 1024, (size_t)256 * FF, (size_t)256 * FF, (size_t)1024 * 512, ctl + CW_TILEE};
            pg8::EpiO E{(bf16_t*)(ws + WS_O), (const int*)(ws + WS_SMALL + SM_ROWINFO)};
            pg8::gemm_phase<pg8::EpiO, pg8::SchedMoe, true, -1, true>(lds, FF, FF, FF, S, E, tid, 0x78787878);
        STEP_END
        } else {
        STEP_BEGIN(12)
            const int ntiles = (int)__hip_atomic_load(ctl + CW_NTILES, __ATOMIC_RELAXED, __HIP_MEMORY_SCOPE_AGENT);
            pg8::SchedMoe S{ntiles, 4, G, bx, (const char*)(ws + WS_H), (const char*)(ws + WS_WEX) + (size_t)NE * 1024 * 1024 * 2, (size_t)256 * FF * 2, (size_t)256 * FF * 2, (size_t)1024 * 512 * 2, ctl + CW_TILEE};
            pg8::EpiO E{(bf16_t*)(ws + WS_O), (const int*)(ws + WS_SMALL + SM_ROWINFO)};
            pg8::gemm_phase<pg8::EpiO, pg8::SchedMoe, true>(lds, FF * 2, FF * 2, FF * 2, S, E, tid);
        STEP_END
        }
        STEP_BEGIN(13)
            phase_ln2(args, l, ws, args->out, lane, gw, NGW);
        STEP_END
    }
#undef STEP_BEGIN
#undef STEP_END
    if ((MK_TP >= 0 || MK_TQ >= 0) && bx == 0 && tid0 == 0) { volatile LAS unsigned long long* tw_ = (volatile LAS unsigned long long*)(lds + LDSCTL_OFF + 512);
        const unsigned long long delay = 10ull * tw_[1] + 100000ull * ((tw_[2] + 50ull) / 100ull); const unsigned long long t0_ = __builtin_amdgcn_s_memrealtime();
        while (__builtin_amdgcn_s_memrealtime() - t0_ < delay) __builtin_amdgcn_s_sleep(32); }
}

extern "C" void kernel_launch(void* const* d_in, const int* in_sizes, int n_in, void* d_out, int out_size, void* d_ws, size_t ws_size, hipStream_t stream) {
    static int grid = 0;
    if (grid == 0) {
        if (n_in != 22 || in_sizes[0] != T * D || out_size != T * D || ws_size < WS_NEED) {
            fprintf(stderr, "kernel_launch: unexpected shapes (n_in %d, in0 %d, out %d, ws %zu, need %zu); nothing launched\n", n_in, n_in > 0 ? in_sizes[0] : -1, out_size, ws_size, (size_t)WS_NEED); grid = -1; return; }
        int dev = 0, cus = 0, per_cu = 0;
        if (hipGetDevice(&dev) != hipSuccess || hipDeviceGetAttribute(&cus, hipDeviceAttributeMultiprocessorCount, dev) != hipSuccess) { grid = -1; return; }
        if (hipFuncSetAttribute((const void*)mk_fwd, hipFuncAttributeMaxDynamicSharedMemorySize, LDS_BYTES) != hipSuccess) { fprintf(stderr, "kernel_launch: hipFuncSetAttribute failed\n"); grid = -1; return; }
        if (hipOccupancyMaxActiveBlocksPerMultiprocessor(&per_cu, (const void*)mk_fwd, 512, LDS_BYTES) != hipSuccess || per_cu < 1) { fprintf(stderr, "kernel_launch: occupancy query says %d blocks per CU\n", per_cu); per_cu = 1; }
        (void)hipGetLastError();
        grid = cus;
    }
    if (grid < 0) return;
    (void)hipMemsetAsync((char*)d_ws + WS_CTL, 0, CTL_ZERO_BYTES, stream);
    Args a{};
    const float** p = (const float**)&a;
    for (int i = 0; i < 22; ++i) p[i] = (const float*)d_in[i];
    a.out = (float*)d_out; a.ws = (unsigned char*)d_ws;
#if MK_PER_STEP_LAUNCH
    for (int s = 0; s < N_STEPS; ++s) { a.ph_lo = s; a.ph_hi = s + 1; hipLaunchKernelGGL(mk_fwd, dim3(grid), dim3(512), LDS_BYTES, stream, a); }
#else
    a.ph_lo = 0; a.ph_hi = N_STEPS;
    hipLaunchKernelGGL(mk_fwd, dim3(grid), dim3(512), LDS_BYTES, stream, a);
#endif
}
```

```cpp
#include <hip/hip_runtime.h>
#include <cstdio>
#include <cstdint>

#ifndef MK_TP
#define MK_TP (-1)
#endif
#ifndef MK_TQ
#define MK_TQ (-1)
#endif
#ifndef MOE_FP8_MASK
#define MOE_FP8_MASK 3u
#endif
#ifndef MK_PER_STEP_LAUNCH
#define MK_PER_STEP_LAUNCH 0
#endif

#define LAS __attribute__((address_space(3)))
typedef unsigned short bf16_t;
typedef short bf16x8 __attribute__((ext_vector_type(8)));
typedef float f32x4 __attribute__((ext_vector_type(4)));
typedef float f32x2 __attribute__((ext_vector_type(2)));
typedef unsigned u32x4 __attribute__((ext_vector_type(4)));
typedef unsigned u32x2 __attribute__((ext_vector_type(2)));

constexpr int D = 1024, T = 16384, SEQ = 4096, NBATCH = 4, DR = 1280, NHEAD = 10, DIN = 7680, NE = 16, FF = 512, DEPTH = 2;
constexpr int NCHUNK = 1, TH = T / NCHUNK;
constexpr int ZC = 3328;
constexpr int GGC = 2048;
constexpr int SCH = 64, NSCH = SEQ / SCH;
constexpr int MOE_ROWS = 36864, MOE_TILES = MOE_ROWS / 256;
constexpr float LN_EPS = 1e-5f;
constexpr float DN_ALPHA = 1.4142135623730951f;

constexpr size_t MiB = 1u << 20;
constexpr size_t WS_CTL = 0, CTL_ZERO_BYTES = 128 * 1024;
constexpr size_t WS_WIN = 1 * MiB;
constexpr size_t WS_WA = 16 * MiB;
constexpr size_t WS_WO = 21 * MiB;
constexpr size_t WS_WG = 23 * MiB;
constexpr size_t WS_XB = 24 * MiB;
constexpr size_t WS_U = 56 * MiB;
constexpr int UC = 2304;
constexpr size_t WS_GG = 92 * MiB;
constexpr size_t WS_Z = 156 * MiB;
constexpr size_t WS_YR = 260 * MiB;
constexpr size_t WS_XC = 300 * MiB;
constexpr size_t WS_GT = 156 * MiB;
constexpr size_t WS_SMALL = 340 * MiB;
constexpr size_t WS_MERGED = 156 * MiB;
constexpr size_t WS_Y = 172 * MiB;
constexpr size_t WS_X1 = 92 * MiB;
constexpr size_t WS_WEX = 236 * MiB;
constexpr size_t WS_XG = 156 * MiB;
constexpr size_t WS_H = 284 * MiB;
constexpr size_t WS_O = 156 * MiB;
constexpr size_t WS_NEED = 344 * MiB + 512 * 1024;
constexpr size_t SM_AEND = 0;
constexpr size_t SM_HEND = SM_AEND + (size_t)NBATCH * NSCH * DR * 4;
constexpr size_t SM_TOKE = SM_HEND + (size_t)NBATCH * NSCH * DR * 4;
constexpr size_t SM_TOKP = SM_TOKE + (size_t)T * 4;
constexpr size_t SM_TOKW = SM_TOKP + (size_t)T * 8;
constexpr size_t SM_ROWINFO = SM_TOKW + (size_t)T * 8;
constexpr size_t SM_WGCNT = SM_ROWINFO + (size_t)MOE_ROWS * 4;
constexpr size_t SM_PCONST = SM_WGCNT + 256 * 16 * 4;
constexpr size_t SM_END = SM_PCONST + 3 * 1280 * 4;
static_assert(WS_SMALL + SM_END <= WS_NEED, "small region");
constexpr int CW_BAR = 4096;
constexpr int CW_CNT = 8192;
constexpr int CW_NTILES = 8256;
constexpr int CW_TILEE = 8320;

constexpr int RING_BYTES = 131072;
constexpr int LDSCTL_OFF = RING_BYTES, MISC_OFF = LDSCTL_OFF + 320;
constexpr int LDS_BYTES = 147456;

__device__ __forceinline__ unsigned cvt_pk_bf16(float lo, float hi) { unsigned r; asm volatile("v_cvt_pk_bf16_f32 %0, %1, %2" : "=v"(r) : "v"(lo), "v"(hi)); return r; }
__device__ __forceinline__ float bflo(unsigned w) { return __uint_as_float(w << 16); }
__device__ __forceinline__ float bfhi(unsigned w) { return __uint_as_float(w & 0xffff0000u); }
__device__ __forceinline__ float bf1(bf16_t b) { return __uint_as_float((unsigned)b << 16); }
__device__ __forceinline__ float fsigmoid(float x) { return __builtin_amdgcn_rcpf(1.0f + __builtin_amdgcn_exp2f(-1.4426950408889634f * x)); }
__device__ __forceinline__ float gelu_tanh(float y) { const float u = 1.5957691216057308f * (y + 0.044715f * y * y * y); return y * fsigmoid(u); }
__device__ __forceinline__ float lane_xor(float v, int mask, int lane) { return __builtin_bit_cast(float, __builtin_amdgcn_ds_bpermute((lane ^ mask) << 2, __builtin_bit_cast(int, v))); }
__device__ __forceinline__ float lane_get(float v, int src) { return __builtin_bit_cast(float, __builtin_amdgcn_ds_bpermute(src << 2, __builtin_bit_cast(int, v))); }
__device__ __forceinline__ float wave_sum(float v, int lane) {
#pragma unroll
    for (int o = 1; o < 64; o <<= 1) v += lane_xor(v, o, lane);
    return v;
}
typedef int v8i __attribute__((ext_vector_type(8)));
typedef int v4i __attribute__((ext_vector_type(4)));
__device__ __forceinline__ unsigned pk4_fp8(float a, float b, float c, float d) {
    a = __builtin_amdgcn_fmed3f(a, -448.f, 448.f); b = __builtin_amdgcn_fmed3f(b, -448.f, 448.f); c = __builtin_amdgcn_fmed3f(c, -448.f, 448.f); d = __builtin_amdgcn_fmed3f(d, -448.f, 448.f);
    int w = __builtin_amdgcn_cvt_pk_fp8_f32(a, b, 0, false); w = __builtin_amdgcn_cvt_pk_fp8_f32(c, d, w, true); return (unsigned)w; }
#ifndef MK_WT
#define MK_WT 0
#endif
__device__ __forceinline__ void st16(void* p, u32x4 v) {
#if MK_WT
    asm volatile("global_store_dwordx4 %0, %1, off sc1\n\ts_nop 1" :: "v"(p), "v"(v));
#else
    *(u32x4*)p = v;
#endif
}
__device__ __forceinline__ void st16f(void* p, f32x4 v) {
#if MK_WT
    asm volatile("global_store_dwordx4 %0, %1, off sc1\n\ts_nop 1" :: "v"(p), "v"(v));
#else
    *(f32x4*)p = v;
#endif
}
#define LDS_WAIT() asm volatile("s_waitcnt lgkmcnt(0)" ::: "memory")
#define VM_WAIT() asm volatile("s_waitcnt vmcnt(0)" ::: "memory")

namespace pg8 {
constexpr int BM = 256, BK = 64, HALF = 128, HTB = HALF * BK * 2, STAGE_BYTES = 8 * HTB, NXCD = 8, WGM = 8;
__host__ __device__ __forceinline__ int lds_byte(int r, int c) { const int st = (r >> 4) * 2 + (c >> 5), rr = r & 15, cc = c & 31, ob = rr * 64 + cc * 2; return st * 1024 + (ob ^ (((ob >> 9) & 1) << 5)); }
__host__ __device__ __forceinline__ void stage_rc(int b, int& R, int& C) { const int st = b / 1024, sb = b % 1024, swz = sb ^ (((sb >> 9) & 1) << 5); R = (st >> 1) * 16 + swz / 64; C = (st & 1) * 32 + (swz % 64) / 2; }
__host__ __device__ __forceinline__ int perm32(int rho) { const int n = rho >> 4, i = rho & 15; return 8 * (i >> 2) + 4 * n + (i & 3); }

struct Unit { const char* a; const char* b; int pm, pn; };

__device__ __forceinline__ bool static_order(int i, int G, int c, int nM, int nN, int& pm, int& pn) {
    const int nwg = nM * nN; const long L = (long)i * G + c; if (L >= nwg) return false;
    int wgid = (int)L; { const int q = nwg / NXCD, r = nwg % NXCD, xcd = wgid % NXCD, off = wgid / NXCD; wgid = (xcd < r ? xcd * (q + 1) : r * (q + 1) + (xcd - r) * q) + off; }
    const int nig = WGM * nN, gid = wgid / nig, fm = gid * WGM, gsz = (nM - fm) < WGM ? (nM - fm) : WGM;
    pm = fm + ((wgid % nig) % gsz); pn = (wgid % nig) / gsz; return true;
}
struct SchedPlain {
    int nM, nN, G, c; const char* A; const char* B; size_t a_tile, b_tile, a_pn;
    __device__ __forceinline__ bool next(int i, Unit& u) const {
        int pm, pn; if (!static_order(i, G, c, nM, nN, pm, pn)) return false;
        u.pm = pm; u.pn = pn; u.a = A + (size_t)pm * a_tile + (size_t)pn * a_pn; u.b = B + (size_t)pn * b_tile; return true;
    }
};
struct SchedMoe {
    int nM, nN, G, c; const char* A; const char* B; size_t a_tile, b_tile, b_exp; const unsigned* tile_e;
    __device__ __forceinline__ bool next(int i, Unit& u) const {
        int pm, pn; if (!static_order(i, G, c, nM, nN, pm, pn)) return false;
        const int e = __builtin_amdgcn_readfirstlane((int)__hip_atomic_load(tile_e + pm, __ATOMIC_RELAXED, __HIP_MEMORY_SCOPE_AGENT));
        u.pm = pm; u.pn = pn; u.a = A + (size_t)pm * a_tile; u.b = B + (size_t)e * b_exp + (size_t)pn * b_tile; return true;
    }
};

template <class Epi, class Sched, bool ALIGN_EPI, int HOOK_T = -1, bool FP8 = false>
__device__ __forceinline__ void gemm_phase(LAS unsigned char* lds, const int lda, const int ldb, const int K, const Sched& S, const Epi& E, const int tid_in, const int scale = 0x7f7f7f7f) {
    int tid = tid_in; asm volatile("" : "+v"(tid));
    const int wid = __builtin_amdgcn_readfirstlane(tid >> 6), lane = tid & 63, wr = wid >> 2, wc = wid & 3, fr = lane & 15, fq = lane >> 4;
    int Kop = K; asm volatile("" : "+s"(Kop));
    const int nt = Kop / 128;
    unsigned voffA[2], voffB[2];
#pragma unroll
    for (int i = 0; i < 2; ++i) { int R, C; stage_rc(tid * 16 + i * 8192, R, C); const int Rb = Epi::PERM ? ((R & ~31) + perm32(R & 31)) : R;
        voffA[i] = (unsigned)(R * lda + 2 * C); voffB[i] = (unsigned)(Rb * ldb + 2 * C); }
    const size_t kstep = (size_t)(BK * 2);
    const size_t hstepA = (size_t)HALF * lda, hstepB = (size_t)HALF * ldb;
    const unsigned ldsw = (unsigned)wid * 1024u;
    const int aoff = FP8 ? lds_byte(wr * 64 + fr, fq * 16) : lds_byte(wr * 64 + fr, fq * 8), boff = FP8 ? lds_byte(wc * 32 + fr, fq * 16) : lds_byte(wc * 32 + fr, fq * 8);
    const int f0 = FP8 ? ((fq >> 1) & 1) * 16 : 0, f1 = 16 - f0;
    const LAS unsigned char* pa0 = lds + aoff + f0; const LAS unsigned char* pa1 = lds + aoff + f1; const LAS unsigned char* pb0 = lds + 4 * HTB + boff + f0; const LAS unsigned char* pb1 = lds + 4 * HTB + boff + f1;
    (void)pa1; (void)pb1;
#define PG8_SA(b, h) (((b) * 2 + (h)) * HTB)
#define PG8_SB(b, h) ((4 + (b) * 2 + (h)) * HTB)
#define PG8_STAGE(bufoff, gbase, voff) do { _Pragma("unroll") for (int _i = 0; _i < 2; ++_i) \
        __builtin_amdgcn_global_load_lds((const unsigned*)((const char*)(gbase) + (voff)[_i]), (LAS unsigned*)(lds + (bufoff) + ldsw + _i * 8192), 16, 0, 0); } while (0)
#define PG8_LD8(dst, i_, p0_, p1_, off_) do { const v4i lo_ = *(const LAS v4i*)((p0_) + (off_)), hi_ = *(const LAS v4i*)((p1_) + (off_)); dst[i_] = __builtin_shufflevector(lo_, hi_, 0, 1, 2, 3, 4, 5, 6, 7); } while (0)
#define PG8_LDA(dst, b, h) do { if constexpr (FP8) { _Pragma("unroll") for (int m = 0; m < 4; ++m) PG8_LD8(dst##8, m, pa0, pa1, PG8_SA(b, h) + m * 2048); } \
        else { _Pragma("unroll") for (int m = 0; m < 4; ++m) _Pragma("unroll") for (int k = 0; k < 2; ++k) dst[m][k] = *(const LAS bf16x8*)(pa0 + PG8_SA(b, h) + m * 2048 + k * 1024); } } while (0)
#define PG8_LDB(dst, b, h) do { if constexpr (FP8) { _Pragma("unroll") for (int n = 0; n < 2; ++n) PG8_LD8(dst##8, n, pb0, pb1, PG8_SA(b, h) + n * 2048); } \
        else { _Pragma("unroll") for (int n = 0; n < 2; ++n) _Pragma("unroll") for (int k = 0; k < 2; ++k) dst[n][k] = *(const LAS bf16x8*)(pb0 + PG8_SA(b, h) + n * 2048 + k * 1024); } } while (0)
#define PG8_MMA(ai, bj, At, Bt) do { __builtin_amdgcn_s_setprio(1); _Pragma("unroll") for (int m = 0; m < 4; ++m) _Pragma("unroll") for (int n = 0; n < 2; ++n) { \
        if constexpr (FP8) asm volatile("v_mfma_scale_f32_16x16x128_f8f6f4 %0, %1, %2, %0, %3, %4 op_sel_hi:[0,0,0]" : "+v"(acc[ai][bj][m][n]) : "v"(Bt##8[n]), "v"(At##8[m]), "v"(scale_v), "v"(one_v)); \
        else { _Pragma("unroll") for (int k = 0; k < 2; ++k) acc[ai][bj][m][n] = __builtin_amdgcn_mfma_f32_16x16x32_bf16(Bt[n][k], At[m][k], acc[ai][bj][m][n], 0, 0, 0); } } \
        __builtin_amdgcn_s_setprio(0); } while (0)
#define PG8_WAIT_V(n) asm volatile("s_waitcnt vmcnt(" #n ")" ::: "memory")
#define PG8_WAIT_L(n) asm volatile("s_waitcnt lgkmcnt(" #n ")" ::: "memory")
#define PG8_BAR __builtin_amdgcn_s_barrier()
#define PG8_SCHED __builtin_amdgcn_sched_barrier(0)
    int scale_v = scale, one_v = 0x7f7f7f7f; asm volatile("" : "+v"(scale_v), "+v"(one_v));
    (void)scale_v; (void)one_v;
    Unit cur, nxt; int ui = 0;
    if (!S.next(0, cur)) return;
    f32x4 acc[2][2][4][2];
#pragma unroll
    for (int a = 0; a < 2; ++a)
#pragma unroll
        for (int b = 0; b < 2; ++b)
#pragma unroll
            for (int m = 0; m < 4; ++m)
#pragma unroll
                for (int n = 0; n < 2; ++n) acc[a][b][m][n] = (f32x4){0.f, 0.f, 0.f, 0.f};
    bf16x8 At[4][2], B0[2][2], B1[2][2];
    v8i At8[4], B08[2], B18[2];
    const char* cA = cur.a; const char* cB = cur.b;
    PG8_STAGE(PG8_SB(0, 0), cB, voffB); PG8_STAGE(PG8_SB(0, 1), cB + hstepB, voffB); PG8_STAGE(PG8_SA(0, 0), cA, voffA); PG8_STAGE(PG8_SA(0, 1), cA + hstepA, voffA);
    if (wr == 1) PG8_BAR;
    PG8_WAIT_V(2); PG8_BAR;
    PG8_STAGE(PG8_SB(1, 0), cB + kstep, voffB); PG8_STAGE(PG8_SA(1, 0), cA + kstep, voffA); PG8_STAGE(PG8_SB(1, 1), cB + hstepB + kstep, voffB);
    PG8_WAIT_V(6); PG8_BAR;
    for (;;) {
        const bool has_next = S.next(ui + 1, nxt);
        const char* nA = has_next ? nxt.a : cA; const char* nB = has_next ? nxt.b : cB;
        for (int t = 0; t < nt; t += 2) {
            const bool last = (t == nt - 2);
            if constexpr (HOOK_T >= 0) { if (t == HOOK_T) { if constexpr (FP8) asm volatile("s_nop 15\n\ts_nop 15" ::: "memory"); int fr2 = fr, fq2 = fq; asm volatile("" : "+v"(fr2), "+v"(fq2)); E.hook(acc, cur, wr, wc, fr2, fq2); } }
            const char* a1 = cA + (size_t)(t + 1) * kstep;
            const char* a2 = last ? nA : cA + (size_t)(t + 2) * kstep; const char* b2 = last ? nB : cB + (size_t)(t + 2) * kstep;
            const char* a3 = a2 + kstep; const char* b3 = b2 + kstep;
            PG8_LDB(B0, 0, 0); PG8_LDB(B1, 0, 1); PG8_SCHED; PG8_LDA(At, 0, 0); PG8_STAGE(PG8_SA(1, 1), a1 + hstepA, voffA);
            PG8_WAIT_V(8); PG8_WAIT_L(0); PG8_BAR; PG8_MMA(0, 0, At, B0); PG8_MMA(0, 1, At, B1); PG8_BAR; PG8_SCHED;
            PG8_LDA(At, 0, 1); PG8_STAGE(PG8_SB(0, 0), b2, voffB); PG8_STAGE(PG8_SB(0, 1), b2 + hstepB, voffB); PG8_STAGE(PG8_SA(0, 0), a2, voffA);
            PG8_WAIT_V(8); PG8_WAIT_L(0); PG8_BAR; PG8_MMA(1, 0, At, B0); PG8_MMA(1, 1, At, B1); PG8_BAR; PG8_SCHED;
            PG8_LDB(B0, 1, 0); PG8_LDB(B1, 1, 1); PG8_SCHED; PG8_LDA(At, 1, 0); PG8_STAGE(PG8_SA(0, 1), a2 + hstepA, voffA);
            PG8_WAIT_V(8); PG8_WAIT_L(0); PG8_BAR; PG8_MMA(0, 0, At, B0); PG8_MMA(0, 1, At, B1); PG8_BAR; PG8_SCHED;
            PG8_LDA(At, 1, 1); PG8_STAGE(PG8_SB(1, 0), b3, voffB); PG8_STAGE(PG8_SB(1, 1), b3 + hstepB, voffB); PG8_STAGE(PG8_SA(1, 0), a3, voffA);
            PG8_WAIT_V(8); PG8_WAIT_L(0); PG8_BAR; PG8_MMA(1, 0, At, B0); PG8_MMA(1, 1, At, B1); PG8_BAR; PG8_SCHED;
        }
        if constexpr (ALIGN_EPI) { if (wr == 0) PG8_BAR; }
        if constexpr (FP8) asm volatile("s_nop 15\n\ts_nop 15" ::: "memory");
        { int fr2 = fr, fq2 = fq; asm volatile("" : "+v"(fr2), "+v"(fq2));
          E(acc, cur, wr, wc, fr2, fq2); }
        if (!has_next) break;
#pragma unroll
        for (int a = 0; a < 2; ++a)
#pragma unroll
            for (int b = 0; b < 2; ++b)
#pragma unroll
                for (int m = 0; m < 4; ++m)
#pragma unroll
                    for (int n = 0; n < 2; ++n) acc[a][b][m][n] = (f32x4){0.f, 0.f, 0.f, 0.f};
        cur = nxt; cA = nA; cB = nB; ++ui;
        if constexpr (ALIGN_EPI) { if (wr == 1) PG8_BAR; }
    }
    PG8_WAIT_V(0);
    if constexpr (!ALIGN_EPI) { if (wr == 0) PG8_BAR; }
    PG8_BAR;
#undef PG8_SA
#undef PG8_SB
#undef PG8_STAGE
#undef PG8_LDA
#undef PG8_LDB
#undef PG8_MMA
#undef PG8_LD8
#undef PG8_WAIT_V
#undef PG8_WAIT_L
#undef PG8_BAR
#undef PG8_SCHED
}

typedef const f32x4 (&AccRef)[2][2][4][2];
typedef f32x4 (&AccMut)[2][2][4][2];
#define EPI_LOOP_ROWS for (int ai = 0; ai < 2; ++ai) _Pragma("unroll") for (int m = 0; m < 4; ++m)

struct EpiZ {
    static constexpr bool PERM = true;
    bf16_t* Z; bf16_t* GG; bf16_t* YR; int row_base;
    __device__ __forceinline__ void operator()(AccRef acc, const Unit& u, int wr, int wc, int fr, int fq) const {
        const int row0 = u.pm * BM + wr * 64 + fr;
        if (u.pn < 8) {
            bf16_t* base = Z + u.pn * HALF + wc * 32 + 8 * fq;
#pragma unroll
            EPI_LOOP_ROWS { const f32x4 h0 = acc[ai][0][m][0], h1 = acc[ai][0][m][1], c0 = acc[ai][1][m][0], c1 = acc[ai][1][m][1];
                u32x4 w; w.x = cvt_pk_bf16(h0[0] * c0[0], h0[1] * c0[1]); w.y = cvt_pk_bf16(h0[2] * c0[2], h0[3] * c0[3]); w.z = cvt_pk_bf16(h1[0] * c1[0], h1[1] * c1[1]); w.w = cvt_pk_bf16(h1[2] * c1[2], h1[3] * c1[3]);
                st16(base + (size_t)(row0 + ai * HALF + m * 16) * ZC, w); }
        } else {
            const int colt = u.pn * BM + wc * 32 + 8 * fq; const int act = u.pn < 17 ? 0 : (u.pn < 22 ? 1 : 2);
            bf16_t* base; size_t ldc;
            if (u.pn < 17) { base = Z + (colt - 1024); ldc = ZC; } else if (u.pn < 22) { base = YR + (colt - 4352); ldc = DR; } else { base = GG + (size_t)row_base * GGC + (colt - 5632); ldc = GGC; }
#pragma unroll
            EPI_LOOP_ROWS { bf16_t* rowp = base + (size_t)(row0 + ai * HALF + m * 16) * ldc;
#pragma unroll
                for (int bj = 0; bj < 2; ++bj) { f32x4 v0 = acc[ai][bj][m][0], v1 = acc[ai][bj][m][1];
                    if (act == 1) {
#pragma unroll
                        for (int j = 0; j < 4; ++j) { v0[j] = gelu_tanh(v0[j]); v1[j] = gelu_tanh(v1[j]); } }
                    else if (act == 2) {
#pragma unroll
                        for (int j = 0; j < 4; ++j) { v0[j] = fsigmoid(v0[j]); v1[j] = fsigmoid(v1[j]); } }
                    u32x4 w; w.x = cvt_pk_bf16(v0[0], v0[1]); w.y = cvt_pk_bf16(v0[2], v0[3]); w.z = cvt_pk_bf16(v1[0], v1[1]); w.w = cvt_pk_bf16(v1[2], v1[3]);
                    st16(rowp + bj * HALF, w); } }
        }
    }
};
struct EpiBf16 {
    static constexpr bool PERM = true;
    bf16_t* O; int ldc;
    __device__ __forceinline__ void operator()(AccRef acc, const Unit& u, int wr, int wc, int fr, int fq) const {
        const int row0 = u.pm * BM + wr * 64 + fr; const int colt = u.pn * BM + wc * 32 + 8 * fq;
#pragma unroll
        EPI_LOOP_ROWS { bf16_t* rowp = O + (size_t)(row0 + ai * HALF + m * 16) * ldc + colt;
#pragma unroll
            for (int bj = 0; bj < 2; ++bj) { const f32x4 v0 = acc[ai][bj][m][0], v1 = acc[ai][bj][m][1];
                u32x4 w; w.x = cvt_pk_bf16(v0[0], v0[1]); w.y = cvt_pk_bf16(v0[2], v0[3]); w.z = cvt_pk_bf16(v1[0], v1[1]); w.w = cvt_pk_bf16(v1[2], v1[3]);
                st16(rowp + bj * HALF, w); } }
    }
};
__device__ __forceinline__ float dpp_shr(float v, float ident, int s) {
    const int o = __builtin_bit_cast(int, ident), x = __builtin_bit_cast(int, v); int r;
    switch (s) { case 1: r = __builtin_amdgcn_update_dpp(o, x, 0x111, 0xf, 0xf, false); break; case 2: r = __builtin_amdgcn_update_dpp(o, x, 0x112, 0xf, 0xf, false); break;
                 case 4: r = __builtin_amdgcn_update_dpp(o, x, 0x114, 0xf, 0xf, false); break; default: r = __builtin_amdgcn_update_dpp(o, x, 0x118, 0xf, 0xf, false); break; }
    return __builtin_bit_cast(float, r);
}
struct EpiRG {
    static constexpr bool PERM = true;
    unsigned char* wsb; int half; const LAS unsigned* pcl;
    __device__ __forceinline__ void operator()(AccRef acc, const Unit& u, int wr, int wc, int fr, int fq) const {
        bf16_t* GT = (bf16_t*)(wsb + WS_GT); const bf16_t* XC = (const bf16_t*)(wsb + WS_XC);
        float* AEND = (float*)(wsb + WS_SMALL + SM_AEND); float* HEND = (float*)(wsb + WS_SMALL + SM_HEND);
        const int row0 = u.pm * BM + wr * 64 + fr; const int cc = wc * 32 + 8 * fq, ch = u.pn * HALF + cc;
#pragma unroll
        for (int ai = 0; ai < 2; ++ai) {
            int chl = ch; asm volatile("" : "+v"(chl));
            u32x4 xwv[4];
#pragma unroll
            for (int m = 0; m < 2; ++m) xwv[m] = *(const u32x4*)(XC + (size_t)(row0 + ai * HALF + m * 16) * DR + ch);
            float At[8], Ht[8];
#pragma unroll
            for (int k = 0; k < 8; ++k) { At[k] = 1.f; Ht[k] = 0.f; }
#pragma unroll
            for (int m = 0; m < 4; ++m) { const size_t r = (size_t)(row0 + ai * HALF + m * 16);
                const u32x4 xw = xwv[m];
                if (m < 2) { xwv[m + 2] = *(const u32x4*)(XC + (size_t)(row0 + ai * HALF + (m + 2) * 16) * DR + ch); asm volatile("" ::: "memory"); }
                float xc[8]; xc[0] = bflo(xw.x); xc[1] = bfhi(xw.x); xc[2] = bflo(xw.y); xc[3] = bfhi(xw.y); xc[4] = bflo(xw.z); xc[5] = bfhi(xw.z); xc[6] = bflo(xw.w); xc[7] = bfhi(xw.w);
#pragma unroll
                for (int n = 0; n < 2; ++n) {
                    float la[4], bb[4];
                    const u32x4 cb = *(const LAS u32x4*)(pcl + chl + 4 * n); const u32x2 xb2 = *(const LAS u32x2*)(pcl + DR + ((chl + 4 * n) >> 1));
#pragma unroll
                    for (int j = 0; j < 4; ++j) { const int k = 4 * n + j; const float rp = acc[ai][0][m][n][j], ip = acc[ai][1][m][n][j];
                        const float l = -bflo(cb[j]) * fsigmoid(rp + bfhi(cb[j])); const float x = 2.0f * l;
                        float em = -x * (1.0f + x * (0.5f + x * (0.16666667f + x * (0.041666668f + x * (0.0083333338f + x * 0.0013888889f)))));
                        la[j] = l; bb[j] = __builtin_amdgcn_sqrtf(em) * fsigmoid(ip + ((j & 1) ? bfhi(xb2[j >> 1]) : bflo(xb2[j >> 1]))) * xc[k]; }
                    u32x2 w0, w1; w0.x = cvt_pk_bf16(la[0], la[1]); w0.y = cvt_pk_bf16(la[2], la[3]); w1.x = cvt_pk_bf16(bb[0], bb[1]); w1.y = cvt_pk_bf16(bb[2], bb[3]);
                    *(u32x2*)(GT + r * 2560 + u.pn * BM + cc + 4 * n) = w0; *(u32x2*)(GT + r * 2560 + u.pn * BM + HALF + cc + 4 * n) = w1;
                    la[0] = bflo(w0.x); la[1] = bfhi(w0.x); la[2] = bflo(w0.y); la[3] = bfhi(w0.y); bb[0] = bflo(w1.x); bb[1] = bfhi(w1.x); bb[2] = bflo(w1.y); bb[3] = bfhi(w1.y);
#pragma unroll
                    for (int j = 0; j < 4; ++j) { const int k = 4 * n + j; float A = __builtin_amdgcn_exp2f(1.4426950408889634f * la[j]), H = bb[j];
#pragma unroll
                        for (int s = 1; s < 16; s <<= 1) { const float Al = dpp_shr(A, 1.f, s), Hl = dpp_shr(H, 0.f, s); H = A * Hl + H; A = A * Al; }
                        Ht[k] = A * Ht[k] + H; At[k] = At[k] * A; }
                    __builtin_amdgcn_sched_barrier(0);
                }
            }
            if (fr == 15) { const int rloc = u.pm * BM + ai * HALF + wr * 64;
                const int b = half * (TH / SEQ) + rloc / SEQ, j = (rloc % SEQ) / SCH; const size_t si = ((size_t)b * NSCH + j) * DR + ch;
                *(f32x4*)(AEND + si) = (f32x4){At[0], At[1], At[2], At[3]}; *(f32x4*)(AEND + si + 4) = (f32x4){At[4], At[5], At[6], At[7]};
                *(f32x4*)(HEND + si) = (f32x4){Ht[0], Ht[1], Ht[2], Ht[3]}; *(f32x4*)(HEND + si + 4) = (f32x4){Ht[4], Ht[5], Ht[6], Ht[7]}; }
            asm volatile("" ::: "memory");
        }
    }
};
struct EpiMix {
    static constexpr bool PERM = true;
    const bf16_t* GG; unsigned char* MG;
    __device__ __forceinline__ void hook(AccMut acc, const Unit& u, int wr, int wc, int fr, int fq) const {
        const int row0 = u.pm * BM + wr * 64 + fr;
        const int colt = u.pn * BM + wc * 32 + 8 * fq;
#pragma unroll
        EPI_LOOP_ROWS { const size_t r = (size_t)(row0 + ai * HALF + m * 16);
#pragma unroll
            for (int bj = 0; bj < 2; ++bj) { const int c = colt + bj * HALF; const u32x4 ga = *(const u32x4*)(GG + r * GGC + c), gr = *(const u32x4*)(GG + r * GGC + D + c);
                f32x4 q0, q1;
                q0[0] = bflo(ga.x) * __builtin_amdgcn_rcpf(bflo(gr.x)); q0[1] = bfhi(ga.x) * __builtin_amdgcn_rcpf(bfhi(gr.x)); q0[2] = bflo(ga.y) * __builtin_amdgcn_rcpf(bflo(gr.y)); q0[3] = bfhi(ga.y) * __builtin_amdgcn_rcpf(bfhi(gr.y));
                q1[0] = bflo(ga.z) * __builtin_amdgcn_rcpf(bflo(gr.z)); q1[1] = bfhi(ga.z) * __builtin_amdgcn_rcpf(bfhi(gr.z)); q1[2] = bflo(ga.w) * __builtin_amdgcn_rcpf(bflo(gr.w)); q1[3] = bfhi(ga.w) * __builtin_amdgcn_rcpf(bfhi(gr.w));
                acc[ai][bj][m][0] *= q0; acc[ai][bj][m][1] *= q1; }
            asm volatile("" ::: "memory"); }
    }
    __device__ __forceinline__ void operator()(AccRef acc, const Unit& u, int wr, int wc, int fr, int fq) const {
        const int row0 = u.pm * BM + wr * 64 + fr; const int colt = u.pn * BM + wc * 32 + 8 * fq;
#pragma unroll
        EPI_LOOP_ROWS { const size_t r = (size_t)(row0 + ai * HALF + m * 16);
#pragma unroll
            for (int bj = 0; bj < 2; ++bj) { const int c = colt + bj * HALF; const u32x4 g = *(const u32x4*)(GG + r * GGC + D + c);
                const f32x4 v0 = acc[ai][bj][m][0], v1 = acc[ai][bj][m][1];
                u32x2 w; w.x = pk4_fp8(4.f * bflo(g.x) * v0[0], 4.f * bfhi(g.x) * v0[1], 4.f * bflo(g.y) * v0[2], 4.f * bfhi(g.y) * v0[3]);
                w.y = pk4_fp8(4.f * bflo(g.z) * v1[0], 4.f * bfhi(g.z) * v1[1], 4.f * bflo(g.w) * v1[2], 4.f * bfhi(g.w) * v1[3]);
                *(u32x2*)(MG + r * D + c) = w; }
            asm volatile("" ::: "memory"); }
    }
};
struct EpiY {
    static constexpr bool PERM = false;
    const float* X0; float* Y;
    __device__ __forceinline__ void operator()(AccRef acc, const Unit& u, int wr, int wc, int fr, int fq) const {
        const int row0 = u.pm * BM + wr * 64 + fr, col0 = u.pn * BM + wc * 32 + 4 * fq;
#pragma unroll
        EPI_LOOP_ROWS { const size_t r = (size_t)(row0 + ai * HALF + m * 16);
#pragma unroll
            for (int bj = 0; bj < 2; ++bj)
#pragma unroll
                for (int n = 0; n < 2; ++n) { const int c = col0 + bj * HALF + n * 16; const f32x4 x = *(const f32x4*)(X0 + r * D + c);
                    st16f(Y + r * D + c, x * DN_ALPHA + acc[ai][bj][m][n]); }
            asm volatile("" ::: "memory"); }
    }
};
template <bool F8> struct EpiH {
    static constexpr bool PERM = true;
    bf16_t* H;
    __device__ __forceinline__ void operator()(AccRef acc, const Unit& u, int wr, int wc, int fr, int fq) const {
        const int row0 = u.pm * BM + wr * 64 + fr; const int col = u.pn * HALF + wc * 32 + 8 * fq;
#pragma unroll
        EPI_LOOP_ROWS { const size_t r = (size_t)(row0 + ai * HALF + m * 16);
            const f32x4 g0 = acc[ai][0][m][0], g1 = acc[ai][0][m][1], u0 = acc[ai][1][m][0], u1 = acc[ai][1][m][1];
            if constexpr (F8) { u32x2 w;
            w.x = pk4_fp8(4.f * g0[0] * fsigmoid(g0[0]) * u0[0], 4.f * g0[1] * fsigmoid(g0[1]) * u0[1], 4.f * g0[2] * fsigmoid(g0[2]) * u0[2], 4.f * g0[3] * fsigmoid(g0[3]) * u0[3]);
            w.y = pk4_fp8(4.f * g1[0] * fsigmoid(g1[0]) * u1[0], 4.f * g1[1] * fsigmoid(g1[1]) * u1[1], 4.f * g1[2] * fsigmoid(g1[2]) * u1[2], 4.f * g1[3] * fsigmoid(g1[3]) * u1[3]);
            *(u32x2*)((unsigned char*)H + r * FF + col) = w; } else {
            u32x4 w;
            w.x = cvt_pk_bf16(g0[0] * fsigmoid(g0[0]) * u0[0], g0[1] * fsigmoid(g0[1]) * u0[1]);
            w.y = cvt_pk_bf16(g0[2] * fsigmoid(g0[2]) * u0[2], g0[3] * fsigmoid(g0[3]) * u0[3]);
            w.z = cvt_pk_bf16(g1[0] * fsigmoid(g1[0]) * u1[0], g1[1] * fsigmoid(g1[1]) * u1[1]);
            w.w = cvt_pk_bf16(g1[2] * fsigmoid(g1[2]) * u1[2], g1[3] * fsigmoid(g1[3]) * u1[3]);
            st16(H + r * FF + col, w); } }
    }
};
struct EpiO {
    static constexpr bool PERM = true;
    bf16_t* O; const int* rowinfo;
    __device__ __forceinline__ void operator()(AccRef acc, const Unit& u, int wr, int wc, int fr, int fq) const {
        const int row0 = u.pm * BM + wr * 64 + fr; const int colt = u.pn * BM + wc * 32 + 8 * fq;
#pragma unroll
        EPI_LOOP_ROWS { const int dst = rowinfo[row0 + ai * HALF + m * 16];
            if (dst >= 0) { bf16_t* rowp = O + (size_t)dst * D + colt;
#pragma unroll
                for (int bj = 0; bj < 2; ++bj) { const f32x4 v0 = acc[ai][bj][m][0], v1 = acc[ai][bj][m][1];
                    u32x4 w; w.x = cvt_pk_bf16(v0[0], v0[1]); w.y = cvt_pk_bf16(v0[2], v0[3]); w.z = cvt_pk_bf16(v1[0], v1[1]); w.w = cvt_pk_bf16(v1[2], v1[3]);
                    st16(rowp + bj * HALF, w); } } }
    }
};
}

#define XB_TMO      128
#define XB_XCNT(j)  (256  + 64 * (j))
#define XB_XSUB(j)  (1280 + 64 * (j))
#define XB_XGEN(j)  (2304 + 64 * (j))
#define XB_TOP      3328
#define XB_TOPGEN   3392
#define XCD_BAR_WORDS 3456
#define XB_SPIN_CAP (1u << 18)
__device__ __forceinline__ unsigned xb_ld(unsigned* p)              { return __hip_atomic_load(p, __ATOMIC_RELAXED, __HIP_MEMORY_SCOPE_AGENT); }
__device__ __forceinline__ unsigned xb_add(unsigned* p, unsigned v) { return __hip_atomic_fetch_add(p, v, __ATOMIC_RELAXED, __HIP_MEMORY_SCOPE_AGENT); }
__device__ __forceinline__ unsigned xb_xcc_id() { return (unsigned)__builtin_amdgcn_s_getreg((3 << 11) | 20) & 0xFu; }
#define XB_SPIN(cond, bar) do { unsigned _sp = 0; while (cond) { __builtin_amdgcn_s_sleep(1); \
    if ((++_sp & 255u) == 0u) { if (xb_ld(&(bar)[XB_TMO])) break; if (_sp > XB_SPIN_CAP) { atomicAdd(&(bar)[XB_TMO], 1u); break; } } } } while (0)
struct XcdBarrier { unsigned* bar; unsigned x; volatile LAS unsigned* st; };
__device__ __forceinline__ XcdBarrier xcd_barrier_post(unsigned* bar, volatile LAS unsigned* st) {
    XcdBarrier b; b.bar = bar; b.x = xb_xcc_id(); b.st = st;
    if (threadIdx.x == 0) (void)xb_add(&bar[XB_XCNT(b.x)], 1u);
    return b;
}
__device__ __forceinline__ void xcd_barrier_complete(unsigned* bar, unsigned x, unsigned& nloc, unsigned& nx) {
    const unsigned G = gridDim.x * gridDim.y * gridDim.z;
    unsigned sum, cnt, mine, sp = 0u;
    for (;;) {
        sum = 0u; cnt = 0u; mine = 0u;
#pragma unroll
        for (unsigned j = 0; j < 16; ++j) { const unsigned c = xb_ld(&bar[XB_XCNT(j)]); sum += c; cnt += (c > 0u) ? 1u : 0u; mine = (j == x) ? c : mine; }
        if (sum == G) break;
        __builtin_amdgcn_s_sleep(1);
        if ((++sp & 255u) == 0u) { if (xb_ld(&bar[XB_TMO])) break; if (sp > XB_SPIN_CAP) { atomicAdd(&bar[XB_TMO], 1u); break; } }
    }
    nloc = mine > 0u ? mine : 1u; nx = cnt > 0u ? cnt : 1u;
}
__device__ __forceinline__ void xcd_barrier(const XcdBarrier& b) {
    asm volatile("s_waitcnt vmcnt(0)" ::: "memory");
    __syncthreads();
    if (threadIdx.x == 0) {
        unsigned* bar = b.bar;
        __builtin_amdgcn_s_waitcnt(0);
        unsigned nloc = b.st[0], nx = b.st[1];
        if (nloc == 0u) { xcd_barrier_complete(bar, b.x, nloc, nx); b.st[0] = nloc; b.st[1] = nx; }
        const unsigned old = xb_add(&bar[XB_XSUB(b.x)], 1u);
        const unsigned gen = old / nloc;
        if (old + 1u == (gen + 1u) * nloc) {
            __builtin_amdgcn_fence(__ATOMIC_RELEASE, "agent");
            asm volatile("s_waitcnt vmcnt(0)" ::: "memory");
            const unsigned og = xb_add(&bar[XB_TOP], 1u);
            const unsigned tg = og / nx;
            if (og + 1u == (tg + 1u) * nx) xb_add(&bar[XB_TOPGEN], 1u);
            else XB_SPIN(xb_ld(&bar[XB_TOPGEN]) == tg, bar);
            __builtin_amdgcn_fence(__ATOMIC_ACQUIRE, "agent");
            xb_add(&bar[XB_XGEN(b.x)], 1u);
            asm volatile("s_waitcnt vmcnt(0)" ::: "memory");
        } else {
            XB_SPIN(xb_ld(&bar[XB_XGEN(b.x)]) == gen, bar);
            __builtin_amdgcn_fence(__ATOMIC_ACQUIRE, "agent");
            asm volatile("s_waitcnt vmcnt(0)" ::: "memory");
        }
    }
    __syncthreads();
}

struct Args {
    const float* x; const float* w_in; const float* conv_a_w; const float* w_branch_a; const float* conv_r_w; const float* conv_r_b;
    const float* w_rg_a; const float* b_rg_a; const float* w_rg_x; const float* b_rg_x; const float* rg_lambda; const float* w_branch_r; const float* w_out;
    const float* ln1_g; const float* ln1_b; const float* w_router; const float* b_router; const float* w_exp_gate; const float* w_exp_up; const float* w_exp_down;
    const float* ln2_g; const float* ln2_b;
    float* out; unsigned char* ws; int ph_lo, ph_hi;
};

typedef const Args __attribute__((address_space(4)))* ArgsP;

__device__ __forceinline__ void transpose_item(const float* W, int N, int k0, int n0, bf16_t* WT, int ldk, int drow0, LAS float* scr, int lane) {
    float tv[32];
    { const float* wp = W + (size_t)(k0 + (lane >> 5)) * N + n0 + (lane & 31);
#pragma unroll
      for (int i = 0; i < 32; ++i) tv[i] = wp[(size_t)(2 * i) * N]; }
#pragma unroll
    for (int i = 0; i < 32; ++i) scr[(2 * i + (lane >> 5)) * 33 + (lane & 31)] = tv[i];
    LDS_WAIT(); asm volatile("" ::: "memory");
    const int c = lane & 7;
#pragma unroll
    for (int j = 0; j < 4; ++j) { const int n = (lane >> 3) + 8 * j; const LAS float* s = scr + (8 * c) * 33 + n;
        u32x4 o; o.x = cvt_pk_bf16(s[0 * 33], s[1 * 33]); o.y = cvt_pk_bf16(s[2 * 33], s[3 * 33]); o.z = cvt_pk_bf16(s[4 * 33], s[5 * 33]); o.w = cvt_pk_bf16(s[6 * 33], s[7 * 33]);
        st16(WT + (size_t)(drow0 + n) * ldk + k0 + 8 * c, o); }
    LDS_WAIT(); asm volatile("" ::: "memory");
}
__device__ __forceinline__ void transpose_item8(const float* W, int N, int k0, int n0, unsigned char* WT, int ldk, int drow0, float sc, LAS float* scr, int lane) {
    float tv[32];
    { const float* wp = W + (size_t)(k0 + (lane >> 5)) * N + n0 + (lane & 31);
#pragma unroll
      for (int i = 0; i < 32; ++i) tv[i] = wp[(size_t)(2 * i) * N]; }
#pragma unroll
    for (int i = 0; i < 32; ++i) scr[(2 * i + (lane >> 5)) * 33 + (lane & 31)] = tv[i];
    LDS_WAIT(); asm volatile("" ::: "memory");
    const int c = lane & 7;
#pragma unroll
    for (int j = 0; j < 4; ++j) { const int n = (lane >> 3) + 8 * j; const LAS float* s = scr + (8 * c) * 33 + n;
        u32x2 o; o.x = pk4_fp8(sc * s[0 * 33], sc * s[1 * 33], sc * s[2 * 33], sc * s[3 * 33]); o.y = pk4_fp8(sc * s[4 * 33], sc * s[5 * 33], sc * s[6 * 33], sc * s[7 * 33]);
        *(u32x2*)(WT + (size_t)(drow0 + n) * ldk + k0 + 8 * c) = o; }
    LDS_WAIT(); asm volatile("" ::: "memory");
}
__device__ __forceinline__ void transpose_plain(const float* W, int K, int N, bf16_t* WT, int item, LAS float* scr, int lane) {
    const int nblk = N / 32, kb = item / nblk, nb = item % nblk;
    transpose_item(W, N, 64 * kb, 32 * nb, WT, K, 32 * nb, scr, lane);
}

__device__ __forceinline__ void prep_tm_weights(ArgsP a, int l, unsigned char* ws, LAS float* scr, int gw, int NGW, int lane) {
    constexpr int I_IN = (D / 64) * (DIN / 32), I_A = (D / 64) * (D / 32), I_R = (DR / 64) * (D / 32), I_O = I_A, I_G = 2 * NHEAD * 2 * 4;
    constexpr int NITEMS = I_IN + I_A + I_R + I_O + I_G;
    if (gw < 20) { const int c = gw * 64 + lane; float* PC = (float*)(ws + WS_SMALL + SM_PCONST);
        PC[c] = 8.0f * log1pf(__expf(-a->rg_lambda[(size_t)l * DR + c])); PC[DR + c] = a->b_rg_a[(size_t)l * DR + c]; PC[2 * DR + c] = a->b_rg_x[(size_t)l * DR + c]; }
    for (int it = gw; it < NITEMS; it += NGW) {
        int r = it;
        if (r < I_IN) { const int nblk = DIN / 32, kb = r / nblk, n0 = 32 * (r % nblk);
            const int drow0 = n0 < 1024 ? (n0 >> 7) * 256 + (n0 & 127) : (n0 < 2048 ? n0 + 1024 : (n0 < 3072 ? ((n0 - 2048) >> 7) * 256 + 128 + (n0 & 127) : n0));
            transpose_item8(a->w_in + (size_t)l * D * DIN, DIN, 64 * kb, n0, ws + WS_WIN, D, drow0, 32.f, scr, lane); continue; } r -= I_IN;
        if (r < I_A) { const int kb = r / (D / 32), nb = r % (D / 32); transpose_item8(a->w_branch_a + (size_t)l * D * D, D, 64 * kb, 32 * nb, ws + WS_WA, UC, 32 * nb, 64.f, scr, lane); continue; } r -= I_A;
        if (r < I_R) { const int kb = r / (D / 32), nb = r % (D / 32); transpose_item8(a->w_branch_r + (size_t)l * DR * D, D, 64 * kb, 32 * nb, ws + WS_WA + D, UC, 32 * nb, 16.f, scr, lane); continue; } r -= I_R;
        if (r < I_O) { const int kb = r / (D / 32), nb = r % (D / 32); transpose_item8(a->w_out + (size_t)l * D * D, D, 64 * kb, 32 * nb, ws + WS_WO, D, 32 * nb, 64.f, scr, lane); continue; } r -= I_O;
        {
            const int nb = r & 3, kb = (r >> 2) & 1, hw = r >> 3, which = hw & 1, hh = hw >> 1;
            const float* W = (which ? a->w_rg_x : a->w_rg_a) + ((size_t)l * NHEAD + hh) * 128 * 128;
            transpose_item(W, 128, 64 * kb, 32 * nb, (bf16_t*)(ws + WS_WG), 128, hh * 256 + which * 128 + 32 * nb, scr, lane);
        }
    }
}
template <bool F8>
__device__ __forceinline__ void prep_expert_weights(ArgsP a, int l, unsigned char* ws, LAS float* scr, int gw, int NGW, int lane) {
    constexpr int I_G = (D / 64) * (FF / 32), I_D = (FF / 64) * (D / 32), PER_E = 2 * I_G + I_D, ES = F8 ? 1 : 2;
    unsigned char* WGU = ws + WS_WEX; unsigned char* WDN = WGU + (size_t)NE * 1024 * 1024 * ES;
    for (int it = gw; it < NE * PER_E; it += NGW) {
        const int e = it / PER_E; int r = it % PER_E;
        if (r < 2 * I_G) { const int which = r / I_G; r %= I_G; const int nblk = FF / 32, kb = r / nblk, nb = r % nblk, n0 = 32 * nb;
            const float* W = (which ? a->w_exp_up : a->w_exp_gate) + ((size_t)l * NE + e) * D * FF;
            const int drow0 = (n0 >> 7) * 256 + which * 128 + (n0 & 127);
            if constexpr (F8) transpose_item8(W, FF, 64 * kb, n0, WGU + (size_t)e * 1024 * 1024, D, drow0, 32.f, scr, lane);
            else transpose_item(W, FF, 64 * kb, n0, (bf16_t*)WGU + (size_t)e * 1024 * 1024, D, drow0, scr, lane);
        } else { r -= 2 * I_G; const float* W = a->w_exp_down + ((size_t)l * NE + e) * FF * D; const int kb = r / (D / 32), nb = r % (D / 32);
            if constexpr (F8) transpose_item8(W, D, 64 * kb, 32 * nb, WDN + (size_t)e * 1024 * 512, FF, 32 * nb, 32.f, scr, lane);
            else transpose_item(W, D, 64 * kb, 32 * nb, (bf16_t*)WDN + (size_t)e * 1024 * 512, FF, 32 * nb, scr, lane); }
    }
}
__device__ __forceinline__ void cvt_x(const float* x, unsigned char* xb, int gtid, int nthr) {
    for (size_t i = gtid; i < (size_t)T * D / 8; i += (size_t)4 * nthr) {
        f32x4 a[4], b[4];
#pragma unroll
        for (int k = 0; k < 4; ++k) { a[k] = *(const f32x4*)(x + (i + (size_t)k * nthr) * 8); b[k] = *(const f32x4*)(x + (i + (size_t)k * nthr) * 8 + 4); }
#pragma unroll
        for (int k = 0; k < 4; ++k) { u32x2 w; w.x = pk4_fp8(a[k][0], a[k][1], a[k][2], a[k][3]); w.y = pk4_fp8(b[k][0], b[k][1], b[k][2], b[k][3]); *(u32x2*)(xb + (i + (size_t)k * nthr) * 8) = w; } }
}
__device__ __forceinline__ void unpack8(const u32x4 w, float (&f)[8]) { f[0] = bflo(w.x); f[1] = bfhi(w.x); f[2] = bflo(w.y); f[3] = bfhi(w.y); f[4] = bflo(w.z); f[5] = bfhi(w.z); f[6] = bflo(w.w); f[7] = bfhi(w.w); }
__device__ __forceinline__ u32x4 pack8(const float (&f)[8]) { u32x4 w; w.x = cvt_pk_bf16(f[0], f[1]); w.y = cvt_pk_bf16(f[2], f[3]); w.z = cvt_pk_bf16(f[4], f[5]); w.w = cvt_pk_bf16(f[6], f[7]); return w; }

__device__ __forceinline__ void phase_e1(ArgsP a, int l, int half, unsigned char* ws, int gtid, int nthr) {
    const bf16_t* Z = (const bf16_t*)(ws + WS_Z); unsigned char* UA = ws + WS_U + (size_t)half * TH * UC; bf16_t* XC = (bf16_t*)(ws + WS_XC);
    constexpr int RUN = 8;
    constexpr int NA = (TH / RUN) * (D / 8), NR = (TH / RUN) * (DR / 8);
    for (int it = gtid; it < NA + NR; it += nthr) {
        if (it < NA) {
            const int cg = it % (D / 8), run = it / (D / 8), t0 = run * RUN, c0 = cg * 8;
            const bool first = (t0 & (SEQ - 1)) == 0;
            u32x4 vv[RUN + 2], bw[RUN];
            vv[0] = first ? (u32x4){0u, 0u, 0u, 0u} : *(const u32x4*)(Z + (size_t)(t0 - 2) * ZC + c0);
            vv[1] = first ? (u32x4){0u, 0u, 0u, 0u} : *(const u32x4*)(Z + (size_t)(t0 - 1) * ZC + c0);
#pragma unroll
            for (int i = 0; i < RUN; ++i) { vv[i + 2] = *(const u32x4*)(Z + (size_t)(t0 + i) * ZC + c0); bw[i] = *(const u32x4*)(Z + (size_t)(t0 + i) * ZC + D + c0); }
            float w0[8], w1[8], w2[8];
            { const float* cw = a->conv_a_w + (size_t)l * 3 * D + c0;
#pragma unroll
              for (int j = 0; j < 8; ++j) { w0[j] = cw[j]; w1[j] = cw[D + j]; w2[j] = cw[2 * D + j]; } }
            float vm2[8], vm1[8]; unpack8(vv[0], vm2); unpack8(vv[1], vm1);
#pragma unroll
            for (int i = 0; i < RUN; ++i) { float v[8], bb[8], o[8]; unpack8(vv[i + 2], v); unpack8(bw[i], bb);
#pragma unroll
                for (int j = 0; j < 8; ++j) { o[j] = bb[j] * (w0[j] * vm2[j] + w1[j] * vm1[j] + w2[j] * v[j]); vm2[j] = vm1[j]; vm1[j] = v[j]; }
                u32x2 w8; w8.x = pk4_fp8(o[0], o[1], o[2], o[3]); w8.y = pk4_fp8(o[4], o[5], o[6], o[7]); *(u32x2*)(UA + (size_t)(t0 + i) * UC + c0) = w8; }
        } else {
            const int r = it - NA; const int cg = r % (DR / 8), run = r / (DR / 8), t0 = run * RUN, c0 = cg * 8;
            const bool first = (t0 & (SEQ - 1)) == 0;
            u32x4 xv[RUN + 3];
#pragma unroll
            for (int i = 0; i < 3; ++i) xv[i] = first ? (u32x4){0u, 0u, 0u, 0u} : *(const u32x4*)(Z + (size_t)(t0 - 3 + i) * ZC + 2 * D + c0);
#pragma unroll
            for (int i = 0; i < RUN; ++i) xv[i + 3] = *(const u32x4*)(Z + (size_t)(t0 + i) * ZC + 2 * D + c0);
            float w0[8], w1[8], w2[8], w3[8], bi[8];
            { const float* cw = a->conv_r_w + (size_t)l * 4 * DR + c0; const float* cb = a->conv_r_b + (size_t)l * DR + c0;
#pragma unroll
              for (int j = 0; j < 8; ++j) { w0[j] = cw[j]; w1[j] = cw[DR + j]; w2[j] = cw[2 * DR + j]; w3[j] = cw[3 * DR + j]; bi[j] = cb[j]; } }
            float x3[8], x2[8], x1[8]; unpack8(xv[0], x3); unpack8(xv[1], x2); unpack8(xv[2], x1);
#pragma unroll
            for (int i = 0; i < RUN; ++i) { float x0[8], o[8]; unpack8(xv[i + 3], x0);
#pragma unroll
                for (int j = 0; j < 8; ++j) { o[j] = w0[j] * x3[j] + w1[j] * x2[j] + w2[j] * x1[j] + w3[j] * x0[j] + bi[j]; x3[j] = x2[j]; x2[j] = x1[j]; x1[j] = x0[j]; }
                st16(XC + (size_t)(t0 + i) * DR + c0, pack8(o)); }
        }
    }
}

__device__ __forceinline__ void phase_scan(unsigned char* ws, int gtid, int nthr) {
    const bf16_t* GT = (const bf16_t*)(ws + WS_GT); const bf16_t* YR = (const bf16_t*)(ws + WS_YR);
    const float* AEND = (const float*)(ws + WS_SMALL + SM_AEND); const float* HEND = (const float*)(ws + WS_SMALL + SM_HEND);
    unsigned char* UR = ws + WS_U + D;
    constexpr int NP = DR / 4, NITEMS = NBATCH * NSCH * NP, BT = 16;
    for (int it = gtid; it < NITEMS; it += nthr) {
        const int cp = it % NP, j = (it / NP) % NSCH, b = it / (NP * NSCH), c = 4 * cp, hh = c >> 7, cc = c & 127;
        f32x4 h = (f32x4){0.f, 0.f, 0.f, 0.f};
        { const size_t sb = (size_t)b * NSCH * DR + c; int jj = 0;
          for (; jj + 8 <= j; jj += 8) { f32x4 ae[8], he[8];
#pragma unroll
              for (int k = 0; k < 8; ++k) { ae[k] = *(const f32x4*)(AEND + sb + (size_t)(jj + k) * DR); he[k] = *(const f32x4*)(HEND + sb + (size_t)(jj + k) * DR); }
#pragma unroll
              for (int k = 0; k < 8; ++k) h = ae[k] * h + he[k]; }
          for (; jj < j; ++jj) { const f32x4 ae = *(const f32x4*)(AEND + sb + (size_t)jj * DR), he = *(const f32x4*)(HEND + sb + (size_t)jj * DR); h = ae * h + he; } }
        const size_t row0 = (size_t)b * SEQ + (size_t)j * SCH;
        const bf16_t* gl = GT + row0 * 2560 + hh * 256 + cc; const bf16_t* zy = YR + row0 * DR + c; unsigned char* ur = UR + row0 * UC + c;
#pragma unroll 1
        for (int t0 = 0; t0 < SCH; t0 += BT) {
            u32x2 lw[BT], bw[BT], yw[BT];
#pragma unroll
            for (int k = 0; k < BT; ++k) { lw[k] = *(const u32x2*)(gl + (size_t)(t0 + k) * 2560); bw[k] = *(const u32x2*)(gl + (size_t)(t0 + k) * 2560 + 128); yw[k] = *(const u32x2*)(zy + (size_t)(t0 + k) * DR); }
#pragma unroll
            for (int k = 0; k < BT; ++k) {
                h[0] = __builtin_amdgcn_exp2f(1.4426950408889634f * bflo(lw[k].x)) * h[0] + bflo(bw[k].x); h[1] = __builtin_amdgcn_exp2f(1.4426950408889634f * bfhi(lw[k].x)) * h[1] + bfhi(bw[k].x);
                h[2] = __builtin_amdgcn_exp2f(1.4426950408889634f * bflo(lw[k].y)) * h[2] + bflo(bw[k].y); h[3] = __builtin_amdgcn_exp2f(1.4426950408889634f * bfhi(lw[k].y)) * h[3] + bfhi(bw[k].y);
                *(unsigned*)(ur + (size_t)(t0 + k) * UC) = pk4_fp8(4.f * h[0] * bflo(yw[k].x), 4.f * h[1] * bfhi(yw[k].x), 4.f * h[2] * bflo(yw[k].y), 4.f * h[3] * bfhi(yw[k].y)); }
        }
    }
}

template <bool moe8>
__device__ __forceinline__ void phase_ln1_router(ArgsP a, int l, unsigned char* ws, LAS unsigned char* lds, int tid, int lane, int gw, int NGW, int vcu) {
    LAS f32x4* wl = (LAS f32x4*)lds;
    for (int idx = tid; idx < 4096; idx += 512) { const int ln = idx & 63, q = (idx >> 6) & 3, jk = idx >> 8, d = 4 * ln + 256 * (jk >> 2) + (jk & 3);
        wl[idx] = *(const f32x4*)(a->w_router + (size_t)d * NE + 4 * q); }
    LAS unsigned* lcnt = (LAS unsigned*)(lds + 65536);
    if (tid < NE) lcnt[tid] = 0u;
    __syncthreads();
    const float* Y = (const float*)(ws + WS_Y); float* X1 = (float*)(ws + WS_X1); bf16_t* XB = (bf16_t*)(ws + WS_XB);
    unsigned* TOKE = (unsigned*)(ws + WS_SMALL + SM_TOKE); unsigned* TOKP = (unsigned*)(ws + WS_SMALL + SM_TOKP); float* TOKW = (float*)(ws + WS_SMALL + SM_TOKW);
    f32x4 gv[4], bv[4];
#pragma unroll
    for (int j = 0; j < 4; ++j) { gv[j] = *(const f32x4*)(a->ln1_g + (size_t)l * D + 4 * lane + 256 * j); bv[j] = *(const f32x4*)(a->ln1_b + (size_t)l * D + 4 * lane + 256 * j); }
    float br[16];
#pragma unroll
    for (int e = 0; e < 16; ++e) br[e] = a->b_router[e];
    for (int t = gw; t < T; t += NGW) {
        f32x4 v[4]; float s = 0.f;
#pragma unroll
        for (int j = 0; j < 4; ++j) { v[j] = *(const f32x4*)(Y + (size_t)t * D + 4 * lane + 256 * j); s += (v[j][0] + v[j][1]) + (v[j][2] + v[j][3]); }
        const float mean = wave_sum(s, lane) * (1.f / D); float s2 = 0.f;
#pragma unroll
        for (int j = 0; j < 4; ++j) { v[j] = v[j] - mean; s2 += (v[j][0] * v[j][0] + v[j][1] * v[j][1]) + (v[j][2] * v[j][2] + v[j][3] * v[j][3]); }
        const float rstd = 1.f / sqrtf(wave_sum(s2, lane) * (1.f / D) + LN_EPS);
        float acc[16];
#pragma unroll
        for (int e = 0; e < 16; ++e) acc[e] = 0.f;
#pragma unroll
        for (int j = 0; j < 4; ++j) { v[j] = v[j] * rstd * gv[j] + bv[j];
            st16f(X1 + (size_t)t * D + 4 * lane + 256 * j, v[j]);
            if constexpr (moe8) *(unsigned*)((unsigned char*)XB + (size_t)t * D + 4 * lane + 256 * j) = pk4_fp8(v[j][0], v[j][1], v[j][2], v[j][3]);
            else { u32x2 w; w.x = cvt_pk_bf16(v[j][0], v[j][1]); w.y = cvt_pk_bf16(v[j][2], v[j][3]); *(u32x2*)(XB + (size_t)t * D + 4 * lane + 256 * j) = w; }
#pragma unroll
            for (int k = 0; k < 4; ++k) { const float xv = v[j][k];
#pragma unroll
                for (int q = 0; q < 4; ++q) { const f32x4 w4 = wl[((j * 4 + k) * 4 + q) * 64 + lane]; acc[4 * q] += xv * w4[0]; acc[4 * q + 1] += xv * w4[1]; acc[4 * q + 2] += xv * w4[2]; acc[4 * q + 3] += xv * w4[3]; } } }
        float r8[8], r4[4], r2[2], r1;
        { const bool hi = (lane & 32) != 0;
#pragma unroll
          for (int i = 0; i < 8; ++i) { const float keep = hi ? acc[i + 8] : acc[i], send = hi ? acc[i] : acc[i + 8]; r8[i] = keep + lane_xor(send, 32, lane); } }
        { const bool hi = (lane & 16) != 0;
#pragma unroll
          for (int i = 0; i < 4; ++i) { const float keep = hi ? r8[i + 4] : r8[i], send = hi ? r8[i] : r8[i + 4]; r4[i] = keep + lane_xor(send, 16, lane); } }
        { const bool hi = (lane & 8) != 0;
#pragma unroll
          for (int i = 0; i < 2; ++i) { const float keep = hi ? r4[i + 2] : r4[i], send = hi ? r4[i] : r4[i + 2]; r2[i] = keep + lane_xor(send, 8, lane); } }
        { const bool hi = (lane & 4) != 0; const float keep = hi ? r2[1] : r2[0], send = hi ? r2[0] : r2[1]; r1 = keep + lane_xor(send, 4, lane); }
        r1 += lane_xor(r1, 2, lane); r1 += lane_xor(r1, 1, lane);
        float lg[16]; float mx = -3.0e38f;
#pragma unroll
        for (int e = 0; e < 16; ++e) { lg[e] = lane_get(r1, 4 * e) + br[e]; mx = fmaxf(mx, lg[e]); }
        float p[16];
#pragma unroll
        for (int e = 0; e < 16; ++e) p[e] = __expf(lg[e] - mx);
        int gsel = 0; float gbest = -1.f;
#pragma unroll
        for (int g = 0; g < 4; ++g) { const float p0 = p[4 * g], p1 = p[4 * g + 1], p2 = p[4 * g + 2], p3 = p[4 * g + 3];
            const float sum = (p0 + p1) + (p2 + p3), mn1 = fminf(fminf(p0, p1), fminf(p2, p3));
            const float hi01 = fmaxf(p0, p1), lo01 = fminf(p0, p1), hi23 = fmaxf(p2, p3), lo23 = fminf(p2, p3);
            const float top1 = fmaxf(hi01, hi23), top2 = fmaxf(fminf(hi01, hi23), fmaxf(lo01, lo23));
            (void)sum; (void)mn1;
            const float sc = top1 + top2; if (sc > gbest) { gbest = sc; gsel = g; } }
        float q0, q1, q2, q3;
        q0 = gsel == 0 ? p[0] : gsel == 1 ? p[4] : gsel == 2 ? p[8] : p[12];
        q1 = gsel == 0 ? p[1] : gsel == 1 ? p[5] : gsel == 2 ? p[9] : p[13];
        q2 = gsel == 0 ? p[2] : gsel == 1 ? p[6] : gsel == 2 ? p[10] : p[14];
        q3 = gsel == 0 ? p[3] : gsel == 1 ? p[7] : gsel == 2 ? p[11] : p[15];
        int i1 = 0; float v1 = q0;
        if (q1 > v1) { v1 = q1; i1 = 1; } if (q2 > v1) { v1 = q2; i1 = 2; } if (q3 > v1) { v1 = q3; i1 = 3; }
        int i2 = -1; float v2 = -1.f;
        if (i1 != 0 && q0 > v2) { v2 = q0; i2 = 0; } if (i1 != 1 && q1 > v2) { v2 = q1; i2 = 1; } if (i1 != 2 && q2 > v2) { v2 = q2; i2 = 2; } if (i1 != 3 && q3 > v2) { v2 = q3; i2 = 3; }
        const float inv = 1.0f / (v1 + v2);
        if (lane == 0) { const int e1 = 4 * gsel + i1, e2 = 4 * gsel + i2;
            const unsigned pos1 = __hip_atomic_fetch_add(lcnt + e1, 1u, __ATOMIC_RELAXED, __HIP_MEMORY_SCOPE_WORKGROUP);
            const unsigned pos2 = __hip_atomic_fetch_add(lcnt + e2, 1u, __ATOMIC_RELAXED, __HIP_MEMORY_SCOPE_WORKGROUP);
            TOKE[t] = (unsigned)e1 | ((unsigned)e2 << 8); TOKP[2 * t] = pos1; TOKP[2 * t + 1] = pos2; TOKW[2 * t] = v1 * inv; TOKW[2 * t + 1] = v2 * inv; }
    }
    __syncthreads();
    if (tid < NE) ((unsigned*)(ws + WS_SMALL + SM_WGCNT))[vcu * NE + tid] = lcnt[tid];
}

__device__ __forceinline__ void phase_moe_lists(unsigned char* ws, LAS unsigned char* lds, int tid, int lane, int gw, int NGW, int vcu, int G, bool moe8) {
    unsigned* ctl = (unsigned*)(ws + WS_CTL);
    LAS unsigned* off = (LAS unsigned*)lds;
    { const unsigned* WGCNT = (const unsigned*)(ws + WS_SMALL + SM_WGCNT);
      const int e = tid & 15, p = tid >> 4; unsigned tot = 0, pre = 0;
      for (int v = p; v < G; v += 32) { const unsigned c = WGCNT[v * NE + e]; tot += c; pre += (v < vcu) ? c : 0u; }
      off[128 + p * 16 + e] = tot; off[128 + 512 + p * 16 + e] = pre; }
    __syncthreads();
    if (tid < NE) { unsigned tot = 0, pre = 0; for (int p = 0; p < 32; ++p) { tot += off[128 + p * 16 + tid]; pre += off[128 + 512 + p * 16 + tid]; } off[32 + tid] = tot; off[48 + tid] = pre; }
    __syncthreads();
    if (tid == 0) { unsigned o = 0;
        for (int e = 0; e < NE; ++e) { const unsigned c = off[32 + e]; off[e] = o; off[64 + e] = o + off[48 + e]; o += (c + 255u) & ~255u; }
        off[16] = o; }
    __syncthreads();
    int* ROWINFO = (int*)(ws + WS_SMALL + SM_ROWINFO);
    if (blockIdx.x == 0) {
        if (tid == 0) ctl[CW_NTILES] = off[16] >> 8;
        if (tid < NE) { const unsigned t0 = off[tid] >> 8, t1 = off[tid + 1] >> 8; for (unsigned tt = t0; tt < t1; ++tt) ctl[CW_TILEE + tt] = (unsigned)tid; }
        for (int e = 0; e < NE; ++e) { const unsigned p0 = off[e] + off[32 + e], p1 = off[e + 1]; for (unsigned r = p0 + tid; r < p1; r += 512) ROWINFO[r] = -1; }
    }
    const bf16_t* XB = (const bf16_t*)(ws + WS_XB); bf16_t* XG = (bf16_t*)(ws + WS_XG);
    const unsigned* TOKE = (const unsigned*)(ws + WS_SMALL + SM_TOKE); const unsigned* TOKP = (const unsigned*)(ws + WS_SMALL + SM_TOKP);
    for (int t = gw; t < T; t += NGW) {
        const unsigned ee = TOKE[t]; const unsigned r1 = off[64 + (ee & 255u)] + TOKP[2 * t], r2 = off[64 + ((ee >> 8) & 255u)] + TOKP[2 * t + 1];
        if (moe8) { const u32x4 v0 = *(const u32x4*)((const unsigned char*)XB + (size_t)t * D + 16 * lane);
            st16((unsigned char*)XG + (size_t)r1 * D + 16 * lane, v0); st16((unsigned char*)XG + (size_t)r2 * D + 16 * lane, v0);
        } else { const u32x4 v0 = *(const u32x4*)(XB + (size_t)t * D + 8 * lane), v1 = *(const u32x4*)(XB + (size_t)t * D + 512 + 8 * lane);
            st16(XG + (size_t)r1 * D + 8 * lane, v0); st16(XG + (size_t)r1 * D + 512 + 8 * lane, v1);
            st16(XG + (size_t)r2 * D + 8 * lane, v0); st16(XG + (size_t)r2 * D + 512 + 8 * lane, v1); }
        if (lane == 0) { ROWINFO[r1] = 2 * t; ROWINFO[r2] = 2 * t + 1; }
    }
}

__device__ __forceinline__ void phase_ln2(ArgsP a, int l, unsigned char* ws, float* out, int lane, int gw, int NGW) {
    const float* X1 = (const float*)(ws + WS_X1); const bf16_t* O = (const bf16_t*)(ws + WS_O); unsigned char* X8 = ws + WS_XB;
    const float* TOKW = (const float*)(ws + WS_SMALL + SM_TOKW);
    f32x4 gv[4], bv[4];
#pragma unroll
    for (int j = 0; j < 4; ++j) { gv[j] = *(const f32x4*)(a->ln2_g + (size_t)l * D + 4 * lane + 256 * j); bv[j] = *(const f32x4*)(a->ln2_b + (size_t)l * D + 4 * lane + 256 * j); }
    for (int t = gw; t < T; t += NGW) {
        const float w1 = TOKW[2 * t], w2 = TOKW[2 * t + 1];
        f32x4 v[4]; float s = 0.f;
#pragma unroll
        for (int j = 0; j < 4; ++j) { const f32x4 x = *(const f32x4*)(X1 + (size_t)t * D + 4 * lane + 256 * j);
            const u32x2 o1 = *(const u32x2*)(O + (size_t)(2 * t) * D + 4 * lane + 256 * j), o2 = *(const u32x2*)(O + (size_t)(2 * t + 1) * D + 4 * lane + 256 * j);
            f32x4 mo; mo[0] = w1 * bflo(o1.x) + w2 * bflo(o2.x); mo[1] = w1 * bfhi(o1.x) + w2 * bfhi(o2.x); mo[2] = w1 * bflo(o1.y) + w2 * bflo(o2.y); mo[3] = w1 * bfhi(o1.y) + w2 * bfhi(o2.y);
            v[j] = x * DN_ALPHA + mo; s += (v[j][0] + v[j][1]) + (v[j][2] + v[j][3]); }
        const float mean = wave_sum(s, lane) * (1.f / D); float s2 = 0.f;
#pragma unroll
        for (int j = 0; j < 4; ++j) { v[j] = v[j] - mean; s2 += (v[j][0] * v[j][0] + v[j][1] * v[j][1]) + (v[j][2] * v[j][2] + v[j][3] * v[j][3]); }
        const float rstd = 1.f / sqrtf(wave_sum(s2, lane) * (1.f / D) + LN_EPS);
#pragma unroll
        for (int j = 0; j < 4; ++j) { v[j] = v[j] * rstd * gv[j] + bv[j];
            st16f(out + (size_t)t * D + 4 * lane + 256 * j, v[j]);
            *(unsigned*)(X8 + (size_t)t * D + 4 * lane + 256 * j) = pk4_fp8(v[j][0], v[j][1], v[j][2], v[j][3]); }
    }
}

constexpr int STEPS_PER_LAYER = 4 * NCHUNK + 7;
constexpr int N_STEPS = 1 + DEPTH * STEPS_PER_LAYER;

__global__ void __launch_bounds__(512, 2) mk_fwd(Args args_by_value) {
    (void)args_by_value;
    extern __shared__ __attribute__((aligned(16))) unsigned char lds_raw[];
    LAS unsigned char* lds = (LAS unsigned char*)lds_raw;
    volatile LAS unsigned* MISC = (volatile LAS unsigned*)(lds + MISC_OFF);
    const int tid0 = threadIdx.x;
    const int wave0 = __builtin_amdgcn_readfirstlane(tid0 >> 6);
    const int G = gridDim.x; const int bx = blockIdx.x; const int vcu0 = (G % 8 == 0) ? (bx % 8) * (G / 8) + bx / 8 : bx;
    const int NGW = G * 8, nthr = G * 512;
    ArgsP ap0 = (ArgsP)__builtin_amdgcn_kernarg_segment_ptr();
    unsigned char* ws0 = ap0->ws;
    unsigned* ctl = (unsigned*)(ws0 + WS_CTL);
    for (int u = tid0; u < (LDS_BYTES - LDSCTL_OFF) / 4; u += 512) ((LAS unsigned*)(lds + LDSCTL_OFF))[u] = 0u;
    __syncthreads();
    XcdBarrier bar; bar.bar = ctl + CW_BAR; bar.x = 0; bar.st = nullptr;
    if (!MK_PER_STEP_LAUNCH) bar = xcd_barrier_post(ctl + CW_BAR, MISC + 8);
    const int lo = ap0->ph_lo, hi = ap0->ph_hi;
    int step = 0;
    if ((MK_TP >= 0 || MK_TQ >= 0) && bx == 0 && tid0 == 0) { volatile LAS unsigned long long* tw_ = (volatile LAS unsigned long long*)(lds + LDSCTL_OFF + 512); tw_[0] = __builtin_amdgcn_s_memrealtime(); tw_[1] = 0; tw_[2] = 0; }
#ifndef MK_MASK
#define MK_MASK 0xFFFFFFFFu
#endif
#ifndef MK_REPEAT
#define MK_REPEAT 0u
#endif
#ifndef MK_BAR2
#define MK_BAR2 0
#endif
#define STEP_BEGIN(id) if (((MK_MASK >> (id)) & 1u) && lo <= step && step < hi) { const int step_id_ = (id); (void)step_id_; for (int rep = 0; rep < 1 + (int)((MK_REPEAT >> (id)) & 1u); ++rep) { if (rep) __syncthreads(); unsigned char* ws = ws0; asm volatile("" : "+s"(ws)); ArgsP args = ap0; asm volatile("" : "+s"(args)); int lz_ = 0; asm volatile("" : "+v"(lz_)); int wv_ = wave0; asm volatile("" : "+s"(wv_)); int vcu = vcu0; asm volatile("" : "+s"(vcu)); \
    const int lane = (int)__builtin_amdgcn_mbcnt_hi(~0u, __builtin_amdgcn_mbcnt_lo(~0u, (unsigned)lz_)), wave = wv_, tid = wave * 64 + lane, gw = vcu * 8 + wave, gtid = vcu * 512 + tid; LAS float* scr = (LAS float*)(lds + wave * 16384); (void)lane; (void)gw; (void)gtid; (void)scr;
#define STEP_END   } if (step + 1 < hi) { if (MK_PER_STEP_LAUNCH) {} else { xcd_barrier(bar); if (MK_BAR2) xcd_barrier(bar); } } \
    if ((MK_TP >= 0 || MK_TQ >= 0) && bx == 0 && tid0 == 0) { const unsigned long long now_ = __builtin_amdgcn_s_memrealtime(); volatile LAS unsigned long long* tw_ = (volatile LAS unsigned long long*)(lds + LDSCTL_OFF + 512); \
        const unsigned long long dt_ = now_ - tw_[0]; tw_[0] = now_; if (step_id_ == MK_TP) tw_[1] += dt_; if (step_id_ == MK_TQ) tw_[2] += dt_; } } ++step;

    STEP_BEGIN(0)
        prep_tm_weights(args, 0, ws, scr, gw, NGW, lane);
        cvt_x(args->x, ws + WS_XB, gtid, nthr);
    STEP_END

#pragma unroll 1
    for (int l = 0; l < DEPTH; ++l) {

#pragma unroll 1
        for (int half = 0; half < NCHUNK; ++half) {
            STEP_BEGIN(1)
                pg8::SchedPlain S{TH / 256, DIN / 256, G, bx, (const char*)(ws + WS_XB) + (size_t)half * TH * D, (const char*)(ws + WS_WIN), (size_t)256 * D, (size_t)256 * D, 0};
                pg8::EpiZ E{(bf16_t*)(ws + WS_Z), (bf16_t*)(ws + WS_GG), (bf16_t*)(ws + WS_YR), half * TH};
                pg8::gemm_phase<pg8::EpiZ, pg8::SchedPlain, true, -1, true>(lds, D, D, D, S, E, tid, 0x7a7a7a7a);
            STEP_END
            STEP_BEGIN(2)
                phase_e1(args, l, half, ws, gtid, nthr);
            STEP_END
            STEP_BEGIN(3)
                pg8::SchedPlain S{TH / 256, NHEAD, G, bx, (const char*)(ws + WS_XC), (const char*)(ws + WS_WG), (size_t)256 * DR * 2, (size_t)256 * 128 * 2, (size_t)128 * 2};
                LAS unsigned* pcl = (LAS unsigned*)(lds + LDSCTL_OFF + 1024);
                { const float* PC = (const float*)(ws + WS_SMALL + SM_PCONST);
                  for (int c = tid; c < DR; c += 512) pcl[c] = cvt_pk_bf16(PC[c], PC[DR + c]);
                  for (int c = tid; c < DR / 2; c += 512) pcl[DR + c] = cvt_pk_bf16(PC[2 * DR + 2 * c], PC[2 * DR + 2 * c + 1]); }
                __syncthreads();
                pg8::EpiRG E{ws, half, pcl};
                pg8::gemm_phase<pg8::EpiRG, pg8::SchedPlain, true>(lds, DR * 2, 128 * 2, 128 * 2, S, E, tid);
            STEP_END
            STEP_BEGIN(5)
                phase_scan(ws, gtid, nthr);
            STEP_END
        }
        STEP_BEGIN(6)
            pg8::SchedPlain S{T / 256, D / 256, G, bx, (const char*)(ws + WS_U), (const char*)(ws + WS_WA), (size_t)256 * UC, (size_t)256 * UC, 0};
            pg8::EpiMix E{(const bf16_t*)(ws + WS_GG), (unsigned char*)(ws + WS_MERGED)};
            pg8::gemm_phase<pg8::EpiMix, pg8::SchedPlain, true, 8, true>(lds, UC, UC, UC, S, E, tid, 0x79797979);
        STEP_END
        STEP_BEGIN(8)
            pg8::SchedPlain S{T / 256, D / 256, G, bx, (const char*)(ws + WS_MERGED), (const char*)(ws + WS_WO), (size_t)256 * D, (size_t)256 * D, 0};
            pg8::EpiY E{(l == 0) ? args->x : (const float*)args->out, (float*)(ws + WS_Y)};
            pg8::gemm_phase<pg8::EpiY, pg8::SchedPlain, true, -1, true>(lds, D, D, D, S, E, tid, 0x77777777);
        STEP_END
        STEP_BEGIN(9)
            if ((MOE_FP8_MASK >> l) & 1u) prep_expert_weights<true>(args, l, ws, scr, gw, NGW, lane); else prep_expert_weights<false>(args, l, ws, scr, gw, NGW, lane);
            __syncthreads();
            if (rep == 0) { if ((MOE_FP8_MASK >> l) & 1u) phase_ln1_router<true>(args, l, ws, lds, tid, lane, gw, NGW, vcu); else phase_ln1_router<false>(args, l, ws, lds, tid, lane, gw, NGW, vcu); }
        STEP_END
        STEP_BEGIN(10)
            phase_moe_lists(ws, lds, tid, lane, gw, NGW, vcu, G, (MOE_FP8_MASK >> l) & 1u);
            __syncthreads();
            if (l + 1 < DEPTH) prep_tm_weights(args, l + 1, ws, scr, gw, NGW, lane);
        STEP_END
        if ((MOE_FP8_MASK >> l) & 1u) {
        STEP_BEGIN(11)
            const int ntiles = (int)__hip_atomic_load(ctl + CW_NTILES, __ATOMIC_RELAXED, __HIP_MEMORY_SCOPE_AGENT);
            pg8::SchedMoe S{ntiles, 4, G, bx, (const char*)(ws + WS_XG), (const char*)(ws + WS_WEX), (size_t)256 * D, (size_t)256 * D, (size_t)1024 * 1024, ctl + CW_TILEE};
            pg8::EpiH<true> E{(bf16_t*)(ws + WS_H)};
            pg8::gemm_phase<pg8::EpiH<true>, pg8::SchedMoe, true, -1, true>(lds, D, D, D, S, E, tid, 0x7a7a7a7a);
        STEP_END
        } else {
        STEP_BEGIN(11)
            const int ntiles = (int)__hip_atomic_load(ctl + CW_NTILES, __ATOMIC_RELAXED, __HIP_MEMORY_SCOPE_AGENT);
            pg8::SchedMoe S{ntiles, 4, G, bx, (const char*)(ws + WS_XG), (const char*)(ws + WS_WEX), (size_t)256 * D * 2, (size_t)256 * D * 2, (size_t)1024 * 1024 * 2, ctl + CW_TILEE};
            pg8::EpiH<false> E{(bf16_t*)(ws + WS_H)};
            pg8::gemm_phase<pg8::EpiH<false>, pg8::SchedMoe, true>(lds, D * 2, D * 2, D * 2, S, E, tid);
        STEP_END
        }
        if ((MOE_FP8_MASK >> l) & 1u) {
        STEP_BEGIN(12)
            const int ntiles = (int)__hip_atomic_load(ctl + CW_NTILES, __ATOMIC_RELAXED, __HIP_MEMORY_SCOPE_AGENT);
            pg8::SchedMoe S{ntiles, 4, G, bx, (const char*)(ws + WS_H), (const char*)(ws + WS_WEX) + (size_t)NE * 1024 * 1024, (size_t)256 * FF, (size_t)256 * FF, (size_t)1024 * 512, ctl + CW_TILEE};
            pg8::EpiO E{(bf16_t*)(ws + WS_O), (const int*)(ws + WS_SMALL + SM_ROWINFO)};
            pg8::gemm_phase<pg8::EpiO, pg8::SchedMoe, true, -1, true>(lds, FF, FF, FF, S, E, tid, 0x78787878);
        STEP_END
        } else {
        STEP_BEGIN(12)
            const int ntiles = (int)__hip_atomic_load(ctl + CW_NTILES, __ATOMIC_RELAXED, __HIP_MEMORY_SCOPE_AGENT);
            pg8::SchedMoe S{ntiles, 4, G, bx, (const char*)(ws + WS_H), (const char*)(ws + WS_WEX) + (size_t)NE * 1024 * 1024 * 2, (size_t)256 * FF * 2, (size_t)256 * FF * 2, (size_t)1024 * 512 * 2, ctl + CW_TILEE};
            pg8::EpiO E{(bf16_t*)(ws + WS_O), (const int*)(ws + WS_SMALL + SM_ROWINFO)};
            pg8::gemm_phase<pg8::EpiO, pg8::SchedMoe, true>(lds, FF * 2, FF * 2, FF * 2, S, E, tid);
        STEP_END
        }
        STEP_BEGIN(13)
            phase_ln2(args, l, ws, args->out, lane, gw, NGW);
        STEP_END
    }
#undef STEP_BEGIN
#undef STEP_END
    if ((MK_TP >= 0 || MK_TQ >= 0) && bx == 0 && tid0 == 0) { volatile LAS unsigned long long* tw_ = (volatile LAS unsigned long long*)(lds + LDSCTL_OFF + 512);
        const unsigned long long delay = 10ull * tw_[1] + 100000ull * ((tw_[2] + 50ull) / 100ull); const unsigned long long t0_ = __builtin_amdgcn_s_memrealtime();
        while (__builtin_amdgcn_s_memrealtime() - t0_ < delay) __builtin_amdgcn_s_sleep(32); }
}

extern "C" void kernel_launch(void* const* d_in, const int* in_sizes, int n_in, void* d_out, int out_size, void* d_ws, size_t ws_size, hipStream_t stream) {
    static int grid = 0;
    if (grid == 0) {
        if (n_in != 22 || in_sizes[0] != T * D || out_size != T * D || ws_size < WS_NEED) {
            fprintf(stderr, "kernel_launch: unexpected shapes (n_in %d, in0 %d, out %d, ws %zu, need %zu); nothing launched\n", n_in, n_in > 0 ? in_sizes[0] : -1, out_size, ws_size, (size_t)WS_NEED); grid = -1; return; }
        int dev = 0, cus = 0, per_cu = 0;
        if (hipGetDevice(&dev) != hipSuccess || hipDeviceGetAttribute(&cus, hipDeviceAttributeMultiprocessorCount, dev) != hipSuccess) { grid = -1; return; }
        if (hipFuncSetAttribute((const void*)mk_fwd, hipFuncAttributeMaxDynamicSharedMemorySize, LDS_BYTES) != hipSuccess) { fprintf(stderr, "kernel_launch: hipFuncSetAttribute failed\n"); grid = -1; return; }
        if (hipOccupancyMaxActiveBlocksPerMultiprocessor(&per_cu, (const void*)mk_fwd, 512, LDS_BYTES) != hipSuccess || per_cu < 1) { fprintf(stderr, "kernel_launch: occupancy query says %d blocks per CU\n", per_cu); per_cu = 1; }
        (void)hipGetLastError();
        grid = cus;
    }
    if (grid < 0) return;
    (void)hipMemsetAsync((char*)d_ws + WS_CTL, 0, CTL_ZERO_BYTES, stream);
    Args a{};
    const float** p = (const float**)&a;
    for (int i = 0; i < 22; ++i) p[i] = (const float*)d_in[i];
    a.out = (float*)d_out; a.ws = (unsigned char*)d_ws;
#if MK_PER_STEP_LAUNCH
    for (int s = 0; s < N_STEPS; ++s) { a.ph_lo = s; a.ph_hi = s + 1; hipLaunchKernelGGL(mk_fwd, dim3(grid), dim3(512), LDS_BYTES, stream, a); }
#else
    a.ph_lo = 0; a.ph_hi = N_STEPS;
    hipLaunchKernelGGL(mk_fwd, dim3(grid), dim3(512), LDS_BYTES, stream, a);
#endif
}
```
